# Optimizing an MI355X kernel written in HIP

```python
import math
import jax
import jax.numpy as jnp
from jax import lax
import numpy as np

D_MODEL = 1024
BATCH = 4
SEQ = 8192
DEPTH = 2

CTX_LEN = 256
GRID_W = 64
RMS_EPS = 1e-6
N_MOD = 6
D_FF = 4 * D_MODEL

RWKV_HEAD = 64
RWKV_W = D_MODEL // 4
RWKV_HEADS = RWKV_W // RWKV_HEAD
DECAY_LORA = 32
AAA_LORA = 32
GATE_LORA = 64
RWKV_COLS = 3 * RWKV_W + DECAY_LORA + AAA_LORA + GATE_LORA
LNX_EPS = 64e-5

GDN_HEAD = 128
GDN_W = D_MODEL // 2
GDN_HEADS = GDN_W // GDN_HEAD
GDN_CONV = 5
GDN_CHUNK = 64
GDN_COLS = 4 * GDN_W + 4 * GDN_HEADS

FNET_CH = 64
FNET_W = D_MODEL - RWKV_W - GDN_W
FNET_GROUPS = FNET_W // FNET_CH

MIX_W = RWKV_W + GDN_W + FNET_W
IN_COLS = RWKV_COLS + GDN_COLS + FNET_W

kernel_name = 'hybrid_rwkv7_gdn_fnet_dit_block'


def rmsnorm(x, g, eps=RMS_EPS):
    xf = x.astype(jnp.float32)
    y = xf * lax.rsqrt(jnp.mean(xf * xf, axis=-1, keepdims=True) + eps)
    return (y * g.astype(jnp.float32)).astype(x.dtype)


def l2norm(x, eps=1e-6):
    xf = x.astype(jnp.float32)
    return xf * lax.rsqrt(jnp.sum(xf * xf, axis=-1, keepdims=True) + eps)


def modulate(h, shift, scale):
    return h * (1 + scale) + shift


def qshift_grid(u, rows):
    b, t, ch = u.shape
    g = u.reshape(b, rows, GRID_W, ch // 4, 4)
    p = jnp.pad(g, ((0, 0), (1, 1), (1, 1), (0, 0), (0, 0)))
    sh = jnp.stack([p[:, 1:-1, :-2, :, 0], p[:, 1:-1, 2:, :, 1],
                    p[:, :-2, 1:-1, :, 2], p[:, 2:, 1:-1, :, 3]], axis=-1)
    return sh.reshape(b, t, ch)


def bishift_seq(u):
    b, t, ch = u.shape
    g = u.reshape(b, t, ch // 2, 2)
    p = jnp.pad(g, ((0, 0), (1, 1), (0, 0), (0, 0)))
    sh = jnp.stack([p[:, :-2, :, 0], p[:, 2:, :, 1]], axis=-1)
    return sh.reshape(b, t, ch)


def dwconv_centred(u, w):
    ch = u.shape[-1]
    kw = w.shape[0]
    return lax.conv_general_dilated(u, w[:, None, :].astype(u.dtype), window_strides=(1,),
                                    padding=[(kw // 2, kw // 2)],
                                    dimension_numbers=('NWC', 'WIO', 'NWC'),
                                    feature_group_count=ch)


def rwkv7_scan(r, w, k, v, kk, a, s0):
    def step(s, inp):
        r_t, w_t, k_t, v_t, kk_t, a_t = inp
        sa = jnp.einsum('bhvk,bhk->bhv', s, kk_t)
        s = (s * w_t[:, :, None, :] - sa[..., None] * (kk_t * a_t)[:, :, None, :]
             + v_t[..., None] * k_t[:, :, None, :])
        return s, jnp.einsum('bhvk,bhk->bhv', s, r_t)
    xs = tuple(jnp.moveaxis(z, 1, 0) for z in (r, w, k, v, kk, a))
    s, o = lax.scan(step, s0, xs)
    return jnp.moveaxis(o, 0, 1), s


def gdn_chunk_scan(q, k, v, g, beta, s0):
    b, t, h, dk = q.shape
    dv = v.shape[-1]
    cs = GDN_CHUNK
    n = t // cs

    def blocks(z):
        z = z.reshape((b, n, cs) + z.shape[2:])
        return jnp.moveaxis(jnp.moveaxis(z, 1, 0), 3, 2)

    qc, kc, vc, bc = blocks(q), blocks(k), blocks(v), blocks(beta)
    gc = jnp.cumsum(blocks(g), axis=-1)
    idx = jnp.arange(cs)
    incl = idx[:, None] >= idx[None, :]
    strict = idx[:, None] > idx[None, :]
    diff = gc[..., :, None] - gc[..., None, :]
    decay = jnp.where(incl, jnp.exp(jnp.where(incl, diff, 0.0)), 0.0)
    kb = kc * bc[..., None]
    lmat = jnp.where(strict, jnp.einsum('nbhik,nbhjk->nbhij', kb, kc) * decay, 0.0)
    amat = lmat + jnp.eye(cs, dtype=lmat.dtype)
    rhs = jnp.concatenate([vc * bc[..., None], kb * jnp.exp(gc)[..., None]], axis=-1)
    sol = lax.linalg.triangular_solve(amat, rhs, left_side=True, lower=True,
                                      unit_diagonal=True)
    uc, wc = sol[..., :dv], sol[..., dv:]
    qk = jnp.einsum('nbhik,nbhjk->nbhij', qc, kc) * decay

    def step(s, inp):
        q_i, k_i, u_i, w_i, g_i, qk_i = inp
        v_new = u_i - jnp.einsum('bhck,bhkv->bhcv', w_i, s)
        o = (jnp.einsum('bhck,bhkv->bhcv', q_i * jnp.exp(g_i)[..., None], s)
             + jnp.einsum('bhij,bhjv->bhiv', qk_i, v_new))
        g_last = g_i[..., -1]
        s = (s * jnp.exp(g_last)[..., None, None]
             + jnp.einsum('bhck,bhcv->bhkv', k_i * jnp.exp(g_last[..., None] - g_i)[..., None], v_new))
        return s, o

    s, o = lax.scan(step, s0, (qc, kc, uc, wc, gc, qk))
    o = jnp.moveaxis(jnp.moveaxis(o, 2, 3), 0, 1).reshape(b, t, h, dv)
    return o, s


def _flip(z, rev):
    return jnp.flip(z, axis=1) if rev else z


def rwkv_mixer(u, shift_fn, s_init, mu, w0, w_up, a0, a_up, g_up, k_k, k_a, r_k, lnx_g, lnx_b):
    b, t, _ = u.shape
    W, H, N = RWKV_W, RWKV_HEADS, RWKV_HEAD
    u = u.astype(jnp.float32)
    u = u + mu * (shift_fn(u) - u)
    r, k, v = u[..., :W], u[..., W:2 * W], u[..., 2 * W:3 * W]
    wd = u[..., 3 * W:3 * W + DECAY_LORA]
    ad = u[..., 3 * W + DECAY_LORA:3 * W + DECAY_LORA + AAA_LORA]
    gd = u[..., 3 * W + DECAY_LORA + AAA_LORA:]
    heads = lambda z: z.reshape(b, t, H, N)
    kk = l2norm(heads(k * k_k), eps=1e-12)
    gate = jax.nn.sigmoid(gd) @ g_up
    rh, vh = heads(r), heads(v)
    outs, bonus, states = [], [], []
    for d in range(2):
        rev = d == 1
        w_log = -jax.nn.softplus(-(w0[d] + jnp.tanh(wd) @ w_up[d])) - 0.5
        dec = jnp.exp(-jnp.exp(w_log))
        a = jax.nn.sigmoid(a0[d] + ad @ a_up[d])
        kd = heads(k * (1 + (a - 1) * k_a))
        o, s = rwkv7_scan(_flip(rh, rev), _flip(heads(dec), rev), _flip(kd, rev),
                          _flip(vh, rev), _flip(kk, rev), _flip(heads(a), rev), s_init[d])
        outs.append(_flip(o, rev))
        states.append(s)
        bonus.append(jnp.sum(rh * kd * r_k, axis=-1, keepdims=True) * vh)
    o = outs[0] + outs[1]
    mean = jnp.mean(o, axis=-1, keepdims=True)
    var = jnp.mean(jnp.square(o - mean), axis=-1, keepdims=True)
    o = ((o - mean) * lax.rsqrt(var + LNX_EPS)).reshape(b, t, W) * lnx_g + lnx_b
    o = (o + (bonus[0] + bonus[1]).reshape(b, t, W)) * gate
    return o, (states[0], states[1])


def gdn_mixer(u, s_init, conv_w, a_log, dt_bias, norm_g):
    b, t, _ = u.shape
    W, H, Dh = GDN_W, GDN_HEADS, GDN_HEAD
    qkv = jax.nn.silu(dwconv_centred(u[..., :3 * W], conv_w)).astype(jnp.float32)
    heads = lambda z: z.reshape(b, t, H, Dh)
    q = l2norm(heads(qkv[..., :W])) * (Dh ** -0.5)
    k = l2norm(heads(qkv[..., W:2 * W]))
    v = heads(qkv[..., 2 * W:])
    z = heads(u[..., 3 * W:4 * W]).astype(jnp.float32)
    sc = u[..., 4 * W:].astype(jnp.float32).reshape(b, t, 4, H)
    outs, states = [], []
    for d in range(2):
        rev = d == 1
        beta = jax.nn.sigmoid(sc[:, :, d])
        gl = -jnp.exp(a_log[d].astype(jnp.float32)) * jax.nn.softplus(sc[:, :, 2 + d] + dt_bias[d])
        o, s = gdn_chunk_scan(_flip(q, rev), _flip(k, rev), _flip(v, rev), _flip(gl, rev),
                              _flip(beta, rev), s_init[d])
        outs.append(_flip(o, rev))
        states.append(s)
    o = rmsnorm(outs[0] + outs[1], norm_g) * jax.nn.silu(z)
    return o.reshape(b, t, W), (states[0], states[1])


def fourier_mixer(u, w_f):
    b, t, _ = u.shape
    g = u.astype(jnp.float32).reshape(b, t, FNET_GROUPS, FNET_CH)
    f = jnp.fft.fft2(g, axes=(1, 3), norm='ortho').real
    return jnp.einsum('btgc,gcd->btgd', f, w_f).reshape(b, t, FNET_W)


def sq_relu_mlp(h, w1, w2):
    a = jax.nn.relu(h @ w1)
    return (a * a) @ w2


def setup_inputs(seed: int = 0) -> dict:
    key = jax.random.key(seed)
    ks = jax.random.split(key, 32)
    f32 = jnp.float32
    L, D = DEPTH, D_MODEL

    def nrm(i, shape, scale):
        return jax.random.normal(ks[i], shape, f32) * scale

    def uni(i, shape, lo, hi):
        return jax.random.uniform(ks[i], shape, f32, lo, hi)

    dt = jnp.exp(uni(23, (L, 2, GDN_HEADS), math.log(1e-3), math.log(1e-1)))
    return {
        'x': nrm(0, (BATCH, SEQ, D), 1.0),
        'c': nrm(1, (BATCH, D), 1.0),
        'ctx': nrm(2, (BATCH, CTX_LEN, D), 1.0),
        'c_ctx': nrm(3, (D,), 1.0),
        'norm1_g': 1.0 + nrm(4, (L, D), 0.02),
        'norm2_g': 1.0 + nrm(5, (L, D), 0.02),
        'w_mod': nrm(6, (L, D, N_MOD * D), 0.5 * D ** -0.5),
        'b_mod': nrm(7, (L, N_MOD * D), 0.02),
        'w_in': nrm(8, (L, D, IN_COLS), D ** -0.5),
        'w_out': nrm(9, (L, MIX_W, D), MIX_W ** -0.5),
        'rk_mu': uni(10, (L, RWKV_COLS), 0.0, 1.0),
        'rk_w0': uni(11, (L, 2, RWKV_W), -6.0, -0.5),
        'rk_w_up': nrm(12, (L, 2, DECAY_LORA, RWKV_W), 0.5 * DECAY_LORA ** -0.5),
        'rk_a0': nrm(13, (L, 2, RWKV_W), 0.1),
        'rk_a_up': nrm(14, (L, 2, AAA_LORA, RWKV_W), 0.5 * AAA_LORA ** -0.5),
        'rk_g_up': nrm(15, (L, GATE_LORA, RWKV_W), GATE_LORA ** -0.5),
        'rk_k_k': 0.85 + nrm(16, (L, RWKV_W), 0.02),
        'rk_k_a': 1.0 + nrm(17, (L, RWKV_W), 0.02),
        'rk_r_k': nrm(18, (L, RWKV_HEADS, RWKV_HEAD), 0.1),
        'rk_lnx_g': 1.0 + nrm(19, (L, RWKV_W), 0.02),
        'rk_lnx_b': nrm(20, (L, RWKV_W), 0.02),
        'gd_conv_w': nrm(21, (L, GDN_CONV, 3 * GDN_W), GDN_CONV ** -0.5),
        'gd_a_log': jnp.log(uni(22, (L, 2, GDN_HEADS), 1.0, 16.0)),
        'gd_dt_bias': dt + jnp.log(-jnp.expm1(-dt)),
        'gd_norm_g': 1.0 + nrm(24, (L, GDN_HEAD), 0.02),
        'fn_w': nrm(25, (L, FNET_GROUPS, FNET_CH, FNET_CH), FNET_CH ** -0.5),
        'mlp_w1': nrm(26, (L, D, D_FF), D ** -0.5),
        'mlp_w2': nrm(27, (L, D_FF, D), D_FF ** -0.5),
        'final_g': 1.0 + nrm(28, (D,), 0.02),
    }


def reference(x, c, ctx, c_ctx, norm1_g, norm2_g, w_mod, b_mod, w_in, w_out,
              rk_mu, rk_w0, rk_w_up, rk_a0, rk_a_up, rk_g_up, rk_k_k, rk_k_a, rk_r_k,
              rk_lnx_g, rk_lnx_b, gd_conv_w, gd_a_log, gd_dt_bias, gd_norm_g, fn_w,
              mlp_w1, mlp_w2, final_g):
    b = x.shape[0]
    rows = x.shape[1] // GRID_W
    grid_shift = lambda u: qshift_grid(u, rows)
    r_end = RWKV_COLS
    g_end = RWKV_COLS + GDN_COLS
    zero_r = jnp.zeros((b, RWKV_HEADS, RWKV_HEAD, RWKV_HEAD), jnp.float32)
    zero_g = jnp.zeros((b, GDN_HEADS, GDN_HEAD, GDN_HEAD), jnp.float32)
    xl, xc = x, ctx
    for l in range(DEPTH):
        last = l == DEPTH - 1
        m = (jax.nn.silu(c) @ w_mod[l] + b_mod[l]).reshape(b, N_MOD, 1, D_MODEL)
        mc = (jax.nn.silu(c_ctx) @ w_mod[l] + b_mod[l]).reshape(N_MOD, D_MODEL)
        rk = (rk_mu[l], rk_w0[l], rk_w_up[l], rk_a0[l], rk_a_up[l], rk_g_up[l],
              rk_k_k[l], rk_k_a[l], rk_r_k[l], rk_lnx_g[l], rk_lnx_b[l])
        gd = (gd_conv_w[l], gd_a_log[l], gd_dt_bias[l], gd_norm_g[l])
        uc = modulate(rmsnorm(xc, norm1_g[l]), mc[0], mc[1]) @ w_in[l]
        yrc, sr = rwkv_mixer(uc[..., :r_end], bishift_seq, (zero_r, zero_r), *rk)
        ygc, sg = gdn_mixer(uc[..., r_end:g_end], (zero_g, zero_g), *gd)
        ux = modulate(rmsnorm(xl, norm1_g[l]), m[:, 0], m[:, 1]) @ w_in[l]
        yrx, _ = rwkv_mixer(ux[..., :r_end], grid_shift, sr, *rk)
        ygx, _ = gdn_mixer(ux[..., r_end:g_end], sg, *gd)
        yfx = fourier_mixer(ux[..., g_end:], fn_w[l])
        yx = jnp.concatenate([yrx, ygx, yfx], axis=-1).astype(xl.dtype) @ w_out[l]
        xl = xl + m[:, 2] * yx
        hx = modulate(rmsnorm(xl, norm2_g[l]), m[:, 3], m[:, 4])
        xl = xl + m[:, 5] * sq_relu_mlp(hx, mlp_w1[l], mlp_w2[l])
        if not last:
            yfc = fourier_mixer(uc[..., g_end:], fn_w[l])
            yc = jnp.concatenate([yrc, ygc, yfc], axis=-1).astype(xc.dtype) @ w_out[l]
            xc = xc + mc[2] * yc
            hc = modulate(rmsnorm(xc, norm2_g[l]), mc[3], mc[4])
            xc = xc + mc[5] * sq_relu_mlp(hc, mlp_w1[l], mlp_w2[l])
    return rmsnorm(xl, final_g)
```

```cpp
#include <hip/hip_runtime.h>
#include <hip/hip_cooperative_groups.h>
#include <cstdio>
#include <cstdint>
namespace cg = cooperative_groups;
namespace pg8 {
#define PG8_LAS __attribute__((address_space(3)))
typedef unsigned short bf16_t;
typedef short bf16x8 __attribute__((ext_vector_type(8)));
typedef float f32x4 __attribute__((ext_vector_type(4)));
typedef unsigned u32x4 __attribute__((ext_vector_type(4)));
constexpr int BM = 256, BK = 64, HALF = 128, HTB = HALF * BK * 2  , STAGE_BYTES = 8 * HTB, NXCD = 8, WGM = 8;

__host__ __device__ __forceinline__ int lds_byte(int r, int c) { const int st = (r >> 4) * 2 + (c >> 5), rr = r & 15, cc = c & 31, ob = rr * 64 + cc * 2; return st * 1024 + (ob ^ (((ob >> 9) & 1) << 5)); }
__host__ __device__ __forceinline__ void stage_rc(int b, int& R, int& C) { const int st = b / 1024, sb = b % 1024, swz = sb ^ (((sb >> 9) & 1) << 5); R = (st >> 1) * 16 + swz / 64; C = (st & 1) * 32 + (swz % 64) / 2; }
__host__ __device__ __forceinline__ int perm32(int rho) { const int n = rho >> 4, i = rho & 15; return 8 * (i >> 2) + 4 * n + (i & 3); }

struct Unit { int pm, pn; };
struct Gemm { const bf16_t* A; const bf16_t* Bt; int M, N, K; };

struct StaticOrder {
    int nM, nN, nwg, G, c;
    __host__ __device__ void init(int M, int N, int G_, int c_) { nM = M / BM; nN = N / BM; nwg = nM * nN; G = G_; c = c_; }
    __host__ __device__ bool next(int i, Unit& u) const {
        const long L = (long)i * G + c; if (L >= nwg) return false;
        int wgid = (int)L; { const int q = nwg / NXCD, r = nwg % NXCD, xcd = wgid % NXCD, off = wgid / NXCD; wgid = (xcd < r ? xcd * (q + 1) : r * (q + 1) + (xcd - r) * q) + off; }
        const int nig = WGM * nN, gid = wgid / nig, fm = gid * WGM, gsz = (nM - fm) < WGM ? (nM - fm) : WGM;
        u.pm = fm + ((wgid % nig) % gsz); u.pn = (wgid % nig) / gsz; return true;
    }
    __device__ __forceinline__ void a_ready(const Unit&) const {}
    __device__ __forceinline__ void done(const Unit&) const {}
};

typedef __bf16 bf16x2_t __attribute__((ext_vector_type(2)));
typedef float f32x2_t __attribute__((ext_vector_type(2)));
__device__ __forceinline__ unsigned cvt_pk_bf16(float lo, float hi) { const f32x2_t v = {lo, hi}; const bf16x2_t b = __builtin_convertvector(v, bf16x2_t); return __builtin_bit_cast(unsigned, b); }
template <int ACT  > struct EpiBf16 {
    static constexpr bool PERM = true, AFTER_DRAIN = false;
    bf16_t* O; int ldc;
    __device__ __forceinline__ void operator()(const f32x4 (&acc)[2][2][4][2], const Unit& u, int wr, int wc, int fr, int fq) const {
        const int row0 = u.pm * BM + wr * 64 + fr; const int col0 = u.pn * BM + wc * 32 + 8 * fq;
#pragma unroll
        for (int ai = 0; ai < 2; ++ai)
#pragma unroll
            for (int m = 0; m < 4; ++m) { bf16_t* rowp = O + (size_t)(row0 + ai * HALF + m * 16) * ldc + col0;
#pragma unroll
                for (int bj = 0; bj < 2; ++bj) { f32x4 v0 = acc[ai][bj][m][0], v1 = acc[ai][bj][m][1];
                    if (ACT == 1) {
#pragma unroll
                        for (int e = 0; e < 4; ++e) { float a = v0[e] > 0.f ? v0[e] : 0.f; v0[e] = a * a; float b = v1[e] > 0.f ? v1[e] : 0.f; v1[e] = b * b; } }
                    u32x4 w; w.x = cvt_pk_bf16(v0[0], v0[1]); w.y = cvt_pk_bf16(v0[2], v0[3]); w.z = cvt_pk_bf16(v1[0], v1[1]); w.w = cvt_pk_bf16(v1[2], v1[3]);
                    *(u32x4*)(rowp + bj * HALF) = w; } }
    }
};
struct EpiResid {
    static constexpr bool PERM = true, AFTER_DRAIN = false;
    const float* rin_lat; const float* rin_ctx; float* rout_lat; float* rout_ctx; const float* gate;
    __device__ __forceinline__ void operator()(const f32x4 (&acc)[2][2][4][2], const Unit& u, int wr, int wc, int fr, int fq) const {
        const bool lat = u.pm < 128; const int bb = lat ? (u.pm >> 5) : 4;
        const int rbase = (lat ? u.pm * 256 : (u.pm - 128) * 256) + wr * 64 + fr;
        const float* rin = lat ? rin_lat : rin_ctx; float* rout = lat ? rout_lat : rout_ctx;
        const int col0 = u.pn * BM + wc * 32 + 8 * fq;
        const float* gv = gate + bb * 6144 + col0;
        f32x4 g[2][2];
#pragma unroll
        for (int bj = 0; bj < 2; ++bj)
#pragma unroll
            for (int n = 0; n < 2; ++n) g[bj][n] = *(const f32x4*)(gv + bj * HALF + 4 * n);
#pragma unroll
        for (int ai = 0; ai < 2; ++ai)
#pragma unroll
            for (int m = 0; m < 4; ++m) { const size_t ro = (size_t)(rbase + ai * HALF + m * 16) * 1024 + col0;
#pragma unroll
                for (int bj = 0; bj < 2; ++bj) {
                    const f32x4 x0 = *(const f32x4*)(rin + ro + bj * HALF), x1 = *(const f32x4*)(rin + ro + bj * HALF + 4);
                    *(f32x4*)(rout + ro + bj * HALF) = x0 + g[bj][0] * acc[ai][bj][m][0];
                    *(f32x4*)(rout + ro + bj * HALF + 4) = x1 + g[bj][1] * acc[ai][bj][m][1]; } }
    }
};
template <class Epi, class Sched, bool ALIGN_EPI = false, bool SP2 = false>
__device__ __forceinline__ void gemm_phase(PG8_LAS unsigned char* lds, const Gemm g, const Sched& S, const Epi& E) {
    int tid_l = threadIdx.x; asm volatile("" : "+v"(tid_l));
    const int tid = tid_l, wid = __builtin_amdgcn_readfirstlane(tid >> 6), lane = tid & 63, wr = wid >> 2, wc = wid & 3, fr = lane & 15, fq = lane >> 4;
    const int K = g.K, nt = K / BK;
    unsigned voffA[2], voffB[2];
#pragma unroll
    for (int i = 0; i < 2; ++i) { int R, C; stage_rc(tid * 16 + i * 8192, R, C); const int Rb = Epi::PERM ? ((R & ~31) + perm32(R & 31)) : R;
        voffA[i] = (unsigned)(R * K + C) * 2u; voffB[i] = (unsigned)(Rb * K + C) * 2u; }
    const size_t kstep = (size_t)(BK * 2);
    const size_t hstep = (size_t)HALF * K * 2;
    const size_t tstep = 2 * hstep;
    const unsigned ldsw = (unsigned)wid * 1024u;
    const int aoff = lds_byte(wr * 64 + fr, fq * 8), boff = lds_byte(wc * 32 + fr, fq * 8);
#define PG8_SA(b, h) (((b) * 2 + (h)) * HTB)
#define PG8_SB(b, h) ((4 + (b) * 2 + (h)) * HTB)
#define PG8_STAGE(bufoff, gbase, voff) do { _Pragma("unroll") for (int _i = 0; _i < 2; ++_i) \
        __builtin_amdgcn_global_load_lds((const unsigned*)((const char*)(gbase) + (voff)[_i]), (PG8_LAS unsigned*)(lds + (bufoff) + ldsw + _i * 8192), 16, 0, 0); } while (0)
#define PG8_LDA(dst, b, h) do { _Pragma("unroll") for (int m = 0; m < 4; ++m) _Pragma("unroll") for (int k = 0; k < 2; ++k) dst[m][k] = *(const PG8_LAS bf16x8*)(lds + PG8_SA(b, h) + aoff + m * 2048 + k * 1024); } while (0)
#define PG8_LDB(dst, b, h) do { _Pragma("unroll") for (int n = 0; n < 2; ++n) _Pragma("unroll") for (int k = 0; k < 2; ++k) dst[n][k] = *(const PG8_LAS bf16x8*)(lds + PG8_SB(b, h) + boff + n * 2048 + k * 1024); } while (0)
#define PG8_MMA(ai, bj, At, Bt) do { __builtin_amdgcn_s_setprio(1); _Pragma("unroll") for (int m = 0; m < 4; ++m) _Pragma("unroll") for (int n = 0; n < 2; ++n) _Pragma("unroll") for (int k = 0; k < 2; ++k) \
        acc[ai][bj][m][n] = __builtin_amdgcn_mfma_f32_16x16x32_bf16(Bt[n][k], At[m][k], acc[ai][bj][m][n], 0, 0, 0); __builtin_amdgcn_s_setprio(0); } while (0)
#define PG8_WAIT_V(n) asm volatile("s_waitcnt vmcnt(" #n ")" ::: "memory")
#define PG8_WAIT_L(n) asm volatile("s_waitcnt lgkmcnt(" #n ")" ::: "memory")
#define PG8_BAR __builtin_amdgcn_s_barrier()
#define PG8_SCHED __builtin_amdgcn_sched_barrier(0)
    Unit cur, nxt; int ui = 0;
    if (!S.next(0, cur)) return;
    f32x4 acc[2][2][4][2];
#pragma unroll
    for (int a = 0; a < 2; ++a)
#pragma unroll
        for (int b = 0; b < 2; ++b)
#pragma unroll
            for (int m = 0; m < 4; ++m)
#pragma unroll
                for (int n = 0; n < 2; ++n) acc[a][b][m][n] = (f32x4){0.f, 0.f, 0.f, 0.f};
    bf16x8 At[4][2], B0[2][2], B1[2][2];
    const char* cA = (const char*)g.A + (size_t)cur.pm * tstep; const char* cB = (const char*)g.Bt + (size_t)cur.pn * tstep;
    S.a_ready(cur);
    if constexpr (SP2) {
        PG8_STAGE(PG8_SB(0, 0), cB, voffB); PG8_STAGE(PG8_SB(0, 1), cB + hstep, voffB); PG8_STAGE(PG8_SA(0, 0), cA, voffA); PG8_STAGE(PG8_SA(0, 1), cA + hstep, voffA);
        if (wr == 1) PG8_BAR;
        PG8_WAIT_V(2); PG8_BAR;
        PG8_STAGE(PG8_SB(1, 0), cB + kstep, voffB); PG8_STAGE(PG8_SA(1, 0), cA + kstep, voffA); PG8_STAGE(PG8_SB(1, 1), cB + hstep + kstep, voffB);
        PG8_WAIT_V(6); PG8_BAR;
    } else {
        PG8_STAGE(PG8_SB(0, 0), cB, voffB); PG8_STAGE(PG8_SA(0, 0), cA, voffA); PG8_STAGE(PG8_SB(0, 1), cB + hstep, voffB); PG8_STAGE(PG8_SA(0, 1), cA + hstep, voffA);
        if (wr == 1) PG8_BAR;
        PG8_WAIT_V(4); PG8_BAR;
        PG8_STAGE(PG8_SB(1, 0), cB + kstep, voffB); PG8_STAGE(PG8_SA(1, 0), cA + kstep, voffA); PG8_STAGE(PG8_SB(1, 1), cB + hstep + kstep, voffB);
        PG8_WAIT_V(6); PG8_BAR;
    }
    for (;;) {
        const bool has_next = S.next(ui + 1, nxt);
        const char* nA = has_next ? (const char*)g.A + (size_t)nxt.pm * tstep : cA; const char* nB = has_next ? (const char*)g.Bt + (size_t)nxt.pn * tstep : cB;
        for (int t = 0; t < nt; t += 2) {
            const bool last = (t == nt - 2);
            const char* a1 = cA + (size_t)(t + 1) * kstep;
            const char* a2 = last ? nA : cA + (size_t)(t + 2) * kstep; const char* b2 = last ? nB : cB + (size_t)(t + 2) * kstep;
            const char* a3 = a2 + kstep; const char* b3 = b2 + kstep;
            if (last && has_next) S.a_ready(nxt);
            if constexpr (SP2) {
            PG8_LDB(B0, 0, 0); PG8_LDB(B1, 0, 1); PG8_SCHED; PG8_LDA(At, 0, 0); PG8_STAGE(PG8_SA(1, 1), a1 + hstep, voffA);
            PG8_WAIT_V(8); PG8_WAIT_L(0); PG8_BAR; PG8_MMA(0, 0, At, B0); PG8_MMA(0, 1, At, B1); PG8_BAR; PG8_SCHED;
            PG8_LDA(At, 0, 1); PG8_STAGE(PG8_SB(0, 0), b2, voffB); PG8_STAGE(PG8_SB(0, 1), b2 + hstep, voffB); PG8_STAGE(PG8_SA(0, 0), a2, voffA);
            PG8_WAIT_V(8); PG8_WAIT_L(0); PG8_BAR; PG8_MMA(1, 0, At, B0); PG8_MMA(1, 1, At, B1); PG8_BAR; PG8_SCHED;
            PG8_LDB(B0, 1, 0); PG8_LDB(B1, 1, 1); PG8_SCHED; PG8_LDA(At, 1, 0); PG8_STAGE(PG8_SA(0, 1), a2 + hstep, voffA);
            PG8_WAIT_V(8); PG8_WAIT_L(0); PG8_BAR; PG8_MMA(0, 0, At, B0); PG8_MMA(0, 1, At, B1); PG8_BAR; PG8_SCHED;
            PG8_LDA(At, 1, 1); PG8_STAGE(PG8_SB(1, 0), b3, voffB); PG8_STAGE(PG8_SB(1, 1), b3 + hstep, voffB); PG8_STAGE(PG8_SA(1, 0), a3, voffA);
            PG8_WAIT_V(8); PG8_WAIT_L(0); PG8_BAR; PG8_MMA(1, 0, At, B0); PG8_MMA(1, 1, At, B1); PG8_BAR; PG8_SCHED;
            } else {
            PG8_LDB(B0, 0, 0); PG8_SCHED; PG8_LDA(At, 0, 0); PG8_STAGE(PG8_SA(1, 1), a1 + hstep, voffA);
            PG8_WAIT_L(8); PG8_BAR; PG8_WAIT_L(0); PG8_MMA(0, 0, At, B0); PG8_BAR; PG8_SCHED;
            PG8_LDB(B1, 0, 1); PG8_STAGE(PG8_SB(0, 0), b2, voffB);
            PG8_BAR; PG8_WAIT_L(0); PG8_MMA(0, 1, At, B1); PG8_BAR;
            PG8_LDA(At, 0, 1); PG8_STAGE(PG8_SA(0, 0), a2, voffA);
            PG8_BAR; PG8_WAIT_L(0); PG8_MMA(1, 0, At, B0); PG8_BAR; PG8_SCHED;
            PG8_STAGE(PG8_SB(0, 1), b2 + hstep, voffB);
            PG8_WAIT_V(6); PG8_BAR; PG8_MMA(1, 1, At, B1); PG8_BAR;
            PG8_LDB(B0, 1, 0); PG8_SCHED; PG8_LDA(At, 1, 0); PG8_STAGE(PG8_SA(0, 1), a2 + hstep, voffA);
            PG8_WAIT_L(8); PG8_BAR; PG8_WAIT_L(0); PG8_MMA(0, 0, At, B0); PG8_BAR; PG8_SCHED;
            PG8_LDB(B1, 1, 1); PG8_STAGE(PG8_SB(1, 0), b3, voffB);
            PG8_BAR; PG8_WAIT_L(0); PG8_MMA(0, 1, At, B1); PG8_BAR;
            PG8_LDA(At, 1, 1); PG8_STAGE(PG8_SA(1, 0), a3, voffA);
            PG8_BAR; PG8_WAIT_L(0); PG8_MMA(1, 0, At, B0); PG8_BAR; PG8_SCHED;
            PG8_STAGE(PG8_SB(1, 1), b3 + hstep, voffB);
            PG8_WAIT_V(6); PG8_BAR; PG8_MMA(1, 1, At, B1); PG8_BAR;
            }
        }
        if constexpr (ALIGN_EPI) { if (wr == 0) PG8_BAR; }
        if constexpr (!Epi::AFTER_DRAIN) { E(acc, cur, wr, wc, fr, fq); S.done(cur); }
        if (!has_next) break;
#pragma unroll
        for (int a = 0; a < 2; ++a)
#pragma unroll
            for (int b = 0; b < 2; ++b)
#pragma unroll
                for (int m = 0; m < 4; ++m)
#pragma unroll
                    for (int n = 0; n < 2; ++n) acc[a][b][m][n] = (f32x4){0.f, 0.f, 0.f, 0.f};
        cur = nxt; cA = nA; cB = nB; ++ui;
        if constexpr (ALIGN_EPI) { if (wr == 1) PG8_BAR; }
    }
    PG8_WAIT_V(0);
    if constexpr (!ALIGN_EPI) { if (wr == 0) PG8_BAR; }
    PG8_BAR;
    if constexpr (Epi::AFTER_DRAIN) { E.fused(acc, cur, wr, wc, fr, fq, lds, wid, lane); S.done(cur); }
#undef PG8_SA
#undef PG8_SB
#undef PG8_STAGE
#undef PG8_LDA
#undef PG8_LDB
#undef PG8_MMA
#undef PG8_WAIT_V
#undef PG8_WAIT_L
#undef PG8_BAR
#undef PG8_SCHED
}
}
typedef unsigned short bf16_t;
typedef short bf16x8 __attribute__((ext_vector_type(8)));
typedef float f32x4 __attribute__((ext_vector_type(4)));
constexpr int NB = 4, T = 8192, TC = 256, D = 1024, DFF = 4096;
constexpr int ML = NB * T, MC = NB * TC, M = ML + MC;
constexpr int LDU = 3584;
constexpr int NPLAIN = 2960, WIN_N = 3216;
constexpr int C_GQ = 896, C_GK = 1408, C_GV = 1920, C_GZ = 2432, C_GS = 2944, C_FZ = 2960;
constexpr size_t MiB = 1u << 20;
constexpr size_t WS_MOD = MiB / 2;
constexpr size_t WS_BC = 3 * MiB / 4;
constexpr size_t WS_WIN = 2 * MiB;
constexpr size_t WS_WOUT = 16 * MiB;
constexpr size_t WS_W1 = 20 * MiB;
constexpr size_t WS_W2 = 36 * MiB;
constexpr size_t WS_XC = 52 * MiB;
constexpr size_t WS_HN = 56 * MiB;
constexpr size_t WS_MID = 56 * MiB;
constexpr size_t WS_OR = 88 * MiB;
constexpr size_t WS_U = 122 * MiB;
constexpr size_t WS_OG = 353 * MiB;
constexpr size_t WS_Y = 419 * MiB;
constexpr size_t WS_H = 122 * MiB;
constexpr size_t WS_END = 485 * MiB;
constexpr size_t WS_BARW = 0;
constexpr int LDS_XB = 159680;
constexpr size_t WS_SBR = 485 * MiB;
constexpr size_t WS_SBG = 487 * MiB;
constexpr size_t WS_END2 = 495 * MiB;
constexpr int LDS_BYTES = 159744;
constexpr int NPH = 18;

struct Prm { const float* in[29]; float* out; unsigned char* ws; int ph_lo, ph_hi; };

__device__ __forceinline__ bf16_t f2bf(float f) { const __bf16 b = (__bf16)f; return __builtin_bit_cast(unsigned short, b); }
__device__ __forceinline__ float bf2f(bf16_t h) { return __uint_as_float(((unsigned)h) << 16); }
__device__ __forceinline__ unsigned pk2(float lo, float hi) { return pg8::cvt_pk_bf16(lo, hi); }
__device__ __forceinline__ float bfe(const uint4& q, int e) { const unsigned w = (e < 2) ? q.x : (e < 4) ? q.y : (e < 6) ? q.z : q.w; return (e & 1) ? __uint_as_float(w & 0xffff0000u) : __uint_as_float(w << 16); }
__device__ __forceinline__ uint4 pack8(const float* v) { uint4 o; o.x = pk2(v[0], v[1]); o.y = pk2(v[2], v[3]); o.z = pk2(v[4], v[5]); o.w = pk2(v[6], v[7]); return o; }
__device__ __forceinline__ float wave_sum(float v) {
#pragma unroll
    for (int o = 1; o < 64; o <<= 1) v += __shfl_xor(v, o);
    return v;
}
__device__ __forceinline__ float fexp(float x) { return __expf(x); }
__device__ __forceinline__ float frcp(float x) { return __builtin_amdgcn_rcpf(x); }
__device__ __forceinline__ float sigmoidf_(float x) { return frcp(1.f + fexp(-x)); }
__device__ __forceinline__ float softplusf_(float z) { const float e = fexp(z); return z > 20.f ? z : (e < 1e-3f ? e * (1.f - 0.5f * e) : __logf(1.f + e)); }
__device__ __forceinline__ float ftanh(float x) { return 1.f - 2.f * frcp(1.f + fexp(2.f * x)); }
__device__ __forceinline__ float siluf_(float x) { return x * frcp(1.f + fexp(-x)); }
__device__ __forceinline__ float shx1(float v) { return __int_as_float(__builtin_amdgcn_ds_swizzle(__float_as_int(v), 0x041F)); }
__device__ __forceinline__ float shx2(float v) { return __int_as_float(__builtin_amdgcn_ds_swizzle(__float_as_int(v), 0x081F)); }
__device__ __forceinline__ float shx4(float v) { return __int_as_float(__builtin_amdgcn_ds_swizzle(__float_as_int(v), 0x101F)); }
typedef unsigned long long u64_t;
__device__ __forceinline__ void st_gran(u64_t* g, unsigned epoch, float v) { __hip_atomic_store(g, ((u64_t)epoch << 32) | (u64_t)__float_as_uint(v), __ATOMIC_RELAXED, __HIP_MEMORY_SCOPE_AGENT); }
template <int N>
__device__ __forceinline__ void recv_gran(const u64_t* g, unsigned epoch, float (&out)[N]) {
    unsigned spins = 0;
    for (;;) { bool ok = true;
#pragma unroll
        for (int k = 0; k < N; ++k) { const u64_t x = __hip_atomic_load(g + k * 512, __ATOMIC_RELAXED, __HIP_MEMORY_SCOPE_AGENT); out[k] = __uint_as_float((unsigned)x); ok = ok && ((unsigned)(x >> 32) == epoch); }
        if (ok || ++spins > (1u << 20)) break; __builtin_amdgcn_s_sleep(2); }
}
#define LDS_WAIT() asm volatile("s_waitcnt lgkmcnt(0)" ::: "memory")

__device__ __forceinline__ void mma_seg(f32x4& acc, const bf16_t* A, int lda, const bf16_t* Bt, int ldb, int tm, int tn, int ksteps, int fr, int fq) {
    const bf16_t* ap = A + (tm * 16 + fr) * lda + fq * 8; const bf16_t* bp = Bt + (tn * 16 + fr) * ldb + fq * 8;
    for (int ks = 0; ks < ksteps; ++ks) {
        const bf16x8 a = *(const bf16x8*)(ap + ks * 32); const bf16x8 b = *(const bf16x8*)(bp + ks * 32);
        acc = __builtin_amdgcn_mfma_f32_16x16x32_bf16(a, b, acc, 0, 0, 0);
    }
}
#define ZERO4 ((f32x4){0.f, 0.f, 0.f, 0.f})
__device__ __forceinline__ void st4bf(bf16_t* dst, float a, float b, float c, float d) { uint2 w; w.x = pk2(a, b); w.y = pk2(c, d); *(uint2*)dst = w; }
__device__ __forceinline__ void mma_seg_bs(f32x4& acc, const bf16_t* A, int lda, const bf16_t* Bt, int ldb, int tm, int tn, int ksteps, int fr, int fq, int g) {
    const bf16_t* ap = A + (tm * 16 + fr) * lda + fq * 8; const bf16_t* bp = Bt + (tn * 16 + fr) * ldb;
    for (int ks = 0; ks < ksteps; ++ks) {
        const bf16x8 a = *(const bf16x8*)(ap + ks * 32); const bf16x8 b = *(const bf16x8*)(bp + ((ks * 32 + fq * 8) ^ (g << 3)));
        acc = __builtin_amdgcn_mfma_f32_16x16x32_bf16(a, b, acc, 0, 0, 0);
    }
}

#define LAS __attribute__((address_space(3)))
#define XB_TMO      128
#define XB_XCNT(j)  (256  + 64 * (j))
#define XB_XSUB(j)  (1280 + 64 * (j))
#define XB_XGEN(j)  (2304 + 64 * (j))
#define XB_TOP      3328
#define XB_TOPGEN   3392
#define XCD_BAR_WORDS 3456
#define XB_SPIN_CAP (1u << 18)

__device__ __forceinline__ unsigned xb_ld(unsigned* p)              { return __hip_atomic_load(p, __ATOMIC_RELAXED, __HIP_MEMORY_SCOPE_AGENT); }
__device__ __forceinline__ unsigned xb_add(unsigned* p, unsigned v) { return __hip_atomic_fetch_add(p, v, __ATOMIC_RELAXED, __HIP_MEMORY_SCOPE_AGENT); }
__device__ __forceinline__ unsigned xb_xcc_id() { return (unsigned)__builtin_amdgcn_s_getreg((3 << 11) | 20) & 0xFu; }
#define XB_SPIN(cond, bar) do { unsigned _sp = 0; while (cond) { __builtin_amdgcn_s_sleep(1); \
    if ((++_sp & 255u) == 0u) { if (xb_ld(&(bar)[XB_TMO])) break; if (_sp > XB_SPIN_CAP) { atomicAdd(&(bar)[XB_TMO], 1u); break; } } } } while (0)

struct XcdBarrier {
    unsigned* bar; unsigned x;
    volatile LAS unsigned* st;
};

__device__ __forceinline__ XcdBarrier xcd_barrier_post(unsigned* bar, volatile LAS unsigned* st) {
    XcdBarrier b; b.bar = bar; b.x = xb_xcc_id(); b.st = st;
    if (threadIdx.x == 0) (void)xb_add(&bar[XB_XCNT(b.x)], 1u);
    return b;
}
__device__ __forceinline__ void xcd_barrier_complete(unsigned* bar, unsigned x, unsigned& nloc, unsigned& nx) {
    const unsigned G = gridDim.x * gridDim.y * gridDim.z;
    unsigned sum, cnt, mine, sp = 0u;
    for (;;) {
        sum = 0u; cnt = 0u; mine = 0u;
#pragma unroll
        for (unsigned j = 0; j < 16; ++j) { const unsigned c = xb_ld(&bar[XB_XCNT(j)]); sum += c; cnt += (c > 0u) ? 1u : 0u; mine = (j == x) ? c : mine; }
        if (sum == G) break;
        __builtin_amdgcn_s_sleep(1);
        if ((++sp & 255u) == 0u) { if (xb_ld(&bar[XB_TMO])) break; if (sp > XB_SPIN_CAP) { atomicAdd(&bar[XB_TMO], 1u); break; } }
    }
    nloc = mine > 0u ? mine : 1u; nx = cnt > 0u ? cnt : 1u;
}

__device__ __forceinline__ void xcd_barrier(const XcdBarrier& b) {
    asm volatile("s_waitcnt vmcnt(0)" ::: "memory");
    __syncthreads();
    if (threadIdx.x == 0) {
        unsigned* bar = b.bar;
        __builtin_amdgcn_s_waitcnt(0);
        unsigned nloc = b.st[0], nx = b.st[1];
        if (nloc == 0u) { xcd_barrier_complete(bar, b.x, nloc, nx); b.st[0] = nloc; b.st[1] = nx; }
        const unsigned old = xb_add(&bar[XB_XSUB(b.x)], 1u);
        const unsigned gen = old / nloc;
        if (old + 1u == (gen + 1u) * nloc) {
            __builtin_amdgcn_fence(__ATOMIC_RELEASE, "agent");
            asm volatile("s_waitcnt vmcnt(0)" ::: "memory");
            const unsigned og = xb_add(&bar[XB_TOP], 1u);
            const unsigned tg = og / nx;
            if (og + 1u == (tg + 1u) * nx) xb_add(&bar[XB_TOPGEN], 1u);
            else XB_SPIN(xb_ld(&bar[XB_TOPGEN]) == tg, bar);
            __builtin_amdgcn_fence(__ATOMIC_ACQUIRE, "agent");
            xb_add(&bar[XB_XGEN(b.x)], 1u);
            asm volatile("s_waitcnt vmcnt(0)" ::: "memory");
        } else {
            XB_SPIN(xb_ld(&bar[XB_XGEN(b.x)]) == gen, bar);
            __builtin_amdgcn_fence(__ATOMIC_ACQUIRE, "agent");
            asm volatile("s_waitcnt vmcnt(0)" ::: "memory");
        }
    }
    __syncthreads();
}

__device__ __forceinline__ void transpose_item(const float* W, int K, int N, int nlimit, bf16_t* WT, float* scr, int item, int lane) {
    const int nblk = (nlimit + 31) / 32, kb = item / nblk, nb = item % nblk, k0 = 64 * kb, n0 = 32 * nb;
    const int nn = n0 + (lane & 31); const bool ok = nn < nlimit;
#pragma unroll 8
    for (int i = 0; i < 32; ++i) { const int kk = 2 * i + (lane >> 5); scr[kk * 33 + (lane & 31)] = ok ? W[(size_t)(k0 + kk) * N + nn] : 0.f; }
    LDS_WAIT();
    const int c = lane & 7;
#pragma unroll
    for (int j = 0; j < 4; ++j) { const int n = (lane >> 3) + 8 * j; const float* s = scr + (8 * c) * 33 + n;
        uint4 o; o.x = pk2(s[0 * 33], s[1 * 33]); o.y = pk2(s[2 * 33], s[3 * 33]); o.z = pk2(s[4 * 33], s[5 * 33]); o.w = pk2(s[6 * 33], s[7 * 33]);
        if (n0 + n < nlimit) *(uint4*)(WT + (size_t)(n0 + n) * K + k0 + 8 * c) = o; }
    LDS_WAIT();
}

__device__ __forceinline__ void prep_phase(const Prm& p, unsigned char* lds, int tid, int G) {
    const int wave = tid >> 6, lane = tid & 63, bid = blockIdx.x;
    unsigned char* ws = p.ws;
    for (int it = bid; it < 448; it += G) {
        if (it < 192) {
            const int l = it / 96, j0 = (it % 96) * 64;
            float* SIL = (float*)lds; float* RED = SIL + 5 * 1024;
            for (int e = tid; e < 5120; e += 512) { const float cv = e < 4096 ? p.in[1][e] : p.in[3][e - 4096]; SIL[e] = cv / (1.f + expf(-cv)); }
            __syncthreads();
            float a0 = 0.f, a1 = 0.f, a2 = 0.f, a3 = 0.f, a4 = 0.f;
            const float* wm = p.in[6] + ((size_t)l * 1024 + wave * 128) * 6144 + j0 + lane;
#pragma unroll 8
            for (int k = 0; k < 128; ++k) { const float w = wm[(size_t)k * 6144]; const int kk = wave * 128 + k;
                a0 += SIL[kk] * w; a1 += SIL[1024 + kk] * w; a2 += SIL[2048 + kk] * w; a3 += SIL[3072 + kk] * w; a4 += SIL[4096 + kk] * w; }
            RED[(wave * 5 + 0) * 64 + lane] = a0; RED[(wave * 5 + 1) * 64 + lane] = a1; RED[(wave * 5 + 2) * 64 + lane] = a2; RED[(wave * 5 + 3) * 64 + lane] = a3; RED[(wave * 5 + 4) * 64 + lane] = a4;
            __syncthreads();
            if (tid < 320) { const int bb = tid >> 6, ln = tid & 63; float s = p.in[7][l * 6144 + j0 + ln];
                for (int w = 0; w < 8; ++w) s += RED[(w * 5 + bb) * 64 + ln];
                ((float*)(ws + WS_MOD))[(l * 5 + bb) * 6144 + j0 + ln] = s; }
            __syncthreads();
        } else {
            const int f = it - 192; const int l = f >> 7, g = (f >> 5) & 3, part = (f >> 4) & 1, kc = f & 15;
            float* PP = (float*)lds; float* WCH = PP + 64 * 65; float* WF = WCH + 64 * 65; float* TB = WF + 64 * 65;
            for (int e = tid; e < 4096; e += 512) { const int r = e >> 6, c = e & 63;
                WF[r * 65 + c] = p.in[25][((size_t)(l * 4 + g) * 64 + r) * 64 + c];
                WCH[r * 65 + c] = p.in[8][((size_t)l * 1024 + kc * 64 + r) * WIN_N + NPLAIN + g * 64 + c]; }
            if (tid < 64) { float s, c; sincospif((float)tid / 32.f, &s, &c); TB[tid] = 0.125f * (part ? -s : c); }
            __syncthreads();
            { const int c = tid >> 3, d0 = (tid & 7) * 8; float acc[8];
#pragma unroll
              for (int e = 0; e < 8; ++e) acc[e] = 0.f;
              for (int c2 = 0; c2 < 64; ++c2) { const float tb = TB[(c * c2) & 63];
#pragma unroll
                  for (int e = 0; e < 8; ++e) acc[e] += tb * WF[c2 * 65 + d0 + e]; }
#pragma unroll
              for (int e = 0; e < 8; ++e) PP[c * 65 + d0 + e] = acc[e]; }
            __syncthreads();
            { const int d = tid >> 3, ko = tid & 7; float acc[8];
#pragma unroll
              for (int e = 0; e < 8; ++e) acc[e] = 0.f;
              for (int c = 0; c < 64; ++c) { const float pv = PP[c * 65 + d];
#pragma unroll
                  for (int e = 0; e < 8; ++e) acc[e] += WCH[(ko * 8 + e) * 65 + c] * pv; }
              bf16_t* wt = (bf16_t*)(ws + WS_WIN) + ((size_t)l * LDU + C_FZ + part * 256 + g * 64 + d) * 1024 + kc * 64 + ko * 8;
              *(uint4*)wt = pack8(acc); }
            __syncthreads();
        }
    }
    { const int gt = bid * 512 + tid, NG = G * 512; const uint4 z = {0u, 0u, 0u, 0u};
      for (int e = gt; e < 2 * 112 * 128; e += NG) { const int l = e / (112 * 128), r = e % (112 * 128);
          *(uint4*)((bf16_t*)(ws + WS_WIN) + ((size_t)l * LDU + 3472) * 1024 + (size_t)r * 8) = z; } }
    if (bid == 0) { const uint4 z = {0u, 0u, 0u, 0u}; for (int e = tid; e < 16384 / 16; e += 512) *(uint4*)(ws + WS_BARW + (size_t)e * 16) = z; }
    { const int gt = bid * 512 + tid, NG = G * 512; const uint4 z = {0u, 0u, 0u, 0u};
      for (int e = gt; e < (int)((WS_END2 - WS_SBR) / 16); e += NG) *(uint4*)(ws + WS_SBR + (size_t)e * 16) = z; }
    float* scr = (float*)(lds + wave * 8448);
    const int gw = bid * 8 + wave, NGW = G * 8;
    for (int it = gw; it < 2 * 6096; it += NGW) {
        const int l = it / 6096; int r = it % 6096;
        if (r < 1488) { transpose_item(p.in[8] + (size_t)l * 1024 * WIN_N, 1024, WIN_N, NPLAIN, (bf16_t*)(ws + WS_WIN) + (size_t)l * LDU * 1024, scr, r, lane); continue; } r -= 1488;
        if (r < 512) { transpose_item(p.in[9] + (size_t)l * 1024 * 1024, 1024, 1024, 1024, (bf16_t*)(ws + WS_WOUT) + (size_t)l * 1024 * 1024, scr, r, lane); continue; } r -= 512;
        if (r < 2048) { transpose_item(p.in[26] + (size_t)l * 1024 * 4096, 1024, 4096, 4096, (bf16_t*)(ws + WS_W1) + (size_t)l * 4096 * 1024, scr, r, lane); continue; } r -= 2048;
        transpose_item(p.in[27] + (size_t)l * 4096 * 1024, 4096, 1024, 1024, (bf16_t*)(ws + WS_W2) + (size_t)l * 1024 * 4096, scr, r, lane);
    }
    __syncthreads();
}

__device__ __forceinline__ void norm_phase(const Prm& p, int l, int mode, int tid, int G) {
    const int wave = tid >> 6, lane = tid & 63; const int gw = blockIdx.x * 8 + wave, NGW = G * 8;
    const int nrows = (mode == 2 || (mode == 1 && l == 1)) ? ML : M;
    const float* gvec = mode == 2 ? p.in[28] : (mode == 1 ? p.in[5] + l * 1024 : p.in[4] + l * 1024);
    const float* modb = (const float*)(p.ws + WS_MOD) + (size_t)l * 5 * 6144;
    bf16_t* HN = (bf16_t*)(p.ws + WS_HN);
    const bool first = (l == 0 && mode == 0);
    for (int row = gw; row < nrows; row += NGW) {
        const bool lat = row < ML; const int bb = lat ? (row >> 13) : 4;
        const float* src = lat ? ((first ? p.in[0] : p.out) + (size_t)row * 1024) : ((first ? p.in[2] : (const float*)(p.ws + WS_XC)) + (size_t)(row - ML) * 1024);
        f32x4 v[4]; float ss = 0.f;
#pragma unroll
        for (int j = 0; j < 4; ++j) { v[j] = *(const f32x4*)(src + j * 256 + lane * 4); ss += (v[j][0] * v[j][0] + v[j][1] * v[j][1]) + (v[j][2] * v[j][2] + v[j][3] * v[j][3]); }
        const float rinv = rsqrtf(wave_sum(ss) * (1.f / 1024.f) + 1e-6f);
        if (mode == 2) {
#pragma unroll
            for (int j = 0; j < 4; ++j) { const f32x4 g = *(const f32x4*)(gvec + j * 256 + lane * 4); *(f32x4*)(p.out + (size_t)row * 1024 + j * 256 + lane * 4) = v[j] * rinv * g; }
        } else {
            const float* sh = modb + bb * 6144 + (mode ? 3 : 0) * 1024; const float* sc = modb + bb * 6144 + (mode ? 4 : 1) * 1024;
#pragma unroll
            for (int j = 0; j < 4; ++j) { const int c = j * 256 + lane * 4; const f32x4 g = *(const f32x4*)(gvec + c), s1 = *(const f32x4*)(sh + c), s2 = *(const f32x4*)(sc + c);
                const f32x4 y = (v[j] * rinv * g) * (s2 + 1.f) + s1;
                uint2 o; o.x = pk2(y[0], y[1]); o.y = pk2(y[2], y[3]); *(uint2*)(HN + (size_t)row * 1024 + c) = o; }
        }
    }
}

__device__ __forceinline__ void lerp8(const bf16_t* U, size_t row, int col, bool isctx, int t, const float* mu, float* out) {
    const bf16_t* bp = U + row * LDU + col;
    const uint4 own = *(const uint4*)bp; const uint4 z = {0u, 0u, 0u, 0u};
    uint4 n0, n1, n2, n3;
    if (isctx) { n0 = (t > 0) ? *(const uint4*)(bp - LDU) : z; n1 = (t < TC - 1) ? *(const uint4*)(bp + LDU) : z; n2 = n0; n3 = n1; }
    else { const int gx = t & 63, gy = t >> 6;
        n0 = (gx > 0) ? *(const uint4*)(bp - LDU) : z; n1 = (gx < 63) ? *(const uint4*)(bp + LDU) : z;
        n2 = (gy > 0) ? *(const uint4*)(bp - 64 * LDU) : z; n3 = (gy < 127) ? *(const uint4*)(bp + 64 * LDU) : z; }
#pragma unroll
    for (int e = 0; e < 8; ++e) { const float o = bfe(own, e); const float nb = (e & 3) == 0 ? bfe(n0, e) : (e & 3) == 1 ? bfe(n1, e) : (e & 3) == 2 ? bfe(n2, e) : bfe(n3, e);
        out[e] = o + mu[e] * (nb - o); }
}

__device__ __forceinline__ void lerp8_load(const bf16_t* U, size_t row, int col, bool isctx, int t, uint4 (&r)[5]) {
    const bf16_t* bp = U + row * LDU + col; const uint4 z = {0u, 0u, 0u, 0u};
    r[0] = *(const uint4*)bp;
    if (isctx) { r[1] = (t > 0) ? *(const uint4*)(bp - LDU) : z; r[2] = (t < TC - 1) ? *(const uint4*)(bp + LDU) : z; r[3] = r[1]; r[4] = r[2]; }
    else { const int gx = t & 63, gy = t >> 6;
        r[1] = (gx > 0) ? *(const uint4*)(bp - LDU) : z; r[2] = (gx < 63) ? *(const uint4*)(bp + LDU) : z;
        r[3] = (gy > 0) ? *(const uint4*)(bp - 64 * LDU) : z; r[4] = (gy < 127) ? *(const uint4*)(bp + 64 * LDU) : z; }
}
__device__ __forceinline__ void lerp8_apply(const uint4 (&r)[5], const float* mu, float* out) {
#pragma unroll
    for (int e = 0; e < 8; ++e) { const float o = bfe(r[0], e); const float nb = (e & 3) == 0 ? bfe(r[1], e) : (e & 3) == 1 ? bfe(r[2], e) : (e & 3) == 2 ? bfe(r[3], e) : bfe(r[4], e);
        out[e] = o + mu[e] * (nb - o); }
}
__device__ __forceinline__ void chunk_coords(int c, int b, int d, int n, bool& isctx, int& t0, size_t& rowbase) {
    isctx = c < 4; const int cc = isctx ? c : c - 4; const int nch = isctx ? 4 : 128;
    t0 = (d ? (nch - 1 - cc) : cc) * 64; rowbase = isctx ? (size_t)(ML + b * TC + t0) : (size_t)(b * T + t0); (void)n;
}
__device__ __forceinline__ void gdn_raw_load(const bf16_t* U, int b, int h, int d, int c, int tid, uint4 (&rv)[7]) {
    const bool isctx = c < 4; const int cc = isctx ? c : c - 4; const int nch = isctx ? 4 : 128; const int slen = isctx ? TC : T;
    const int t0 = (d ? (nch - 1 - cc) : cc) * 64; const size_t seqbase = isctx ? (size_t)(ML + b * TC) : (size_t)(b * T);
#pragma unroll
    for (int it = 0; it < 7; ++it) { const int pc = tid + it * 512; const int rr = pc / 48, pi = pc % 48; const int tt = t0 - 2 + rr;
        const int col = pi < 16 ? C_GQ + h * 128 + pi * 8 : pi < 32 ? C_GK + h * 128 + (pi - 16) * 8 : C_GV + h * 128 + (pi - 32) * 8;
        rv[it] = (uint4){0u, 0u, 0u, 0u}; if (pc < 68 * 48 && tt >= 0 && tt < slen) rv[it] = *(const uint4*)(U + (seqbase + tt) * LDU + col); }
}

template <int MODE>
__device__ __forceinline__ void trinv64(const bf16_t* LA, const float* LD, bf16_t* TA, int ldt, bf16_t* TT, bf16_t* WT, bf16_t* T1, bf16_t* T2, const float* s1, const float* s2, int tid, int wave, int fr, int fq) {
    if (wave == 0) { const int bi = (tid & 63) >> 4, cc = tid & 15; const float* A = LD + bi * 256; float dcol[16];
#pragma unroll
        for (int r = 0; r < 16; ++r) { float v = (r == cc) ? 1.f : 0.f;
#pragma unroll
            for (int j = 0; j < r; ++j) v -= A[r * 16 + j] * dcol[j];
            dcol[r] = v; }
#pragma unroll
        for (int r = 0; r < 16; ++r) { const int R = bi * 16 + r, Cc = bi * 16 + cc; const bf16_t bv = f2bf(dcol[r]); TA[R * ldt + Cc] = bv; TT[Cc * 72 + R] = bv;
            if (MODE == 1) T1[R * 72 + Cc] = f2bf(dcol[r] * s1[Cc]); }
    } else { for (int e = tid - 64; e < 4096; e += 448) { const int r = e >> 6, c = e & 63; if ((r >> 4) != (c >> 4)) TT[r * 72 + c] = 0; WT[r * 72 + c] = 0; } }
    __syncthreads();
    if (wave < 2) { const int tm = 2 * wave + 1, tn = 2 * wave, ko = 32 * wave, r0 = tm * 16 + fq * 4, c = tn * 16 + fr;
        f32x4 acc = ZERO4; mma_seg(acc, LA + ko, 72, TT + ko, 72, tm, tn, 1, fr, fq);
#pragma unroll
        for (int j = 0; j < 4; ++j) WT[c * 72 + r0 + j] = f2bf(acc[j]); }
    __syncthreads();
    if (wave < 2) { const int tm = 2 * wave + 1, tn = 2 * wave, ko = 32 * wave, r0 = tm * 16 + fq * 4, c = tn * 16 + fr;
        f32x4 acc = ZERO4; mma_seg(acc, TA + ko, ldt, WT + ko, 72, tm, tn, 1, fr, fq);
#pragma unroll
        for (int j = 0; j < 4; ++j) { const float v = -acc[j]; const bf16_t bv = f2bf(v); TA[(r0 + j) * ldt + c] = bv; TT[c * 72 + r0 + j] = bv;
            if (MODE == 1) T1[(r0 + j) * 72 + c] = f2bf(v * s1[c]); } }
    __syncthreads();
    if (wave < 4) { const int tm = 2 + (wave >> 1), tn = wave & 1, r0 = tm * 16 + fq * 4, c = tn * 16 + fr;
        f32x4 acc = ZERO4; mma_seg(acc, LA, 72, TT, 72, tm, tn, 1, fr, fq);
#pragma unroll
        for (int j = 0; j < 4; ++j) WT[c * 72 + r0 + j] = f2bf(acc[j]); }
    __syncthreads();
    if (wave < 4) { const int tm = 2 + (wave >> 1), tn = wave & 1, r0 = tm * 16 + fq * 4, c = tn * 16 + fr;
        f32x4 acc = ZERO4; mma_seg(acc, TA + 32, ldt, WT + 32, 72, tm, tn, 1, fr, fq);
#pragma unroll
        for (int j = 0; j < 4; ++j) { const float v = -acc[j]; TA[(r0 + j) * ldt + c] = f2bf(v);
            if (MODE == 1) T1[(r0 + j) * 72 + c] = f2bf(v * s1[c]); } }
    __syncthreads();
}
__device__ __forceinline__ void rwkv_scan(const Prm& p, int l, int sid, int kblk, int nblk, unsigned char* lds, int tid) {
    const int b = sid >> 3, h = (sid >> 1) & 3, d = sid & 1;
    const int wave = tid >> 6, lane = tid & 63, fr = lane & 15, fq = lane >> 4;
    bf16_t* TL = (bf16_t*)lds;
#define RTILE(i) (TL + (i) * 4608)
    bf16_t *S0bf = RTILE(0), *KT = RTILE(1), *BTl = RTILE(2), *KL = RTILE(3), *KTt = RTILE(4), *RT = RTILE(5), *VT = RTILE(6), *BS = RTILE(7),
           *LK = RTILE(9), *MB = RTILE(10), *MK = RTILE(11), *LA = RTILE(14), *TT = RTILE(1), *WT = RTILE(2),
           *TW = RTILE(12), *X1T = RTILE(1), *PT = RTILE(2);
    float* XW = (float*)RTILE(9); float* XAf = XW + 64 * 65; bf16_t* TWD = (bf16_t*)(XAf + 64 * 65); bf16_t* ADl = TWD + 64 * 40;
    unsigned char* cb = lds + 15 * 9216;
    bf16_t* WUPt = (bf16_t*)cb; bf16_t* AUPt = WUPt + 64 * 40; float* CV = (float*)(cb + 10240); float* GL = CV + 320; float* SEG = GL + 64; float* LD = SEG + 512;
#undef RTILE
    const bf16_t* U = (const bf16_t*)(p.ws + WS_U);
    bf16_t* ORp = (bf16_t*)(p.ws + WS_OR); float* BC = (float*)(p.ws + WS_BC);
    const int n = tid >> 3, jq = tid & 7, j0 = jq * 8; const int i = d ? 63 - n : n;
    for (int e = tid; e < 2048; e += 512) { const int q = e >> 6, j = e & 63;
        WUPt[j * 40 + q] = f2bf(p.in[12][((size_t)(l * 2 + d) * 32 + q) * 256 + h * 64 + j]);
        AUPt[j * 40 + q] = f2bf(p.in[14][((size_t)(l * 2 + d) * 32 + q) * 256 + h * 64 + j]); }
    if (tid < 64) { CV[tid] = p.in[11][(l * 2 + d) * 256 + h * 64 + tid]; CV[64 + tid] = p.in[13][(l * 2 + d) * 256 + h * 64 + tid];
        CV[128 + tid] = p.in[16][l * 256 + h * 64 + tid]; CV[192 + tid] = p.in[17][l * 256 + h * 64 + tid]; CV[256 + tid] = p.in[18][l * 256 + h * 64 + tid]; }
    f32x4 accS[2]; accS[0] = ZERO4; accS[1] = ZERO4;
    u64_t* SB = (u64_t*)(p.ws + WS_SBR) + (size_t)sid * 2 * 4096; const unsigned fbase = (unsigned)l * 132u;
    float r8[8], k8[8], v8[8], x8[8];
    { const int n0_ = tid >> 3, j00 = (tid & 7) * 8; bool ic; int t0_; size_t rb_; chunk_coords(kblk, b, d, n0_, ic, t0_, rb_);
      uint4 q0[5], q1[5], q2[5], q3[5];
      lerp8_load(U, rb_ + n0_, h * 64 + j00, ic, t0_ + n0_, q0); lerp8_load(U, rb_ + n0_, 256 + h * 64 + j00, ic, t0_ + n0_, q1);
      lerp8_load(U, rb_ + n0_, 512 + h * 64 + j00, ic, t0_ + n0_, q2); lerp8_load(U, rb_ + n0_, 768 + j00, ic, t0_ + n0_, q3);
      float m0[8], m1[8], m2[8], m3[8]; const float* mup = p.in[10] + l * 896 + j00;
#pragma unroll
      for (int e = 0; e < 8; ++e) { m0[e] = mup[h * 64 + e]; m1[e] = mup[256 + h * 64 + e]; m2[e] = mup[512 + h * 64 + e]; m3[e] = mup[768 + e]; }
      lerp8_apply(q0, m0, r8); lerp8_apply(q1, m1, k8); lerp8_apply(q2, m2, v8); lerp8_apply(q3, m3, x8); }
    __syncthreads();
    for (int c = kblk; c < 132; c += nblk) {
        int tid2 = threadIdx.x; asm volatile("" : "+v"(tid2)); const int tid = tid2;
        const int wave = tid2 >> 6, lane = tid2 & 63, fr = tid2 & 15, fq = (tid2 >> 4) & 3, n = tid2 >> 3, jq = tid2 & 7;
        const int j0 = jq * 8; const int i = d ? 63 - n : n;
        const bool isctx = c < 4; const int cc = isctx ? c : c - 4; const int nch = isctx ? 4 : 128;
        const int t0 = (d ? (nch - 1 - cc) : cc) * 64;
        const size_t rowbase = isctx ? (size_t)(ML + b * TC + t0) : (size_t)(b * T + t0);
        const int t = t0 + n; const size_t row = rowbase + n;
        if (jq < 4) {
#pragma unroll
            for (int e = 0; e < 8; ++e) TWD[i * 40 + j0 + e] = f2bf(ftanh(x8[e]));
        } else {
#pragma unroll
            for (int e = 0; e < 8; ++e) ADl[i * 40 + j0 - 32 + e] = f2bf(x8[e]);
        }
        __syncthreads();
#pragma unroll
        for (int q = 0; q < 2; ++q) { const int tile = wave + 8 * q, tm = tile >> 2, tn = tile & 3, r0 = tm * 16 + fq * 4, cc2 = tn * 16 + fr;
            f32x4 a1 = ZERO4, a2 = ZERO4; mma_seg(a1, TWD, 40, WUPt, 40, tm, tn, 1, fr, fq); mma_seg(a2, ADl, 40, AUPt, 40, tm, tn, 1, fr, fq);
#pragma unroll
            for (int j = 0; j < 4; ++j) { XW[(r0 + j) * 65 + cc2] = a1[j]; XAf[(r0 + j) * 65 + cc2] = a2[j]; } }
        __syncthreads();
        float a8[8], kd8[8], kk8[8]; float ss = 0.f, bcp = 0.f;
#pragma unroll
        for (int e = 0; e < 8; ++e) { const int j = j0 + e; const float xw = XW[i * 65 + j] + CV[j], xa = XAf[i * 65 + j] + CV[64 + j];
            const float a = sigmoidf_(xa); const float wl = -softplusf_(-xw) - 0.5f; const float lw = -fexp(wl);
            const float kd = k8[e] * (1.f + (a - 1.f) * CV[192 + j]); const float kkr = k8[e] * CV[128 + j];
            ss += kkr * kkr; bcp += r8[e] * kd * CV[256 + j]; a8[e] = a; kd8[e] = kd; kk8[e] = kkr; XW[i * 65 + j] = lw; }
        ss += shx1(ss); ss += shx2(ss); ss += shx4(ss);
        bcp += shx1(bcp); bcp += shx2(bcp); bcp += shx4(bcp);
        { const float rn = rsqrtf(ss + 1e-12f);
#pragma unroll
          for (int e = 0; e < 8; ++e) kk8[e] *= rn; }
        if (jq == 0) BC[((size_t)d * M + row) * 4 + h] = bcp;
        __syncthreads();
        { const int sg = tid >> 6, j = tid & 63; float s = 0.f;
#pragma unroll
          for (int ii = 0; ii < 8; ++ii) s += XW[(sg * 8 + ii) * 65 + j];
          SEG[sg * 64 + j] = s;
          __syncthreads();
          float pre = 0.f; for (int s2 = 0; s2 < sg; ++s2) pre += SEG[s2 * 64 + j];
#pragma unroll
          for (int ii = 0; ii < 8; ++ii) { pre += XW[(sg * 8 + ii) * 65 + j]; XW[(sg * 8 + ii) * 65 + j] = pre; } }
        __syncthreads();
        { float o_kt[8], o_bt[8], o_kl[8], o_rt[8];
#pragma unroll
          for (int e = 0; e < 8; ++e) { const int j = j0 + e; const float lwi = XW[i * 65 + j], lwm = i > 0 ? XW[(i - 1) * 65 + j] : 0.f, lwl = XW[63 * 65 + j];
              const float em = fexp(lwm), ei = fexp(lwi), eni = fexp(-lwi), el = fexp(lwl - lwi); const float b_ = kk8[e] * a8[e];
              o_kt[e] = kk8[e] * em; o_bt[e] = b_ * eni; o_kl[e] = kd8[e] * eni; o_rt[e] = r8[e] * ei;
              KTt[j * 72 + i] = f2bf(o_kt[e]); BS[j * 136 + i] = f2bf(b_ * el); BS[j * 136 + 64 + i] = f2bf(kd8[e] * el); VT[j * 72 + i] = f2bf(v8[e]);
              if (i == 63) GL[j] = ei; }
          *(uint4*)(KT + i * 72 + j0) = pack8(o_kt); *(uint4*)(BTl + i * 72 + j0) = pack8(o_bt); *(uint4*)(KL + i * 72 + j0) = pack8(o_kl); *(uint4*)(RT + i * 72 + j0) = pack8(o_rt); }
        __syncthreads();
        const int cn = c + nblk; const bool have_next = cn < 132;
        uint4 pq0[5], pq1[5], pq2[5], pq3[5];
        if (have_next) { bool ic; int t0n; size_t rbn; chunk_coords(cn, b, d, n, ic, t0n, rbn);
            lerp8_load(U, rbn + n, h * 64 + j0, ic, t0n + n, pq0); lerp8_load(U, rbn + n, 256 + h * 64 + j0, ic, t0n + n, pq1);
            lerp8_load(U, rbn + n, 512 + h * 64 + j0, ic, t0n + n, pq2); lerp8_load(U, rbn + n, 768 + j0, ic, t0n + n, pq3); }
        { const uint4 z4 = {0u, 0u, 0u, 0u}; *(uint4*)(TW + (tid >> 3) * 136 + (tid & 7) * 8) = z4; }
#pragma unroll
        for (int q = 0; q < 2; ++q) { const int tile = wave + 8 * q, tm = tile >> 2, tn = tile & 3, r0 = tm * 16 + fq * 4, cx = tn * 16 + fr;
            f32x4 a1 = ZERO4, a2 = ZERO4, a3 = ZERO4, a4 = ZERO4;
            { const int ao = (tm * 16 + fr) * 72 + fq * 8, bo = (tn * 16 + fr) * 72 + fq * 8;
#pragma unroll
              for (int ks = 0; ks < 2; ++ks) { const bf16x8 fk = *(const bf16x8*)(KT + ao + ks * 32), fr_ = *(const bf16x8*)(RT + ao + ks * 32), fb = *(const bf16x8*)(BTl + bo + ks * 32), fl = *(const bf16x8*)(KL + bo + ks * 32);
                  a1 = __builtin_amdgcn_mfma_f32_16x16x32_bf16(fk, fb, a1, 0, 0, 0); a2 = __builtin_amdgcn_mfma_f32_16x16x32_bf16(fk, fl, a2, 0, 0, 0);
                  a3 = __builtin_amdgcn_mfma_f32_16x16x32_bf16(fr_, fb, a3, 0, 0, 0); a4 = __builtin_amdgcn_mfma_f32_16x16x32_bf16(fr_, fl, a4, 0, 0, 0); } }
#pragma unroll
            for (int j = 0; j < 4; ++j) { const int r = r0 + j; const float x0 = (cx < r) ? a1[j] : 0.f;
                LA[r * 72 + cx] = f2bf(x0); if (tm == tn) LD[tm * 256 + (r & 15) * 16 + (cx & 15)] = x0;
                LK[r * 72 + cx] = f2bf(cx < r ? a2[j] : 0.f); MB[r * 72 + cx] = f2bf(cx <= r ? a3[j] : 0.f); MK[r * 72 + cx] = f2bf(cx <= r ? a4[j] : 0.f); } }
        __syncthreads();
        trinv64<0>(LA, LD, TW, 136, TT, WT, nullptr, nullptr, nullptr, nullptr, tid, wave, fr, fq);
        f32x4 accO[2];
#pragma unroll
        for (int q = 0; q < 2; ++q) { const int tile = wave + 8 * q, tm = tile >> 2, tn = tile & 3, r0 = tm * 16 + fq * 4, cx = tn * 16 + fr;
            f32x4 a1 = ZERO4, a2 = ZERO4; mma_seg(a1, TW, 136, KTt, 72, tm, tn, 2, fr, fq); mma_seg(a2, LK, 72, VT, 72, tm, tn, 2, fr, fq);
#pragma unroll
            for (int j = 0; j < 4; ++j) TW[(r0 + j) * 136 + 64 + cx] = f2bf(a1[j]);
            st4bf(X1T + cx * 72 + r0, a2[0], a2[1], a2[2], a2[3]);
            accO[q] = ZERO4; mma_seg(accO[q], MK, 72, VT, 72, tm, tn, 2, fr, fq); }
        if (have_next) { float m0[8], m1[8], m2[8], m3[8]; const float* mup = p.in[10] + l * 896 + j0;
#pragma unroll
            for (int e = 0; e < 8; ++e) { m0[e] = mup[h * 64 + e]; m1[e] = mup[256 + h * 64 + e]; m2[e] = mup[512 + h * 64 + e]; m3[e] = mup[768 + e]; }
            lerp8_apply(pq0, m0, r8); lerp8_apply(pq1, m1, k8); lerp8_apply(pq2, m2, v8); lerp8_apply(pq3, m3, x8); }
        if (c > 0) { float sv[8]; recv_gran<8>(SB + (c & 1) * 4096 + tid, fbase + (unsigned)c, sv);
#pragma unroll
            for (int q = 0; q < 2; ++q)
#pragma unroll
                for (int j = 0; j < 4; ++j) accS[q][j] = sv[q * 4 + j];
        } else { accS[0] = ZERO4; accS[1] = ZERO4; }
#pragma unroll
        for (int q = 0; q < 2; ++q) { const int tile = wave + 8 * q, tm = tile >> 2, tn = tile & 3;
#pragma unroll
            for (int j = 0; j < 4; ++j) S0bf[(tm * 16 + fq * 4 + j) * 72 + tn * 16 + fr] = f2bf(accS[q][j]); }
        __syncthreads();
#pragma unroll
        for (int q = 0; q < 2; ++q) { const int tile = wave + 8 * q, tm = tile >> 2, tn = tile & 3, r0 = tm * 16 + fq * 4, cx = tn * 16 + fr;
            f32x4 a1 = ZERO4; mma_seg(a1, TW, 136, X1T, 72, tm, tn, 2, fr, fq); mma_seg(a1, TW + 64, 136, S0bf, 72, tm, tn, 2, fr, fq);
            st4bf(PT + cx * 72 + r0, -a1[0], -a1[1], -a1[2], -a1[3]); }
        __syncthreads();
        { u64_t* sbn = SB + ((c + 1) & 1) * 4096; const unsigned ep = fbase + (unsigned)c + 1u;
#pragma unroll
          for (int q = 0; q < 2; ++q) { const int tile = wave + 8 * q, tm = tile >> 2, tn = tile & 3, cx = tn * 16 + fr;
              const float g = GL[cx]; accS[q] = accS[q] * g;
              mma_seg(accS[q], PT, 72, BS, 136, tm, tn, 2, fr, fq); mma_seg(accS[q], VT, 72, BS + 64, 136, tm, tn, 2, fr, fq);
#pragma unroll
              for (int j = 0; j < 4; ++j) st_gran(sbn + (q * 4 + j) * 512 + tid, ep, accS[q][j]); } }
#pragma unroll
        for (int q = 0; q < 2; ++q) { const int tile = wave + 8 * q, tm = tile >> 2, tn = tile & 3, r0 = tm * 16 + fq * 4, cx = tn * 16 + fr;
            mma_seg(accO[q], RT, 72, S0bf, 72, tm, tn, 2, fr, fq); mma_seg(accO[q], MB, 72, PT, 72, tm, tn, 2, fr, fq);
#pragma unroll
            for (int j = 0; j < 4; ++j) { const int tt = r0 + j; const int nn = d ? 63 - tt : tt;
                ORp[((size_t)d * M + rowbase + nn) * 256 + h * 64 + cx] = f2bf(accO[q][j]); } }
        __syncthreads();
    }
}

__device__ __forceinline__ void gdn_scan(const Prm& p, int l, int sid, int kblk, int nblk, unsigned char* lds, int tid) {
    const int b = sid >> 3, h = (sid >> 1) & 3, d = sid & 1;
    bf16_t* STbf = (bf16_t*)lds; bf16_t* Qn = (bf16_t*)(lds + 17408); bf16_t* KNt = (bf16_t*)(lds + 34816); bf16_t* VT = (bf16_t*)(lds + 53248); bf16_t* QKd = (bf16_t*)(lds + 71680);
    bf16_t* XP = (bf16_t*)(lds + 80896);
    bf16_t *LA = XP, *TT = XP + 4608, *WT = XP + 2 * 4608, *TA = XP + 3 * 4608, *T1 = XP + 4 * 4608;
    bf16_t *VNt = LA, *VNs = TT, *RAW = QKd;
    bf16_t* KN = (bf16_t*)(lds + 126976); bf16_t* Wm = KN;
    float* GLs = (float*)(lds + 144384); float* GC = GLs + 64; float* BETA = GC + 64; float* SC1 = BETA + 64; float* CW = SC1 + 64; float* LD = CW + 1920;
    const bf16_t* U = (const bf16_t*)(p.ws + WS_U); bf16_t* OGp = (bf16_t*)(p.ws + WS_OG);
    for (int e = tid; e < 1920; e += 512) { const int tap = e / 384, cc = e % 384;
        const int ch = cc < 128 ? h * 128 + cc : cc < 256 ? 512 + h * 128 + (cc - 128) : 1024 + h * 128 + (cc - 256);
        CW[e] = p.in[21][((size_t)l * 5 + tap) * 1536 + ch]; }
    const float a_exp = fexp(p.in[22][(l * 2 + d) * 4 + h]); const float dtb = p.in[23][(l * 2 + d) * 4 + h];
    f32x4 accS[8];
#pragma unroll
    for (int q = 0; q < 8; ++q) accS[q] = ZERO4;
    u64_t* SB = (u64_t*)(p.ws + WS_SBG) + (size_t)sid * 2 * 16384; const unsigned fbase = (unsigned)l * 132u;
    uint4 rv[7]; gdn_raw_load(U, b, h, d, kblk, tid, rv);
    __syncthreads();
    for (int c = kblk; c < 132; c += nblk) {
        int tid2 = threadIdx.x; asm volatile("" : "+v"(tid2)); const int tid = tid2;
        const int wave = tid2 >> 6, lane = tid2 & 63, fr = tid2 & 15, fq = (tid2 >> 4) & 3, n = tid2 >> 3, jq = tid2 & 7;
        const int i = d ? 63 - n : n;
        const bool isctx = c < 4; const int cc = isctx ? c : c - 4; const int nch = isctx ? 4 : 128; const int slen = isctx ? TC : T;
        const int t0 = (d ? (nch - 1 - cc) : cc) * 64;
        const size_t seqbase = isctx ? (size_t)(ML + b * TC) : (size_t)(b * T);
        const size_t rowbase = seqbase + t0;
#pragma unroll
        for (int it = 0; it < 7; ++it) { const int pc = tid + it * 512; const int rr = pc / 48, pi = pc % 48; if (pc < 68 * 48) *(uint4*)(RAW + rr * 392 + pi * 8) = rv[it]; }
        __syncthreads();
        { float qv[16];
          const bf16_t* up = U + (rowbase + n) * LDU + C_GS; const float beta_n = sigmoidf_(bf2f(up[d * 4 + h]));
#pragma unroll
          for (int e = 0; e < 16; ++e) qv[e] = 0.f;
#pragma unroll
          for (int tap = 0; tap < 5; ++tap) { const uint4 r0 = *(const uint4*)(RAW + (n + tap) * 392 + jq * 16), r1 = *(const uint4*)(RAW + (n + tap) * 392 + jq * 16 + 8);
              const float* cw = CW + tap * 384 + jq * 16;
#pragma unroll
              for (int e = 0; e < 8; ++e) { qv[e] += cw[e] * bfe(r0, e); qv[8 + e] += cw[8 + e] * bfe(r1, e); } }
          float sq = 0.f;
#pragma unroll
          for (int e = 0; e < 16; ++e) { const float a = siluf_(qv[e]); qv[e] = a; sq += a * a; }
          sq += shx1(sq); sq += shx2(sq); sq += shx4(sq);
          { const float rq = rsqrtf(sq + 1e-6f) * 0.08838834764831845f;
#pragma unroll
            for (int e = 0; e < 16; ++e) qv[e] *= rq; }
          *(uint4*)(Qn + i * 136 + jq * 16) = pack8(qv); *(uint4*)(Qn + i * 136 + jq * 16 + 8) = pack8(qv + 8);
          __builtin_amdgcn_sched_barrier(0);
#pragma unroll
          for (int e = 0; e < 16; ++e) qv[e] = 0.f;
#pragma unroll
          for (int tap = 0; tap < 5; ++tap) { const uint4 r0 = *(const uint4*)(RAW + (n + tap) * 392 + 128 + jq * 16), r1 = *(const uint4*)(RAW + (n + tap) * 392 + 128 + jq * 16 + 8);
              const float* cw = CW + tap * 384 + 128 + jq * 16;
#pragma unroll
              for (int e = 0; e < 8; ++e) { qv[e] += cw[e] * bfe(r0, e); qv[8 + e] += cw[8 + e] * bfe(r1, e); } }
          float sk = 0.f;
#pragma unroll
          for (int e = 0; e < 16; ++e) { const float a = siluf_(qv[e]); qv[e] = a; sk += a * a; }
          sk += shx1(sk); sk += shx2(sk); sk += shx4(sk);
          { const float rk = rsqrtf(sk + 1e-6f);
#pragma unroll
            for (int e = 0; e < 16; ++e) { qv[e] *= rk; KNt[(jq * 16 + e) * 72 + (i ^ (jq << 3))] = f2bf(qv[e]); } }
          *(uint4*)(KN + i * 136 + jq * 16) = pack8(qv); *(uint4*)(KN + i * 136 + jq * 16 + 8) = pack8(qv + 8);
          __builtin_amdgcn_sched_barrier(0);
#pragma unroll
          for (int e = 0; e < 16; ++e) qv[e] = 0.f;
#pragma unroll
          for (int tap = 0; tap < 5; ++tap) { const uint4 r0 = *(const uint4*)(RAW + (n + tap) * 392 + 256 + jq * 16), r1 = *(const uint4*)(RAW + (n + tap) * 392 + 256 + jq * 16 + 8);
              const float* cw = CW + tap * 384 + 256 + jq * 16;
#pragma unroll
              for (int e = 0; e < 8; ++e) { qv[e] += cw[e] * bfe(r0, e); qv[8 + e] += cw[8 + e] * bfe(r1, e); } }
#pragma unroll
          for (int e = 0; e < 16; ++e) VT[(jq * 16 + e) * 72 + (i ^ (jq << 3))] = f2bf(siluf_(qv[e]) * beta_n);
          if (jq == 0) { const float sa = bf2f(up[8 + d * 4 + h]); BETA[i] = beta_n; GLs[i] = -a_exp * softplusf_(sa + dtb); } }
        __syncthreads();
        if (wave == 0) { float x = GLs[lane];
#pragma unroll
            for (int o = 1; o < 64; o <<= 1) { const float y = __int_as_float(__builtin_amdgcn_ds_bpermute((lane - o) << 2, __float_as_int(x))); if (lane >= o) x += y; }
            GC[lane] = x; SC1[lane] = BETA[lane] * fexp(x); }
        __syncthreads();
        if (c + nblk < 132) gdn_raw_load(U, b, h, d, c + nblk, tid, rv);
        { const uint4 z4 = {0u, 0u, 0u, 0u}; *(uint4*)(TA + (tid >> 3) * 72 + (tid & 7) * 8) = z4; *(uint4*)(T1 + (tid >> 3) * 72 + (tid & 7) * 8) = z4; }
#pragma unroll
        for (int q = 0; q < 2; ++q) { const int tix = wave + 8 * q, tm = tix >> 2, tn = tix & 3, r0 = tm * 16 + fq * 4, cx = tn * 16 + fr;
            f32x4 a1 = ZERO4, a2 = ZERO4;
            const bf16_t* bp = KN + (tn * 16 + fr) * 136 + fq * 8; const bf16_t* ap1 = KN + (tm * 16 + fr) * 136 + fq * 8; const bf16_t* ap2 = Qn + (tm * 16 + fr) * 136 + fq * 8;
#pragma unroll
            for (int ks = 0; ks < 4; ++ks) { const bf16x8 bfr = *(const bf16x8*)(bp + ks * 32);
                a1 = __builtin_amdgcn_mfma_f32_16x16x32_bf16(*(const bf16x8*)(ap1 + ks * 32), bfr, a1, 0, 0, 0);
                a2 = __builtin_amdgcn_mfma_f32_16x16x32_bf16(*(const bf16x8*)(ap2 + ks * 32), bfr, a2, 0, 0, 0); }
#pragma unroll
            for (int j = 0; j < 4; ++j) { const int r = r0 + j; const float dec = fexp(GC[r] - GC[cx]); const float x0 = (cx < r) ? a1[j] * BETA[r] * dec : 0.f;
                LA[r * 72 + cx] = f2bf(x0); if (tm == tn) LD[tm * 256 + (r & 15) * 16 + (cx & 15)] = x0;
                QKd[r * 72 + cx] = f2bf((cx <= r) ? a2[j] * dec : 0.f); } }
        __syncthreads();
        trinv64<1>(LA, LD, TA, 72, TT, WT, T1, nullptr, SC1, nullptr, tid, wave, fr, fq);
        { const bf16_t* bp = KNt + (wave * 16 + fr) * 72;
          const bf16x8 b0 = *(const bf16x8*)(bp + ((fq * 8) ^ (wave << 3))), b1 = *(const bf16x8*)(bp + ((32 + fq * 8) ^ (wave << 3)));
#pragma unroll
          for (int q = 0; q < 4; ++q) { const bf16_t* ap = T1 + (q * 16 + fr) * 72 + fq * 8; f32x4 a1 = ZERO4;
              a1 = __builtin_amdgcn_mfma_f32_16x16x32_bf16(*(const bf16x8*)ap, b0, a1, 0, 0, 0); a1 = __builtin_amdgcn_mfma_f32_16x16x32_bf16(*(const bf16x8*)(ap + 32), b1, a1, 0, 0, 0);
#pragma unroll
              for (int j = 0; j < 4; ++j) Wm[(q * 16 + fq * 4 + j) * 136 + wave * 16 + fr] = f2bf(-a1[j]); } }
        const float gl63 = GC[63]; const float eg = fexp(gl63);
        u64_t* sbn = SB + ((c + 1) & 1) * 16384; const unsigned ep = fbase + (unsigned)c + 1u;
#pragma unroll
        for (int vh = 0; vh < 2; ++vh) {
            if (c > 0) { float sv[16]; recv_gran<16>(SB + (c & 1) * 16384 + (vh * 16) * 512 + tid, fbase + (unsigned)c, sv);
#pragma unroll
                for (int q = 0; q < 4; ++q)
#pragma unroll
                    for (int j = 0; j < 4; ++j) accS[vh * 4 + q][j] = sv[q * 4 + j];
            } else {
#pragma unroll
                for (int q = 0; q < 4; ++q) accS[vh * 4 + q] = ZERO4; }
#pragma unroll
            for (int q = 0; q < 4; ++q) { const int tile = wave + 8 * q, tm = tile >> 3, tn = tile & 7;
#pragma unroll
                for (int j = 0; j < 4; ++j) STbf[(tm * 16 + fq * 4 + j) * 136 + tn * 16 + fr] = f2bf(accS[vh * 4 + q][j]); }
            __syncthreads();
#pragma unroll
            for (int q2 = 0; q2 < 2; ++q2) { const int tile = wave + 8 * q2, tm = tile >> 2, tn = tile & 3, r0 = tm * 16 + fq * 4, cx = tn * 16 + fr;
                f32x4 au = ZERO4; mma_seg_bs(au, TA, 72, VT + (vh * 64) * 72, 72, tm, tn, 2, fr, fq, (vh * 4 + tn) & 7);
                mma_seg(au, Wm, 136, STbf, 136, tm, tn, 4, fr, fq);
                st4bf(VNt + cx * 72 + r0, au[0], au[1], au[2], au[3]);
                st4bf(VNs + cx * 72 + r0, au[0] * fexp(gl63 - GC[r0]), au[1] * fexp(gl63 - GC[r0 + 1]), au[2] * fexp(gl63 - GC[r0 + 2]), au[3] * fexp(gl63 - GC[r0 + 3])); }
            __syncthreads();
            { const bf16_t* bp = KNt + (wave * 16 + fr) * 72;
              const bf16x8 b0 = *(const bf16x8*)(bp + ((fq * 8) ^ (wave << 3))), b1 = *(const bf16x8*)(bp + ((32 + fq * 8) ^ (wave << 3)));
#pragma unroll
              for (int q = 0; q < 4; ++q) { const bf16_t* ap = VNs + (q * 16 + fr) * 72 + fq * 8; f32x4 a1 = accS[vh * 4 + q] * eg;
                  a1 = __builtin_amdgcn_mfma_f32_16x16x32_bf16(*(const bf16x8*)ap, b0, a1, 0, 0, 0); a1 = __builtin_amdgcn_mfma_f32_16x16x32_bf16(*(const bf16x8*)(ap + 32), b1, a1, 0, 0, 0);
                  accS[vh * 4 + q] = a1;
#pragma unroll
                  for (int j = 0; j < 4; ++j) st_gran(sbn + ((vh * 4 + q) * 4 + j) * 512 + tid, ep, a1[j]); } }
#pragma unroll
            for (int q2 = 0; q2 < 2; ++q2) { const int tile = wave + 8 * q2, tm = tile >> 2, tn = tile & 3, r0 = tm * 16 + fq * 4, cx = tn * 16 + fr;
                f32x4 a1 = ZERO4, a2 = ZERO4; mma_seg(a1, Qn, 136, STbf, 136, tm, tn, 4, fr, fq); mma_seg(a2, QKd, 72, VNt, 72, tm, tn, 2, fr, fq);
#pragma unroll
                for (int j = 0; j < 4; ++j) { const int tt = r0 + j; const int nn = d ? 63 - tt : tt; const float o = fexp(GC[tt]) * a1[j] + a2[j];
                    OGp[((size_t)d * M + rowbase + nn) * 512 + h * 128 + vh * 64 + cx] = f2bf(o); } }
            __syncthreads();
        }
    }
}
__device__ __forceinline__ void fft1_item(const Prm& p, int item, unsigned char* lds, int tid) {
    const int b = item >> 7, t2 = item & 127; const int wave = tid >> 6, lane = tid & 63, fr = lane & 15, fq = lane >> 4;
    bf16_t* A1 = (bf16_t*)lds; bf16_t* Bt = A1 + 128 * 136;
    const bf16_t* U = (const bf16_t*)(p.ws + WS_U); bf16_t* MID = (bf16_t*)(p.ws + WS_MID);
    for (int e = tid; e < 4096; e += 512) { const int f1 = e >> 6, t1 = e & 63; const int m = (f1 * (128 * t1 + t2)) & 8191; const float s = __builtin_amdgcn_sinf((float)m * (1.f / 8192.f)), c = __builtin_amdgcn_cosf((float)m * (1.f / 8192.f));
        A1[f1 * 136 + t1] = f2bf(c); A1[f1 * 136 + 64 + t1] = f2bf(s); A1[(64 + f1) * 136 + t1] = f2bf(-s); A1[(64 + f1) * 136 + 64 + t1] = f2bf(c); }
    { const int t1 = tid >> 3, pc = tid & 7; const bf16_t* up = U + ((size_t)b * T + 128 * t1 + t2) * LDU + C_FZ + pc * 64;
#pragma unroll
      for (int g8 = 0; g8 < 8; ++g8) { const uint4 v = *(const uint4*)(up + g8 * 8); const int col = pc * 64 + g8 * 8; const int part = col >> 8, ch = col & 255;
#pragma unroll
          for (int e = 0; e < 8; ++e) Bt[(ch + e) * 136 + part * 64 + t1] = f2bf(bfe(v, e)); } }
    __syncthreads();
    for (int tile = wave; tile < 128; tile += 8) { const int tm = tile >> 4, tn = tile & 15, r0 = tm * 16 + fq * 4, ch = tn * 16 + fr;
        f32x4 acc = ZERO4; mma_seg(acc, A1, 136, Bt, 136, tm, tn, 4, fr, fq);
#pragma unroll
        for (int j = 0; j < 4; ++j) { const int r = r0 + j, po = r >> 6, f1 = r & 63;
            MID[(((size_t)b * 64 + f1) * 128 + t2) * 512 + po * 256 + ch] = f2bf(acc[j]); } }
    __syncthreads();
}
__device__ __forceinline__ void fft2_item(const Prm& p, int item, unsigned char* lds, int tid) {
    const int b = item >> 7, f1 = (item >> 1) & 63, chh = item & 1; const int wave = tid >> 6, lane = tid & 63, fr = lane & 15, fq = lane >> 4;
    bf16_t* A2 = (bf16_t*)lds; bf16_t* Bt = A2 + 128 * 264;
    const bf16_t* MID = (const bf16_t*)(p.ws + WS_MID); bf16_t* Y = (bf16_t*)(p.ws + WS_Y);
    { const int t2 = tid >> 2, q = tid & 3, pi = q >> 1, hf = q & 1; const bf16_t* mp = MID + (((size_t)b * 64 + f1) * 128 + t2) * 512 + pi * 256 + chh * 128 + hf * 64;
#pragma unroll
      for (int g8 = 0; g8 < 8; ++g8) { const uint4 v = *(const uint4*)(mp + g8 * 8);
#pragma unroll
          for (int e = 0; e < 8; ++e) Bt[(hf * 64 + g8 * 8 + e) * 264 + pi * 128 + t2] = f2bf(bfe(v, e)); } }
    __syncthreads();
    for (int tile = wave; tile < 64; tile += 8) { const int tm = tile >> 3, tn = tile & 7, r0 = tm * 16 + fq * 4, ch = tn * 16 + fr;
        f32x4 acc = ZERO4; mma_seg(acc, A2, 264, Bt, 264, tm, tn, 8, fr, fq);
#pragma unroll
        for (int j = 0; j < 4; ++j) { const int f2 = r0 + j; Y[((size_t)b * T + f1 + 64 * f2) * 1024 + 768 + chh * 128 + ch] = f2bf(acc[j] * 0.011048543456039806f); } }
    __syncthreads();
}
__device__ __forceinline__ void fftc_item(const Prm& p, int item, unsigned char* lds, int tid) {
    const int b = item >> 4, ft = (item >> 2) & 3, cq = item & 3; const int wave = tid >> 6, lane = tid & 63, fr = lane & 15, fq = lane >> 4;
    bf16_t* A3 = (bf16_t*)lds; bf16_t* Bt = A3 + 64 * 520;
    const bf16_t* U = (const bf16_t*)(p.ws + WS_U); bf16_t* Y = (bf16_t*)(p.ws + WS_Y);
    for (int e = tid; e < 64 * 256; e += 512) { const int fl = e >> 8, t = e & 255; const int m = ((ft * 64 + fl) * t) & 255; const float s = __builtin_amdgcn_sinf((float)m * (1.f / 256.f)), c = __builtin_amdgcn_cosf((float)m * (1.f / 256.f));
        A3[fl * 520 + t] = f2bf(c); A3[fl * 520 + 256 + t] = f2bf(s); }
    { const int t = tid >> 1, pi = tid & 1; const bf16_t* up = U + ((size_t)ML + b * TC + t) * LDU + C_FZ + pi * 256 + cq * 64;
#pragma unroll
      for (int g8 = 0; g8 < 8; ++g8) { const uint4 v = *(const uint4*)(up + g8 * 8);
#pragma unroll
          for (int e = 0; e < 8; ++e) Bt[(g8 * 8 + e) * 520 + pi * 256 + t] = f2bf(bfe(v, e)); } }
    __syncthreads();
    for (int tile = wave; tile < 16; tile += 8) { const int tm = tile >> 2, tn = tile & 3, r0 = tm * 16 + fq * 4, ch = tn * 16 + fr;
        f32x4 acc = ZERO4; mma_seg(acc, A3, 520, Bt, 520, tm, tn, 16, fr, fq);
#pragma unroll
        for (int j = 0; j < 4; ++j) Y[((size_t)ML + b * TC + ft * 64 + r0 + j) * 1024 + 768 + cq * 64 + ch] = f2bf(acc[j] * 0.0625f); }
    __syncthreads();
}

__device__ __forceinline__ void rwkv_post_tile(const Prm& p, int l, int tile, unsigned char* lds, int tid_in) {
    int tid = threadIdx.x; asm volatile("" : "+v"(tid));
    const int wave = tid >> 6, lane = tid & 63, fr = lane & 15, fq = lane >> 4;
    bf16_t* GUPt = (bf16_t*)lds; bf16_t* SG = GUPt + 256 * 72; float* GATE = (float*)(SG + 64 * 72);
    const bf16_t* U = (const bf16_t*)(p.ws + WS_U); const bf16_t* ORp = (const bf16_t*)(p.ws + WS_OR); const float* BC = (const float*)(p.ws + WS_BC); bf16_t* Y = (bf16_t*)(p.ws + WS_Y);
    const int n = tid >> 3, jq = tid & 7; const size_t row = (size_t)tile * 64 + n; const bool isctx = row >= (size_t)ML; const int t = isctx ? (int)((row - ML) & (TC - 1)) : (int)(row & (T - 1));
    const float* mu = p.in[10] + l * 896;
    const int cb = jq * 32, hh = jq >> 1;
    uint4 oa[4], ob[4], vr0[5], vr1[5], vr2[5], vr3[5];
#pragma unroll
    for (int g8 = 0; g8 < 4; ++g8) { oa[g8] = *(const uint4*)(ORp + row * 256 + cb + g8 * 8); ob[g8] = *(const uint4*)(ORp + ((size_t)M + row) * 256 + cb + g8 * 8); }
    lerp8_load(U, row, 512 + cb, isctx, t, vr0); lerp8_load(U, row, 512 + cb + 8, isctx, t, vr1); lerp8_load(U, row, 512 + cb + 16, isctx, t, vr2); lerp8_load(U, row, 512 + cb + 24, isctx, t, vr3);
    const float bcs = BC[row * 4 + hh] + BC[((size_t)M + row) * 4 + hh];
    { float m8[8], g8[8];
      { const f32x4 ma = *(const f32x4*)(mu + 832 + jq * 8), mb = *(const f32x4*)(mu + 832 + jq * 8 + 4);
#pragma unroll
        for (int e = 0; e < 4; ++e) { m8[e] = ma[e]; m8[4 + e] = mb[e]; } }
      lerp8(U, row, 832 + jq * 8, isctx, t, m8, g8);
#pragma unroll
      for (int e = 0; e < 8; ++e) g8[e] = sigmoidf_(g8[e]);
      *(uint4*)(SG + n * 72 + jq * 8) = pack8(g8); }
    __syncthreads();
    for (int tl = wave; tl < 64; tl += 8) { const int tm = tl >> 4, tn = tl & 15, r0 = tm * 16 + fq * 4, cx = tn * 16 + fr;
        f32x4 acc = ZERO4; mma_seg(acc, SG, 72, GUPt, 72, tm, tn, 2, fr, fq);
#pragma unroll
        for (int j = 0; j < 4; ++j) GATE[(r0 + j) * 260 + cx] = acc[j]; }
    __syncthreads();
    { float o[32]; float s = 0.f;
#pragma unroll
      for (int g8 = 0; g8 < 4; ++g8)
#pragma unroll
          for (int e = 0; e < 8; ++e) { o[g8 * 8 + e] = bfe(oa[g8], e) + bfe(ob[g8], e); s += o[g8 * 8 + e]; }
      s += shx1(s); const float mean = s * (1.f / 64.f); float vs = 0.f;
#pragma unroll
      for (int e = 0; e < 32; ++e) { const float dd = o[e] - mean; vs += dd * dd; }
      vs += shx1(vs); const float rstd = rsqrtf(vs * (1.f / 64.f) + 64e-5f);
#pragma unroll
      for (int g8 = 0; g8 < 4; ++g8) { float m8[8], v8[8], y8[8], lg[8], lb[8];
          { const float* mp = mu + 512 + cb + g8 * 8; const float* gp = p.in[19] + l * 256 + cb + g8 * 8; const float* bp2 = p.in[20] + l * 256 + cb + g8 * 8;
            const f32x4 ma = *(const f32x4*)mp, mb = *(const f32x4*)(mp + 4), ga = *(const f32x4*)gp, gb = *(const f32x4*)(gp + 4), ba = *(const f32x4*)bp2, bb2 = *(const f32x4*)(bp2 + 4);
#pragma unroll
            for (int e = 0; e < 4; ++e) { m8[e] = ma[e]; m8[4 + e] = mb[e]; lg[e] = ga[e]; lg[4 + e] = gb[e]; lb[e] = ba[e]; lb[4 + e] = bb2[e]; } }
          if (g8 == 0) lerp8_apply(vr0, m8, v8); else if (g8 == 1) lerp8_apply(vr1, m8, v8); else if (g8 == 2) lerp8_apply(vr2, m8, v8); else lerp8_apply(vr3, m8, v8);
          const f32x4 ga0 = *(const f32x4*)(GATE + n * 260 + cb + g8 * 8), ga1 = *(const f32x4*)(GATE + n * 260 + cb + g8 * 8 + 4);
#pragma unroll
          for (int e = 0; e < 8; ++e) { const float yn = (o[g8 * 8 + e] - mean) * rstd * lg[e] + lb[e];
              y8[e] = (yn + bcs * v8[e]) * (e < 4 ? ga0[e] : ga1[e - 4]); }
          *(uint4*)(Y + row * 1024 + cb + g8 * 8) = pack8(y8); } }
    __syncthreads();
}
__device__ __forceinline__ void gdn_post_tile(const Prm& p, int l, int tile, int tid_in) {
    int tid = threadIdx.x; asm volatile("" : "+v"(tid));
    const bf16_t* U = (const bf16_t*)(p.ws + WS_U); const bf16_t* OGp = (const bf16_t*)(p.ws + WS_OG); bf16_t* Y = (bf16_t*)(p.ws + WS_Y);
    const int n = tid >> 3, jq = tid & 7; const size_t row = (size_t)tile * 64 + n; const int cb = jq * 64;
    uint4 oa[8], ob[8], zq[8];
#pragma unroll
    for (int g8 = 0; g8 < 8; ++g8) { oa[g8] = *(const uint4*)(OGp + row * 512 + cb + g8 * 8); ob[g8] = *(const uint4*)(OGp + ((size_t)M + row) * 512 + cb + g8 * 8);
        zq[g8] = *(const uint4*)(U + row * LDU + C_GZ + cb + g8 * 8); }
    float ss = 0.f;
#pragma unroll
    for (int g8 = 0; g8 < 8; ++g8)
#pragma unroll
        for (int e = 0; e < 8; ++e) { const float o = bfe(oa[g8], e) + bfe(ob[g8], e); ss += o * o; }
    ss += shx1(ss); const float rinv = rsqrtf(ss * (1.f / 128.f) + 1e-6f);
#pragma unroll
    for (int g8 = 0; g8 < 8; ++g8) { float y8[8], ng[8];
        { const float* np = p.in[24] + l * 128 + ((cb + g8 * 8) & 127); const f32x4 na = *(const f32x4*)np, nb2 = *(const f32x4*)(np + 4);
#pragma unroll
          for (int e = 0; e < 4; ++e) { ng[e] = na[e]; ng[4 + e] = nb2[e]; } }
#pragma unroll
        for (int e = 0; e < 8; ++e) { const float o = bfe(oa[g8], e) + bfe(ob[g8], e); const float z = bfe(zq[g8], e); y8[e] = o * rinv * ng[e] * siluf_(z); }
        *(uint4*)(Y + row * 1024 + 256 + cb + g8 * 8) = pack8(y8); }
}
__device__ __forceinline__ void post_phase(const Prm& p, int l, unsigned char* lds, int tid, int G) {
    const int bid = blockIdx.x; const int ntile = (l == 0) ? M / 64 : ML / 64;
    if (bid < ntile) { bf16_t* GUPt = (bf16_t*)lds;
        for (int e = tid; e < 64 * 256; e += 512) { const int q = e >> 8, c = e & 255; GUPt[c * 72 + q] = f2bf(p.in[15][((size_t)l * 64 + q) * 256 + c]); }
        __syncthreads();
#ifdef PROBE_RPOST
        for (int rp = 0; rp < PROBE_RPOST; ++rp)
#endif
        for (int tile = bid; tile < ntile; tile += G) rwkv_post_tile(p, l, tile, lds, tid); }
#ifdef PROBE_GPOST
    for (int rp = 0; rp < PROBE_GPOST; ++rp)
#endif
    for (int tile = bid; tile < ntile; tile += G) gdn_post_tile(p, l, tile, tid);
    __syncthreads();
    if (bid < 512) { bf16_t* A2 = (bf16_t*)lds;
        for (int e = tid; e < 128 * 128; e += 512) { const int f2 = e >> 7, t2 = e & 127; const int m = (f2 * t2) & 127; const float s = __builtin_amdgcn_sinf((float)m * (1.f / 128.f)), c = __builtin_amdgcn_cosf((float)m * (1.f / 128.f));
            A2[f2 * 264 + t2] = f2bf(c); A2[f2 * 264 + 128 + t2] = f2bf(s); }
        __syncthreads();
        for (int it = bid; it < 512; it += G) fft2_item(p, it, lds, tid); }
    if (l == 0 && bid >= G - 64) fftc_item(p, bid - (G - 64), lds, tid);
}

#ifndef PHMASK
#define PHMASK 0x3ffff
#endif
#define PH_IN(k) (((PHMASK >> (k)) & 1) && lo <= (k) && (k) < hi)
#ifndef DUPMASK
#define DUPMASK 0
#endif
#define PH_REP(k) for (int rep_ = 0; rep_ <= ((DUPMASK >> (k)) & 1); ++rep_)
#define PH_SYNC(k) do { if (PH_IN(k) && PH_IN((k) + 1)) { if ((k) == 0) grid.sync(); else xcd_barrier(xbar); } } while (0)
template <int L>
__device__ __forceinline__ void layer_phases(const Prm& p, cg::grid_group& grid, const XcdBarrier& xbar, unsigned char* lds, int lo, int hi) {
    constexpr int l = L; constexpr int base = 1 + 8 * L;
    if (PH_IN(base + 0)) PH_REP(base + 0) { int tid = threadIdx.x; asm volatile("" : "+v"(tid)); norm_phase(p, l, 0, tid, gridDim.x); }
    PH_SYNC(base + 0);
    if (PH_IN(base + 1)) PH_REP(base + 1) { unsigned char* ws = p.ws; const int G = gridDim.x, bid = blockIdx.x;
        pg8::Gemm g{(const bf16_t*)(ws + WS_HN), (const bf16_t*)(ws + WS_WIN) + (size_t)l * LDU * 1024, M, LDU, 1024}; pg8::StaticOrder S; S.init(M, LDU, G, bid);
        pg8::EpiBf16<0> E{(bf16_t*)(ws + WS_U), LDU};
        pg8::gemm_phase<pg8::EpiBf16<0>, pg8::StaticOrder, true, true>((PG8_LAS unsigned char*)lds, g, S, E); }
    PH_SYNC(base + 1);
    if (PH_IN(base + 2)) PH_REP(base + 2) { int tid = threadIdx.x; asm volatile("" : "+v"(tid)); const int G = gridDim.x, bid = blockIdx.x;
        if (G >= 256) { if (bid < 128) rwkv_scan(p, l, bid >> 2, bid & 3, 4, lds, tid); else if (bid < 256) gdn_scan(p, l, (bid - 128) >> 2, bid & 3, 4, lds, tid);
            if (bid < 128) for (int it = bid; it < 512; it += 128) fft1_item(p, it, lds, tid); }
        else { if (bid < 32) rwkv_scan(p, l, bid, 0, 1, lds, tid); else if (bid < 64) gdn_scan(p, l, bid - 32, 0, 1, lds, tid);
            else for (int it = bid - 64; it < 512; it += G - 64) fft1_item(p, it, lds, tid); } }
    PH_SYNC(base + 2);
    if (PH_IN(base + 3)) PH_REP(base + 3) { int tid = threadIdx.x; asm volatile("" : "+v"(tid)); post_phase(p, l, lds, tid, gridDim.x); }
    PH_SYNC(base + 3);
    if (PH_IN(base + 4)) PH_REP(base + 4) { unsigned char* ws = p.ws; const int G = gridDim.x, bid = blockIdx.x; const float* modl = (const float*)(ws + WS_MOD) + (size_t)l * 5 * 6144;
        constexpr int Mg = (l == 0) ? M : ML;
        pg8::Gemm g{(const bf16_t*)(ws + WS_Y), (const bf16_t*)(ws + WS_WOUT) + (size_t)l * 1024 * 1024, Mg, 1024, 1024}; pg8::StaticOrder S; S.init(Mg, 1024, G, bid);
        pg8::EpiResid E{l == 0 ? p.in[0] : p.out, l == 0 ? p.in[2] : (const float*)(ws + WS_XC), p.out, (float*)(ws + WS_XC), modl + 2 * 1024};
        pg8::gemm_phase<pg8::EpiResid, pg8::StaticOrder, true, true>((PG8_LAS unsigned char*)lds, g, S, E); }
    PH_SYNC(base + 4);
    if (PH_IN(base + 5)) PH_REP(base + 5) { int tid = threadIdx.x; asm volatile("" : "+v"(tid)); norm_phase(p, l, 1, tid, gridDim.x); }
    PH_SYNC(base + 5);
    if (PH_IN(base + 6)) PH_REP(base + 6) { unsigned char* ws = p.ws; const int G = gridDim.x, bid = blockIdx.x; constexpr int Mg = (l == 0) ? M : ML;
        pg8::Gemm g{(const bf16_t*)(ws + WS_HN), (const bf16_t*)(ws + WS_W1) + (size_t)l * 4096 * 1024, Mg, DFF, 1024}; pg8::StaticOrder S; S.init(Mg, DFF, G, bid);
        pg8::EpiBf16<1> E{(bf16_t*)(ws + WS_H), DFF};
        pg8::gemm_phase<pg8::EpiBf16<1>, pg8::StaticOrder, true, true>((PG8_LAS unsigned char*)lds, g, S, E); }
    PH_SYNC(base + 6);
    if (PH_IN(base + 7)) PH_REP(base + 7) { unsigned char* ws = p.ws; const int G = gridDim.x, bid = blockIdx.x; const float* modl = (const float*)(ws + WS_MOD) + (size_t)l * 5 * 6144; constexpr int Mg = (l == 0) ? M : ML;
        pg8::Gemm g{(const bf16_t*)(ws + WS_H), (const bf16_t*)(ws + WS_W2) + (size_t)l * 1024 * 4096, Mg, 1024, DFF}; pg8::StaticOrder S; S.init(Mg, 1024, G, bid);
        pg8::EpiResid E{p.out, (const float*)(ws + WS_XC), p.out, (float*)(ws + WS_XC), modl + 5 * 1024};
        pg8::gemm_phase<pg8::EpiResid, pg8::StaticOrder, true, true>((PG8_LAS unsigned char*)lds, g, S, E); }
    PH_SYNC(base + 7);
}
__global__ void __launch_bounds__(512, 2) mega_fwd(Prm p) {
    extern __shared__ __attribute__((aligned(16))) unsigned char lds[];
    cg::grid_group grid = cg::this_grid();
    const int lo = p.ph_lo, hi = p.ph_hi;
    if (threadIdx.x < 2) ((volatile LAS unsigned*)((LAS unsigned char*)lds + LDS_XB))[threadIdx.x] = 0u;
    __syncthreads();
#ifdef EXTRA_SYNCS
    for (int es = 0; es < EXTRA_SYNCS; ++es) grid.sync();
#endif
    if (PH_IN(0)) PH_REP(0) { int tid = threadIdx.x; asm volatile("" : "+v"(tid)); prep_phase(p, lds, tid, gridDim.x); }
    if (PH_IN(0) && PH_IN(1)) grid.sync();
    const XcdBarrier xbar = xcd_barrier_post((unsigned*)(p.ws + WS_BARW), (volatile LAS unsigned*)((LAS unsigned char*)lds + LDS_XB));
    layer_phases<0>(p, grid, xbar, lds, lo, hi);
    layer_phases<1>(p, grid, xbar, lds, lo, hi);
    if (PH_IN(NPH - 1)) { int tid = threadIdx.x; asm volatile("" : "+v"(tid)); norm_phase(p, 1, 2, tid, gridDim.x); }
}

#ifndef MK_SPLIT
#define MK_SPLIT 0
#endif
extern "C" void kernel_launch(void* const* d_in, const int* in_sizes, int n_in, void* d_out, int out_size, void* d_ws, size_t ws_size, hipStream_t stream) {
    static int grid = 0;
    if (grid == 0) {
        int dev = 0, cus = 0, per_cu = 0;
        if (n_in != 29 || out_size != ML * D || ws_size < WS_END2) { fprintf(stderr, "kernel_launch: unexpected problem shape (n_in %d out %d ws %zu)\n", n_in, out_size, ws_size); grid = -1; return; }
        hipGetDevice(&dev); hipDeviceGetAttribute(&cus, hipDeviceAttributeMultiprocessorCount, dev);
        if (hipFuncSetAttribute((const void*)mega_fwd, hipFuncAttributeMaxDynamicSharedMemorySize, LDS_BYTES) != hipSuccess) { fprintf(stderr, "kernel_launch: hipFuncSetAttribute failed\n"); grid = -1; return; }
        if (hipOccupancyMaxActiveBlocksPerMultiprocessor(&per_cu, (const void*)mega_fwd, 512, LDS_BYTES) != hipSuccess || per_cu < 1) { fprintf(stderr, "kernel_launch: occupancy query says %d blocks per CU\n", per_cu); grid = -1; return; }
        grid = cus * 1;
        if (grid > 256) grid = 256;
        if (grid < 128) { fprintf(stderr, "kernel_launch: needs >= 128 CUs\n"); grid = -1; return; }
    }
    if (grid < 0) return;
    Prm prm{};
    for (int i = 0; i < 29; ++i) prm.in[i] = (const float*)d_in[i];
    prm.out = (float*)d_out; prm.ws = (unsigned char*)d_ws;
#if MK_SPLIT
    for (int ph = 0; ph < NPH; ++ph) { prm.ph_lo = ph; prm.ph_hi = ph + 1; void* args[] = {&prm};
        hipError_t e = hipLaunchCooperativeKernel((const void*)mega_fwd, dim3(grid), dim3(512), args, LDS_BYTES, stream);
        if (e != hipSuccess) { fprintf(stderr, "kernel_launch: launch failed: %s\n", hipGetErrorString(e)); break; } }
#else
    prm.ph_lo = 0; prm.ph_hi = NPH; void* args[] = {&prm};
    hipError_t e = hipLaunchCooperativeKernel((const void*)mega_fwd, dim3(grid), dim3(512), args, LDS_BYTES, stream);
    if (e != hipSuccess) fprintf(stderr, "kernel_launch: cooperative launch failed: %s (grid %d)\n", hipGetErrorString(e), grid);
#endif
}
```

```cpp
#include <hip/hip_runtime.h>
#include <hip/hip_cooperative_groups.h>
#include <cstdio>
#include <cstdint>
namespace cg = cooperative_groups;
namespace pg8 {
#define PG8_LAS __attribute__((address_space(3)))
typedef unsigned short bf16_t;
typedef short bf16x8 __attribute__((ext_vector_type(8)));
typedef float f32x4 __attribute__((ext_vector_type(4)));
typedef unsigned u32x4 __attribute__((ext_vector_type(4)));
constexpr int BM = 256, BK = 64, HALF = 128, HTB = HALF * BK * 2  , STAGE_BYTES = 8 * HTB, NXCD = 8, WGM = 8;

__host__ __device__ __forceinline__ int lds_byte(int r, int c) { const int st = (r >> 4) * 2 + (c >> 5), rr = r & 15, cc = c & 31, ob = rr * 64 + cc * 2; return st * 1024 + (ob ^ (((ob >> 9) & 1) << 5)); }
__host__ __device__ __forceinline__ void stage_rc(int b, int& R, int& C) { const int st = b / 1024, sb = b % 1024, swz = sb ^ (((sb >> 9) & 1) << 5); R = (st >> 1) * 16 + swz / 64; C = (st & 1) * 32 + (swz % 64) / 2; }
__host__ __device__ __forceinline__ int perm32(int rho) { const int n = rho >> 4, i = rho & 15; return 8 * (i >> 2) + 4 * n + (i & 3); }

struct Unit { int pm, pn; };
struct Gemm { const bf16_t* A; const bf16_t* Bt; int M, N, K; };

struct StaticOrder {
    int nM, nN, nwg, G, c;
    __host__ __device__ void init(int M, int N, int G_, int c_) { nM = M / BM; nN = N / BM; nwg = nM * nN; G = G_; c = c_; }
    __host__ __device__ bool next(int i, Unit& u) const {
        const long L = (long)i * G + c; if (L >= nwg) return false;
        int wgid = (int)L; { const int q = nwg / NXCD, r = nwg % NXCD, xcd = wgid % NXCD, off = wgid / NXCD; wgid = (xcd < r ? xcd * (q + 1) : r * (q + 1) + (xcd - r) * q) + off; }
        const int nig = WGM * nN, gid = wgid / nig, fm = gid * WGM, gsz = (nM - fm) < WGM ? (nM - fm) : WGM;
        u.pm = fm + ((wgid % nig) % gsz); u.pn = (wgid % nig) / gsz; return true;
    }
    __device__ __forceinline__ void a_ready(const Unit&) const {}
    __device__ __forceinline__ void done(const Unit&) const {}
};

typedef __bf16 bf16x2_t __attribute__((ext_vector_type(2)));
typedef float f32x2_t __attribute__((ext_vector_type(2)));
__device__ __forceinline__ unsigned cvt_pk_bf16(float lo, float hi) { const f32x2_t v = {lo, hi}; const bf16x2_t b = __builtin_convertvector(v, bf16x2_t); return __builtin_bit_cast(unsigned, b); }
template <int ACT  > struct EpiBf16 {
    static constexpr bool PERM = true, AFTER_DRAIN = false;
    bf16_t* O; int ldc;
    __device__ __forceinline__ void operator()(const f32x4 (&acc)[2][2][4][2], const Unit& u, int wr, int wc, int fr, int fq) const {
        const int row0 = u.pm * BM + wr * 64 + fr; const int col0 = u.pn * BM + wc * 32 + 8 * fq;
#pragma unroll
        for (int ai = 0; ai < 2; ++ai)
#pragma unroll
            for (int m = 0; m < 4; ++m) { bf16_t* rowp = O + (size_t)(row0 + ai * HALF + m * 16) * ldc + col0;
#pragma unroll
                for (int bj = 0; bj < 2; ++bj) { f32x4 v0 = acc[ai][bj][m][0], v1 = acc[ai][bj][m][1];
                    if (ACT == 1) {
#pragma unroll
                        for (int e = 0; e < 4; ++e) { float a = v0[e] > 0.f ? v0[e] : 0.f; v0[e] = a * a; float b = v1[e] > 0.f ? v1[e] : 0.f; v1[e] = b * b; } }
                    u32x4 w; w.x = cvt_pk_bf16(v0[0], v0[1]); w.y = cvt_pk_bf16(v0[2], v0[3]); w.z = cvt_pk_bf16(v1[0], v1[1]); w.w = cvt_pk_bf16(v1[2], v1[3]);
                    *(u32x4*)(rowp + bj * HALF) = w; } }
    }
};
struct EpiResid {
    static constexpr bool PERM = true, AFTER_DRAIN = false;
    const float* rin_lat; const float* rin_ctx; float* rout_lat; float* rout_ctx; const float* gate;
    __device__ __forceinline__ void operator()(const f32x4 (&acc)[2][2][4][2], const Unit& u, int wr, int wc, int fr, int fq) const {
        const bool lat = u.pm < 128; const int bb = lat ? (u.pm >> 5) : 4;
        const int rbase = (lat ? u.pm * 256 : (u.pm - 128) * 256) + wr * 64 + fr;
        const float* rin = lat ? rin_lat : rin_ctx; float* rout = lat ? rout_lat : rout_ctx;
        const int col0 = u.pn * BM + wc * 32 + 8 * fq;
        const float* gv = gate + bb * 6144 + col0;
        f32x4 g[2][2];
#pragma unroll
        for (int bj = 0; bj < 2; ++bj)
#pragma unroll
            for (int n = 0; n < 2; ++n) g[bj][n] = *(const f32x4*)(gv + bj * HALF + 4 * n);
#pragma unroll
        for (int ai = 0; ai < 2; ++ai)
#pragma unroll
            for (int m = 0; m < 4; ++m) { const size_t ro = (size_t)(rbase + ai * HALF + m * 16) * 1024 + col0;
#pragma unroll
                for (int bj = 0; bj < 2; ++bj) {
                    const f32x4 x0 = *(const f32x4*)(rin + ro + bj * HALF), x1 = *(const f32x4*)(rin + ro + bj * HALF + 4);
                    *(f32x4*)(rout + ro + bj * HALF) = x0 + g[bj][0] * acc[ai][bj][m][0];
                    *(f32x4*)(rout + ro + bj * HALF + 4) = x1 + g[bj][1] * acc[ai][bj][m][1]; } }
    }
};
template <class Epi, class Sched, bool ALIGN_EPI = false, bool SP2 = false>
__device__ __forceinline__ void gemm_phase(PG8_LAS unsigned char* lds, const Gemm g, const Sched& S, const Epi& E) {
    int tid_l = threadIdx.x; asm volatile("" : "+v"(tid_l));
    const int tid = tid_l, wid = __builtin_amdgcn_readfirstlane(tid >> 6), lane = tid & 63, wr = wid >> 2, wc = wid & 3, fr = lane & 15, fq = lane >> 4;
    const int K = g.K, nt = K / BK;
    unsigned voffA[2], voffB[2];
#pragma unroll
    for (int i = 0; i < 2; ++i) { int R, C; stage_rc(tid * 16 + i * 8192, R, C); const int Rb = Epi::PERM ? ((R & ~31) + perm32(R & 31)) : R;
        voffA[i] = (unsigned)(R * K + C) * 2u; voffB[i] = (unsigned)(Rb * K + C) * 2u; }
    const size_t kstep = (size_t)(BK * 2);
    const size_t hstep = (size_t)HALF * K * 2;
    const size_t tstep = 2 * hstep;
    const unsigned ldsw = (unsigned)wid * 1024u;
    const int aoff = lds_byte(wr * 64 + fr, fq * 8), boff = lds_byte(wc * 32 + fr, fq * 8);
#define PG8_SA(b, h) (((b) * 2 + (h)) * HTB)
#define PG8_SB(b, h) ((4 + (b) * 2 + (h)) * HTB)
#define PG8_STAGE(bufoff, gbase, voff) do { _Pragma("unroll") for (int _i = 0; _i < 2; ++_i) \
        __builtin_amdgcn_global_load_lds((const unsigned*)((const char*)(gbase) + (voff)[_i]), (PG8_LAS unsigned*)(lds + (bufoff) + ldsw + _i * 8192), 16, 0, 0); } while (0)
#define PG8_LDA(dst, b, h) do { _Pragma("unroll") for (int m = 0; m < 4; ++m) _Pragma("unroll") for (int k = 0; k < 2; ++k) dst[m][k] = *(const PG8_LAS bf16x8*)(lds + PG8_SA(b, h) + aoff + m * 2048 + k * 1024); } while (0)
#define PG8_LDB(dst, b, h) do { _Pragma("unroll") for (int n = 0; n < 2; ++n) _Pragma("unroll") for (int k = 0; k < 2; ++k) dst[n][k] = *(const PG8_LAS bf16x8*)(lds + PG8_SB(b, h) + boff + n * 2048 + k * 1024); } while (0)
#define PG8_MMA(ai, bj, At, Bt) do { __builtin_amdgcn_s_setprio(1); _Pragma("unroll") for (int m = 0; m < 4; ++m) _Pragma("unroll") for (int n = 0; n < 2; ++n) _Pragma("unroll") for (int k = 0; k < 2; ++k) \
        acc[ai][bj][m][n] = __builtin_amdgcn_mfma_f32_16x16x32_bf16(Bt[n][k], At[m][k], acc[ai][bj][m][n], 0, 0, 0); __builtin_amdgcn_s_setprio(0); } while (0)
#define PG8_WAIT_V(n) asm volatile("s_waitcnt vmcnt(" #n ")" ::: "memory")
#define PG8_WAIT_L(n) asm volatile("s_waitcnt lgkmcnt(" #n ")" ::: "memory")
#define PG8_BAR __builtin_amdgcn_s_barrier()
#define PG8_SCHED __builtin_amdgcn_sched_barrier(0)
    Unit cur, nxt; int ui = 0;
    if (!S.next(0, cur)) return;
    f32x4 acc[2][2][4][2];
#pragma unroll
    for (int a = 0; a < 2; ++a)
#pragma unroll
        for (int b = 0; b < 2; ++b)
#pragma unroll
            for (int m = 0; m < 4; ++m)
#pragma unroll
                for (int n = 0; n < 2; ++n) acc[a][b][m][n] = (f32x4){0.f, 0.f, 0.f, 0.f};
    bf16x8 At[4][2], B0[2][2], B1[2][2];
    const char* cA = (const char*)g.A + (size_t)cur.pm * tstep; const char* cB = (const char*)g.Bt + (size_t)cur.pn * tstep;
    S.a_ready(cur);
    if constexpr (SP2) {
        PG8_STAGE(PG8_SB(0, 0), cB, voffB); PG8_STAGE(PG8_SB(0, 1), cB + hstep, voffB); PG8_STAGE(PG8_SA(0, 0), cA, voffA); PG8_STAGE(PG8_SA(0, 1), cA + hstep, voffA);
        if (wr == 1) PG8_BAR;
        PG8_WAIT_V(2); PG8_BAR;
        PG8_STAGE(PG8_SB(1, 0), cB + kstep, voffB); PG8_STAGE(PG8_SA(1, 0), cA + kstep, voffA); PG8_STAGE(PG8_SB(1, 1), cB + hstep + kstep, voffB);
        PG8_WAIT_V(6); PG8_BAR;
    } else {
        PG8_STAGE(PG8_SB(0, 0), cB, voffB); PG8_STAGE(PG8_SA(0, 0), cA, voffA); PG8_STAGE(PG8_SB(0, 1), cB + hstep, voffB); PG8_STAGE(PG8_SA(0, 1), cA + hstep, voffA);
        if (wr == 1) PG8_BAR;
        PG8_WAIT_V(4); PG8_BAR;
        PG8_STAGE(PG8_SB(1, 0), cB + kstep, voffB); PG8_STAGE(PG8_SA(1, 0), cA + kstep, voffA); PG8_STAGE(PG8_SB(1, 1), cB + hstep + kstep, voffB);
        PG8_WAIT_V(6); PG8_BAR;
    }
    for (;;) {
        const bool has_next = S.next(ui + 1, nxt);
        const char* nA = has_next ? (const char*)g.A + (size_t)nxt.pm * tstep : cA; const char* nB = has_next ? (const char*)g.Bt + (size_t)nxt.pn * tstep : cB;
        for (int t = 0; t < nt; t += 2) {
            const bool last = (t == nt - 2);
            const char* a1 = cA + (size_t)(t + 1) * kstep;
            const char* a2 = last ? nA : cA + (size_t)(t + 2) * kstep; const char* b2 = last ? nB : cB + (size_t)(t + 2) * kstep;
            const char* a3 = a2 + kstep; const char* b3 = b2 + kstep;
            if (last && has_next) S.a_ready(nxt);
            if constexpr (SP2) {
            PG8_LDB(B0, 0, 0); PG8_LDB(B1, 0, 1); PG8_SCHED; PG8_LDA(At, 0, 0); PG8_STAGE(PG8_SA(1, 1), a1 + hstep, voffA);
            PG8_WAIT_V(8); PG8_WAIT_L(0); PG8_BAR; PG8_MMA(0, 0, At, B0); PG8_MMA(0, 1, At, B1); PG8_BAR; PG8_SCHED;
            PG8_LDA(At, 0, 1); PG8_STAGE(PG8_SB(0, 0), b2, voffB); PG8_STAGE(PG8_SB(0, 1), b2 + hstep, voffB); PG8_STAGE(PG8_SA(0, 0), a2, voffA);
            PG8_WAIT_V(8); PG8_WAIT_L(0); PG8_BAR; PG8_MMA(1, 0, At, B0); PG8_MMA(1, 1, At, B1); PG8_BAR; PG8_SCHED;
            PG8_LDB(B0, 1, 0); PG8_LDB(B1, 1, 1); PG8_SCHED; PG8_LDA(At, 1, 0); PG8_STAGE(PG8_SA(0, 1), a2 + hstep, voffA);
            PG8_WAIT_V(8); PG8_WAIT_L(0); PG8_BAR; PG8_MMA(0, 0, At, B0); PG8_MMA(0, 1, At, B1); PG8_BAR; PG8_SCHED;
            PG8_LDA(At, 1, 1); PG8_STAGE(PG8_SB(1, 0), b3, voffB); PG8_STAGE(PG8_SB(1, 1), b3 + hstep, voffB); PG8_STAGE(PG8_SA(1, 0), a3, voffA);
            PG8_WAIT_V(8); PG8_WAIT_L(0); PG8_BAR; PG8_MMA(1, 0, At, B0); PG8_MMA(1, 1, At, B1); PG8_BAR; PG8_SCHED;
            } else {
            PG8_LDB(B0, 0, 0); PG8_SCHED; PG8_LDA(At, 0, 0); PG8_STAGE(PG8_SA(1, 1), a1 + hstep, voffA);
            PG8_WAIT_L(8); PG8_BAR; PG8_WAIT_L(0); PG8_MMA(0, 0, At, B0); PG8_BAR; PG8_SCHED;
            PG8_LDB(B1, 0, 1); PG8_STAGE(PG8_SB(0, 0), b2, voffB);
            PG8_BAR; PG8_WAIT_L(0); PG8_MMA(0, 1, At, B1); PG8_BAR;
            PG8_LDA(At, 0, 1); PG8_STAGE(PG8_SA(0, 0), a2, voffA);
            PG8_BAR; PG8_WAIT_L(0); PG8_MMA(1, 0, At, B0); PG8_BAR; PG8_SCHED;
            PG8_STAGE(PG8_SB(0, 1), b2 + hstep, voffB);
            PG8_WAIT_V(6); PG8_BAR; PG8_MMA(1, 1, At, B1); PG8_BAR;
            PG8_LDB(B0, 1, 0); PG8_SCHED; PG8_LDA(At, 1, 0); PG8_STAGE(PG8_SA(0, 1), a2 + hstep, voffA);
            PG8_WAIT_L(8); PG8_BAR; PG8_WAIT_L(0); PG8_MMA(0, 0, At, B0); PG8_BAR; PG8_SCHED;
            PG8_LDB(B1, 1, 1); PG8_STAGE(PG8_SB(1, 0), b3, voffB);
            PG8_BAR; PG8_WAIT_L(0); PG8_MMA(0, 1, At, B1); PG8_BAR;
            PG8_LDA(At, 1, 1); PG8_STAGE(PG8_SA(1, 0), a3, voffA);
            PG8_BAR; PG8_WAIT_L(0); PG8_MMA(1, 0, At, B0); PG8_BAR; PG8_SCHED;
            PG8_STAGE(PG8_SB(1, 1), b3 + hstep, voffB);
            PG8_WAIT_V(6); PG8_BAR; PG8_MMA(1, 1, At, B1); PG8_BAR;
            }
        }
        if constexpr (ALIGN_EPI) { if (wr == 0) PG8_BAR; }
        if constexpr (!Epi::AFTER_DRAIN) { E(acc, cur, wr, wc, fr, fq); S.done(cur); }
        if (!has_next) break;
#pragma unroll
        for (int a = 0; a < 2; ++a)
#pragma unroll
            for (int b = 0; b < 2; ++b)
#pragma unroll
                for (int m = 0; m < 4; ++m)
#pragma unroll
                    for (int n = 0; n < 2; ++n) acc[a][b][m][n] = (f32x4){0.f, 0.f, 0.f, 0.f};
        cur = nxt; cA = nA; cB = nB; ++ui;
        if constexpr (ALIGN_EPI) { if (wr == 1) PG8_BAR; }
    }
    PG8_WAIT_V(0);
    if constexpr (!ALIGN_EPI) { if (wr == 0) PG8_BAR; }
    PG8_BAR;
    if constexpr (Epi::AFTER_DRAIN) { E.fused(acc, cur, wr, wc, fr, fq, lds, wid, lane); S.done(cur); }
#undef PG8_SA
#undef PG8_SB
#undef PG8_STAGE
#undef PG8_LDA
#undef PG8_LDB
#undef PG8_MMA
#undef PG8_WAIT_V
#undef PG8_WAIT_L
#undef PG8_BAR
#undef PG8_SCHED
}
}
typedef unsigned short bf16_t;
typedef short bf16x8 __attribute__((ext_vector_type(8)));
typedef float f32x4 __attribute__((ext_vector_type(4)));
constexpr int NB = 4, T = 8192, TC = 256, D = 1024, DFF = 4096;
constexpr int ML = NB * T, MC = NB * TC, M = ML + MC;
constexpr int LDU = 3584;
constexpr int NPLAIN = 2960, WIN_N = 3216;
constexpr int C_GQ = 896, C_GK = 1408, C_GV = 1920, C_GZ = 2432, C_GS = 2944, C_FZ = 2960;
constexpr size_t MiB = 1u << 20;
constexpr size_t WS_MOD = MiB / 2;
constexpr size_t WS_BC = 3 * MiB / 4;
constexpr size_t WS_WIN = 2 * MiB;
constexpr size_t WS_WOUT = 16 * MiB;
constexpr size_t WS_W1 = 20 * MiB;
constexpr size_t WS_W2 = 36 * MiB;
constexpr size_t WS_XC = 52 * MiB;
constexpr size_t WS_HN = 56 * MiB;
constexpr size_t WS_MID = 56 * MiB;
constexpr size_t WS_OR = 88 * MiB;
constexpr size_t WS_U = 122 * MiB;
constexpr size_t WS_OG = 353 * MiB;
constexpr size_t WS_Y = 419 * MiB;
constexpr size_t WS_H = 122 * MiB;
constexpr size_t WS_END = 485 * MiB;
constexpr size_t WS_BARW = 0;
constexpr int LDS_XB = 159680;
constexpr size_t WS_SBR = 485 * MiB;
constexpr size_t WS_SBG = 487 * MiB;
constexpr size_t WS_END2 = 495 * MiB;
constexpr int LDS_BYTES = 159744;
constexpr int NPH = 18;

struct Prm { const float* in[29]; float* out; unsigned char* ws; int ph_lo, ph_hi; };

__device__ __forceinline__ bf16_t f2bf(float f) { const __bf16 b = (__bf16)f; return __builtin_bit_cast(unsigned short, b); }
__device__ __forceinline__ float bf2f(bf16_t h) { return __uint_as_float(((unsigned)h) << 16); }
__device__ __forceinline__ unsigned pk2(float lo, float hi) { return pg8::cvt_pk_bf16(lo, hi); }
__device__ __forceinline__ float bfe(const uint4& q, int e) { const unsigned w = (e < 2) ? q.x : (e < 4) ? q.y : (e < 6) ? q.z : q.w; return (e & 1) ? __uint_as_float(w & 0xffff0000u) : __uint_as_float(w << 16); }
__device__ __forceinline__ uint4 pack8(const float* v) { uint4 o; o.x = pk2(v[0], v[1]); o.y = pk2(v[2], v[3]); o.z = pk2(v[4], v[5]); o.w = pk2(v[6], v[7]); return o; }
__device__ __forceinline__ float wave_sum(float v) {
#pragma unroll
    for (int o = 1; o < 64; o <<= 1) v += __shfl_xor(v, o);
    return v;
}
__device__ __forceinline__ float fexp(float x) { return __expf(x); }
__device__ __forceinline__ float frcp(float x) { return __builtin_amdgcn_rcpf(x); }
__device__ __forceinline__ float sigmoidf_(float x) { return frcp(1.f + fexp(-x)); }
__device__ __forceinline__ float softplusf_(float z) { const float e = fexp(z); return z > 20.f ? z : (e < 1e-3f ? e * (1.f - 0.5f * e) : __logf(1.f + e)); }
__device__ __forceinline__ float ftanh(float x) { return 1.f - 2.f * frcp(1.f + fexp(2.f * x)); }
__device__ __forceinline__ float siluf_(float x) { return x * frcp(1.f + fexp(-x)); }
__device__ __forceinline__ float shx1(float v) { return __int_as_float(__builtin_amdgcn_ds_swizzle(__float_as_int(v), 0x041F)); }
__device__ __forceinline__ float shx2(float v) { return __int_as_float(__builtin_amdgcn_ds_swizzle(__float_as_int(v), 0x081F)); }
__device__ __forceinline__ float shx4(float v) { return __int_as_float(__builtin_amdgcn_ds_swizzle(__float_as_int(v), 0x101F)); }
typedef unsigned long long u64_t;
__device__ __forceinline__ void st_gran(u64_t* g, unsigned epoch, float v) { __hip_atomic_store(g, ((u64_t)epoch << 32) | (u64_t)__float_as_uint(v), __ATOMIC_RELAXED, __HIP_MEMORY_SCOPE_AGENT); }
template <int N>
__device__ __forceinline__ void recv_gran(const u64_t* g, unsigned epoch, float (&out)[N]) {
    unsigned spins = 0;
    for (;;) { bool ok = true;
#pragma unroll
        for (int k = 0; k < N; ++k) { const u64_t x = __hip_atomic_load(g + k * 512, __ATOMIC_RELAXED, __HIP_MEMORY_SCOPE_AGENT); out[k] = __uint_as_float((unsigned)x); ok = ok && ((unsigned)(x >> 32) == epoch); }
        if (ok || ++spins > (1u << 20)) break; __builtin_amdgcn_s_sleep(2); }
}
#define LDS_WAIT() asm volatile("s_waitcnt lgkmcnt(0)" ::: "memory")

__device__ __forceinline__ void mma_seg(f32x4& acc, const bf16_t* A, int lda, const bf16_t* Bt, int ldb, int tm, int tn, int ksteps, int fr, int fq) {
    const bf16_t* ap = A + (tm * 16 + fr) * lda + fq * 8; const bf16_t* bp = Bt + (tn * 16 + fr) * ldb + fq * 8;
    for (int ks = 0; ks < ksteps; ++ks) {
        const bf16x8 a = *(const bf16x8*)(ap + ks * 32); const bf16x8 b = *(const bf16x8*)(bp + ks * 32);
        acc = __builtin_amdgcn_mfma_f32_16x16x32_bf16(a, b, acc, 0, 0, 0);
    }
}
#define ZERO4 ((f32x4){0.f, 0.f, 0.f, 0.f})
__device__ __forceinline__ void st4bf(bf16_t* dst, float a, float b, float c, float d) { uint2 w; w.x = pk2(a, b); w.y = pk2(c, d); *(uint2*)dst = w; }
__device__ __forceinline__ void mma_seg_bs(f32x4& acc, const bf16_t* A, int lda, const bf16_t* Bt, int ldb, int tm, int tn, int ksteps, int fr, int fq, int g) {
    const bf16_t* ap = A + (tm * 16 + fr) * lda + fq * 8; const bf16_t* bp = Bt + (tn * 16 + fr) * ldb;
    for (int ks = 0; ks < ksteps; ++ks) {
        const bf16x8 a = *(const bf16x8*)(ap + ks * 32); const bf16x8 b = *(const bf16x8*)(bp + ((ks * 32 + fq * 8) ^ (g << 3)));
        acc = __builtin_amdgcn_mfma_f32_16x16x32_bf16(a, b, acc, 0, 0, 0);
    }
}

#define LAS __attribute__((address_space(3)))
#define XB_TMO      128
#define XB_XCNT(j)  (256  + 64 * (j))
#define XB_XSUB(j)  (1280 + 64 * (j))
#define XB_XGEN(j)  (2304 + 64 * (j))
#define XB_TOP      3328
#define XB_TOPGEN   3392
#define XCD_BAR_WORDS 3456
#define XB_SPIN_CAP (1u << 18)

__device__ __forceinline__ unsigned xb_ld(unsigned* p)              { return __hip_atomic_load(p, __ATOMIC_RELAXED, __HIP_MEMORY_SCOPE_AGENT); }
__device__ __forceinline__ unsigned xb_add(unsigned* p, unsigned v) { return __hip_atomic_fetch_add(p, v, __ATOMIC_RELAXED, __HIP_MEMORY_SCOPE_AGENT); }
__device__ __forceinline__ unsigned xb_xcc_id() { return (unsigned)__builtin_amdgcn_s_getreg((3 << 11) | 20) & 0xFu; }
#define XB_SPIN(cond, bar) do { unsigned _sp = 0; while (cond) { __builtin_amdgcn_s_sleep(1); \
    if ((++_sp & 255u) == 0u) { if (xb_ld(&(bar)[XB_TMO])) break; if (_sp > XB_SPIN_CAP) { atomicAdd(&(bar)[XB_TMO], 1u); break; } } } } while (0)

struct XcdBarrier {
    unsigned* bar; unsigned x;
    volatile LAS unsigned* st;
};

__device__ __forceinline__ XcdBarrier xcd_barrier_post(unsigned* bar, volatile LAS unsigned* st) {
    XcdBarrier b; b.bar = bar; b.x = xb_xcc_id(); b.st = st;
    if (threadIdx.x == 0) (void)xb_add(&bar[XB_XCNT(b.x)], 1u);
    return b;
}
__device__ __forceinline__ void xcd_barrier_complete(unsigned* bar, unsigned x, unsigned& nloc, unsigned& nx) {
    const unsigned G = gridDim.x * gridDim.y * gridDim.z;
    unsigned sum, cnt, mine, sp = 0u;
    for (;;) {
        sum = 0u; cnt = 0u; mine = 0u;
#pragma unroll
        for (unsigned j = 0; j < 16; ++j) { const unsigned c = xb_ld(&bar[XB_XCNT(j)]); sum += c; cnt += (c > 0u) ? 1u : 0u; mine = (j == x) ? c : mine; }
        if (sum == G) break;
        __builtin_amdgcn_s_sleep(1);
        if ((++sp & 255u) == 0u) { if (xb_ld(&bar[XB_TMO])) break; if (sp > XB_SPIN_CAP) { atomicAdd(&bar[XB_TMO], 1u); break; } }
    }
    nloc = mine > 0u ? mine : 1u; nx = cnt > 0u ? cnt : 1u;
}

__device__ __forceinline__ void xcd_barrier(const XcdBarrier& b) {
    asm volatile("s_waitcnt vmcnt(0)" ::: "memory");
    __syncthreads();
    if (threadIdx.x == 0) {
        unsigned* bar = b.bar;
        __builtin_amdgcn_s_waitcnt(0);
        unsigned nloc = b.st[0], nx = b.st[1];
        if (nloc == 0u) { xcd_barrier_complete(bar, b.x, nloc, nx); b.st[0] = nloc; b.st[1] = nx; }
        const unsigned old = xb_add(&bar[XB_XSUB(b.x)], 1u);
        const unsigned gen = old / nloc;
        if (old + 1u == (gen + 1u) * nloc) {
            __builtin_amdgcn_fence(__ATOMIC_RELEASE, "agent");
            asm volatile("s_waitcnt vmcnt(0)" ::: "memory");
            const unsigned og = xb_add(&bar[XB_TOP], 1u);
            const unsigned tg = og / nx;
            if (og + 1u == (tg + 1u) * nx) xb_add(&bar[XB_TOPGEN], 1u);
            else XB_SPIN(xb_ld(&bar[XB_TOPGEN]) == tg, bar);
            __builtin_amdgcn_fence(__ATOMIC_ACQUIRE, "agent");
            xb_add(&bar[XB_XGEN(b.x)], 1u);
            asm volatile("s_waitcnt vmcnt(0)" ::: "memory");
        } else {
            XB_SPIN(xb_ld(&bar[XB_XGEN(b.x)]) == gen, bar);
            __builtin_amdgcn_fence(__ATOMIC_ACQUIRE, "agent");
            asm volatile("s_waitcnt vmcnt(0)" ::: "memory");
        }
    }
    __syncthreads();
}

__device__ __forceinline__ void transpose_item(const float* W, int K, int N, int nlimit, bf16_t* WT, float* scr, int item, int lane) {
    const int nblk = (nlimit + 31) / 32, kb = item / nblk, nb = item % nblk, k0 = 64 * kb, n0 = 32 * nb;
    const int nn = n0 + (lane & 31); const bool ok = nn < nlimit;
#pragma unroll 8
    for (int i = 0; i < 32; ++i) { const int kk = 2 * i + (lane >> 5); scr[kk * 33 + (lane & 31)] = ok ? W[(size_t)(k0 + kk) * N + nn] : 0.f; }
    LDS_WAIT();
    const int c = lane & 7;
#pragma unroll
    for (int j = 0; j < 4; ++j) { const int n = (lane >> 3) + 8 * j; const float* s = scr + (8 * c) * 33 + n;
        uint4 o; o.x = pk2(s[0 * 33], s[1 * 33]); o.y = pk2(s[2 * 33], s[3 * 33]); o.z = pk2(s[4 * 33], s[5 * 33]); o.w = pk2(s[6 * 33], s[7 * 33]);
        if (n0 + n < nlimit) *(uint4*)(WT + (size_t)(n0 + n) * K + k0 + 8 * c) = o; }
    LDS_WAIT();
}

__device__ __forceinline__ void prep_phase(const Prm& p, unsigned char* lds, int tid, int G) {
    const int wave = tid >> 6, lane = tid & 63, bid = blockIdx.x;
    unsigned char* ws = p.ws;
    for (int it = bid; it < 448; it += G) {
        if (it < 192) {
            const int l = it / 96, j0 = (it % 96) * 64;
            float* SIL = (float*)lds; float* RED = SIL + 5 * 1024;
            for (int e = tid; e < 5120; e += 512) { const float cv = e < 4096 ? p.in[1][e] : p.in[3][e - 4096]; SIL[e] = cv / (1.f + expf(-cv)); }
            __syncthreads();
            float a0 = 0.f, a1 = 0.f, a2 = 0.f, a3 = 0.f, a4 = 0.f;
            const float* wm = p.in[6] + ((size_t)l * 1024 + wave * 128) * 6144 + j0 + lane;
#pragma unroll 8
            for (int k = 0; k < 128; ++k) { const float w = wm[(size_t)k * 6144]; const int kk = wave * 128 + k;
                a0 += SIL[kk] * w; a1 += SIL[1024 + kk] * w; a2 += SIL[2048 + kk] * w; a3 += SIL[3072 + kk] * w; a4 += SIL[4096 + kk] * w; }
            RED[(wave * 5 + 0) * 64 + lane] = a0; RED[(wave * 5 + 1) * 64 + lane] = a1; RED[(wave * 5 + 2) * 64 + lane] = a2; RED[(wave * 5 + 3) * 64 + lane] = a3; RED[(wave * 5 + 4) * 64 + lane] = a4;
            __syncthreads();
            if (tid < 320) { const int bb = tid >> 6, ln = tid & 63; float s = p.in[7][l * 6144 + j0 + ln];
                for (int w = 0; w < 8; ++w) s += RED[(w * 5 + bb) * 64 + ln];
                ((float*)(ws + WS_MOD))[(l * 5 + bb) * 6144 + j0 + ln] = s; }
            __syncthreads();
        } else {
            const int f = it - 192; const int l = f >> 7, g = (f >> 5) & 3, part = (f >> 4) & 1, kc = f & 15;
            float* PP = (float*)lds; float* WCH = PP + 64 * 65; float* WF = WCH + 64 * 65; float* TB = WF + 64 * 65;
            for (int e = tid; e < 4096; e += 512) { const int r = e >> 6, c = e & 63;
                WF[r * 65 + c] = p.in[25][((size_t)(l * 4 + g) * 64 + r) * 64 + c];
                WCH[r * 65 + c] = p.in[8][((size_t)l * 1024 + kc * 64 + r) * WIN_N + NPLAIN + g * 64 + c]; }
            if (tid < 64) { float s, c; sincospif((float)tid / 32.f, &s, &c); TB[tid] = 0.125f * (part ? -s : c); }
            __syncthreads();
            { const int c = tid >> 3, d0 = (tid & 7) * 8; float acc[8];
#pragma unroll
              for (int e = 0; e < 8; ++e) acc[e] = 0.f;
              for (int c2 = 0; c2 < 64; ++c2) { const float tb = TB[(c * c2) & 63];
#pragma unroll
                  for (int e = 0; e < 8; ++e) acc[e] += tb * WF[c2 * 65 + d0 + e]; }
#pragma unroll
              for (int e = 0; e < 8; ++e) PP[c * 65 + d0 + e] = acc[e]; }
            __syncthreads();
            { const int d = tid >> 3, ko = tid & 7; float acc[8];
#pragma unroll
              for (int e = 0; e < 8; ++e) acc[e] = 0.f;
              for (int c = 0; c < 64; ++c) { const float pv = PP[c * 65 + d];
#pragma unroll
                  for (int e = 0; e < 8; ++e) acc[e] += WCH[(ko * 8 + e) * 65 + c] * pv; }
              bf16_t* wt = (bf16_t*)(ws + WS_WIN) + ((size_t)l * LDU + C_FZ + part * 256 + g * 64 + d) * 1024 + kc * 64 + ko * 8;
              *(uint4*)wt = pack8(acc); }
            __syncthreads();
        }
    }
    { const int gt = bid * 512 + tid, NG = G * 512; const uint4 z = {0u, 0u, 0u, 0u};
      for (int e = gt; e < 2 * 112 * 128; e += NG) { const int l = e / (112 * 128), r = e % (112 * 128);
          *(uint4*)((bf16_t*)(ws + WS_WIN) + ((size_t)l * LDU + 3472) * 1024 + (size_t)r * 8) = z; } }
    if (bid == 0) { const uint4 z = {0u, 0u, 0u, 0u}; for (int e = tid; e < 16384 / 16; e += 512) *(uint4*)(ws + WS_BARW + (size_t)e * 16) = z; }
    { const int gt = bid * 512 + tid, NG = G * 512; const uint4 z = {0u, 0u, 0u, 0u};
      for (int e = gt; e < (int)((WS_END2 - WS_SBR) / 16); e += NG) *(uint4*)(ws + WS_SBR + (size_t)e * 16) = z; }
    float* scr = (float*)(lds + wave * 8448);
    const int gw = bid * 8 + wave, NGW = G * 8;
    for (int it = gw; it < 2 * 6096; it += NGW) {
        const int l = it / 6096; int r = it % 6096;
        if (r < 1488) { transpose_item(p.in[8] + (size_t)l * 1024 * WIN_N, 1024, WIN_N, NPLAIN, (bf16_t*)(ws + WS_WIN) + (size_t)l * LDU * 1024, scr, r, lane); continue; } r -= 1488;
        if (r < 512) { transpose_item(p.in[9] + (size_t)l * 1024 * 1024, 1024, 1024, 1024, (bf16_t*)(ws + WS_WOUT) + (size_t)l * 1024 * 1024, scr, r, lane); continue; } r -= 512;
        if (r < 2048) { transpose_item(p.in[26] + (size_t)l * 1024 * 4096, 1024, 4096, 4096, (bf16_t*)(ws + WS_W1) + (size_t)l * 4096 * 1024, scr, r, lane); continue; } r -= 2048;
        transpose_item(p.in[27] + (size_t)l * 4096 * 1024, 4096, 1024, 1024, (bf16_t*)(ws + WS_W2) + (size_t)l * 1024 * 4096, scr, r, lane);
    }
    __syncthreads();
}

__device__ __forceinline__ void norm_phase(const Prm& p, int l, int mode, int tid, int G) {
    const int wave = tid >> 6, lane = tid & 63; const int gw = blockIdx.x * 8 + wave, NGW = G * 8;
    const int nrows = (mode == 2 || (mode == 1 && l == 1)) ? ML : M;
    const float* gvec = mode == 2 ? p.in[28] : (mode == 1 ? p.in[5] + l * 1024 : p.in[4] + l * 1024);
    const float* modb = (const float*)(p.ws + WS_MOD) + (size_t)l * 5 * 6144;
    bf16_t* HN = (bf16_t*)(p.ws + WS_HN);
    const bool first = (l == 0 && mode == 0);
    for (int row = gw; row < nrows; row += NGW) {
        const bool lat = row < ML; const int bb = lat ? (row >> 13) : 4;
        const float* src = lat ? ((first ? p.in[0] : p.out) + (size_t)row * 1024) : ((first ? p.in[2] : (const float*)(p.ws + WS_XC)) + (size_t)(row - ML) * 1024);
        f32x4 v[4]; float ss = 0.f;
#pragma unroll
        for (int j = 0; j < 4; ++j) { v[j] = *(const f32x4*)(src + j * 256 + lane * 4); ss += (v[j][0] * v[j][0] + v[j][1] * v[j][1]) + (v[j][2] * v[j][2] + v[j][3] * v[j][3]); }
        const float rinv = rsqrtf(wave_sum(ss) * (1.f / 1024.f) + 1e-6f);
        if (mode == 2) {
#pragma unroll
            for (int j = 0; j < 4; ++j) { const f32x4 g = *(const f32x4*)(gvec + j * 256 + lane * 4); *(f32x4*)(p.out + (size_t)row * 1024 + j * 256 + lane * 4) = v[j] * rinv * g; }
        } else {
            const float* sh = modb + bb * 6144 + (mode ? 3 : 0) * 1024; const float* sc = modb + bb * 6144 + (mode ? 4 : 1) * 1024;
#pragma unroll
            for (int j = 0; j < 4; ++j) { const int c = j * 256 + lane * 4; const f32x4 g = *(const f32x4*)(gvec + c), s1 = *(const f32x4*)(sh + c), s2 = *(const f32x4*)(sc + c);
                const f32x4 y = (v[j] * rinv * g) * (s2 + 1.f) + s1;
                uint2 o; o.x = pk2(y[0], y[1]); o.y = pk2(y[2], y[3]); *(uint2*)(HN + (size_t)row * 1024 + c) = o; }
        }
    }
}

__device__ __forceinline__ void lerp8(const bf16_t* U, size_t row, int col, bool isctx, int t, const float* mu, float* out) {
    const bf16_t* bp = U + row * LDU + col;
    const uint4 own = *(const uint4*)bp; const uint4 z = {0u, 0u, 0u, 0u};
    uint4 n0, n1, n2, n3;
    if (isctx) { n0 = (t > 0) ? *(const uint4*)(bp - LDU) : z; n1 = (t < TC - 1) ? *(const uint4*)(bp + LDU) : z; n2 = n0; n3 = n1; }
    else { const int gx = t & 63, gy = t >> 6;
        n0 = (gx > 0) ? *(const uint4*)(bp - LDU) : z; n1 = (gx < 63) ? *(const uint4*)(bp + LDU) : z;
        n2 = (gy > 0) ? *(const uint4*)(bp - 64 * LDU) : z; n3 = (gy < 127) ? *(const uint4*)(bp + 64 * LDU) : z; }
#pragma unroll
    for (int e = 0; e < 8; ++e) { const float o = bfe(own, e); const float nb = (e & 3) == 0 ? bfe(n0, e) : (e & 3) == 1 ? bfe(n1, e) : (e & 3) == 2 ? bfe(n2, e) : bfe(n3, e);
        out[e] = o + mu[e] * (nb - o); }
}

__device__ __forceinline__ void lerp8_load(const bf16_t* U, size_t row, int col, bool isctx, int t, uint4 (&r)[5]) {
    const bf16_t* bp = U + row * LDU + col; const uint4 z = {0u, 0u, 0u, 0u};
    r[0] = *(const uint4*)bp;
    if (isctx) { r[1] = (t > 0) ? *(const uint4*)(bp - LDU) : z; r[2] = (t < TC - 1) ? *(const uint4*)(bp + LDU) : z; r[3] = r[1]; r[4] = r[2]; }
    else { const int gx = t & 63, gy = t >> 6;
        r[1] = (gx > 0) ? *(const uint4*)(bp - LDU) : z; r[2] = (gx < 63) ? *(const uint4*)(bp + LDU) : z;
        r[3] = (gy > 0) ? *(const uint4*)(bp - 64 * LDU) : z; r[4] = (gy < 127) ? *(const uint4*)(bp + 64 * LDU) : z; }
}
__device__ __forceinline__ void lerp8_apply(const uint4 (&r)[5], const float* mu, float* out) {
#pragma unroll
    for (int e = 0; e < 8; ++e) { const float o = bfe(r[0], e); const float nb = (e & 3) == 0 ? bfe(r[1], e) : (e & 3) == 1 ? bfe(r[2], e) : (e & 3) == 2 ? bfe(r[3], e) : bfe(r[4], e);
        out[e] = o + mu[e] * (nb - o); }
}
__device__ __forceinline__ void chunk_coords(int c, int b, int d, int n, bool& isctx, int& t0, size_t& rowbase) {
    isctx = c < 4; const int cc = isctx ? c : c - 4; const int nch = isctx ? 4 : 128;
    t0 = (d ? (nch - 1 - cc) : cc) * 64; rowbase = isctx ? (size_t)(ML + b * TC + t0) : (size_t)(b * T + t0); (void)n;
}
__device__ __forceinline__ void gdn_raw_load(const bf16_t* U, int b, int h, int d, int c, int tid, uint4 (&rv)[7]) {
    const bool isctx = c < 4; const int cc = isctx ? c : c - 4; const int nch = isctx ? 4 : 128; const int slen = isctx ? TC : T;
    const int t0 = (d ? (nch - 1 - cc) : cc) * 64; const size_t seqbase = isctx ? (size_t)(ML + b * TC) : (size_t)(b * T);
#pragma unroll
    for (int it = 0; it < 7; ++it) { const int pc = tid + it * 512; const int rr = pc / 48, pi = pc % 48; const int tt = t0 - 2 + rr;
        const int col = pi < 16 ? C_GQ + h * 128 + pi * 8 : pi < 32 ? C_GK + h * 128 + (pi - 16) * 8 : C_GV + h * 128 + (pi - 32) * 8;
        rv[it] = (uint4){0u, 0u, 0u, 0u}; if (pc < 68 * 48 && tt >= 0 && tt < slen) rv[it] = *(const uint4*)(U + (seqbase + tt) * LDU + col); }
}

template <int MODE>
__device__ __forceinline__ void trinv64(const bf16_t* LA, const float* LD, bf16_t* TA, int ldt, bf16_t* TT, bf16_t* WT, bf16_t* T1, bf16_t* T2, const float* s1, const float* s2, int tid, int wave, int fr, int fq) {
    if (wave == 0) { const int bi = (tid & 63) >> 4, cc = tid & 15; const float* A = LD + bi * 256; float dcol[16];
#pragma unroll
        for (int r = 0; r < 16; ++r) { float v = (r == cc) ? 1.f : 0.f;
#pragma unroll
            for (int j = 0; j < r; ++j) v -= A[r * 16 + j] * dcol[j];
            dcol[r] = v; }
#pragma unroll
        for (int r = 0; r < 16; ++r) { const int R = bi * 16 + r, Cc = bi * 16 + cc; const bf16_t bv = f2bf(dcol[r]); TA[R * ldt + Cc] = bv; TT[Cc * 72 + R] = bv;
            if (MODE == 1) T1[R * 72 + Cc] = f2bf(dcol[r] * s1[Cc]); }
    } else { for (int e = tid - 64; e < 4096; e += 448) { const int r = e >> 6, c = e & 63; if ((r >> 4) != (c >> 4)) TT[r * 72 + c] = 0; WT[r * 72 + c] = 0; } }
    __syncthreads();
    if (wave < 2) { const int tm = 2 * wave + 1, tn = 2 * wave, ko = 32 * wave, r0 = tm * 16 + fq * 4, c = tn * 16 + fr;
        f32x4 acc = ZERO4; mma_seg(acc, LA + ko, 72, TT + ko, 72, tm, tn, 1, fr, fq);
#pragma unroll
        for (int j = 0; j < 4; ++j) WT[c * 72 + r0 + j] = f2bf(acc[j]); }
    __syncthreads();
    if (wave < 2) { const int tm = 2 * wave + 1, tn = 2 * wave, ko = 32 * wave, r0 = tm * 16 + fq * 4, c = tn * 16 + fr;
        f32x4 acc = ZERO4; mma_seg(acc, TA + ko, ldt, WT + ko, 72, tm, tn, 1, fr, fq);
#pragma unroll
        for (int j = 0; j < 4; ++j) { const float v = -acc[j]; const bf16_t bv = f2bf(v); TA[(r0 + j) * ldt + c] = bv; TT[c * 72 + r0 + j] = bv;
            if (MODE == 1) T1[(r0 + j) * 72 + c] = f2bf(v * s1[c]); } }
    __syncthreads();
    if (wave < 4) { const int tm = 2 + (wave >> 1), tn = wave & 1, r0 = tm * 16 + fq * 4, c = tn * 16 + fr;
        f32x4 acc = ZERO4; mma_seg(acc, LA, 72, TT, 72, tm, tn, 1, fr, fq);
#pragma unroll
        for (int j = 0; j < 4; ++j) WT[c * 72 + r0 + j] = f2bf(acc[j]); }
    __syncthreads();
    if (wave < 4) { const int tm = 2 + (wave >> 1), tn = wave & 1, r0 = tm * 16 + fq * 4, c = tn * 16 + fr;
        f32x4 acc = ZERO4; mma_seg(acc, TA + 32, ldt, WT + 32, 72, tm, tn, 1, fr, fq);
#pragma unroll
        for (int j = 0; j < 4; ++j) { const float v = -acc[j]; TA[(r0 + j) * ldt + c] = f2bf(v);
            if (MODE == 1) T1[(r0 + j) * 72 + c] = f2bf(v * s1[c]); } }
    __syncthreads();
}
__device__ __forceinline__ void rwkv_scan(const Prm& p, int l, int sid, int kblk, int nblk, unsigned char* lds, int tid) {
    const int b = sid >> 3, h = (sid >> 1) & 3, d = sid & 1;
    const int wave = tid >> 6, lane = tid & 63, fr = lane & 15, fq = lane >> 4;
    bf16_t* TL = (bf16_t*)lds;
#define RTILE(i) (TL + (i) * 4608)
    bf16_t *S0bf = RTILE(0), *KT = RTILE(1), *BTl = RTILE(2), *KL = RTILE(3), *KTt = RTILE(4), *RT = RTILE(5), *VT = RTILE(6), *BS = RTILE(7),
           *LK = RTILE(9), *MB = RTILE(10), *MK = RTILE(11), *LA = RTILE(14), *TT = RTILE(1), *WT = RTILE(2),
           *TW = RTILE(12), *X1T = RTILE(1), *PT = RTILE(2);
    float* XW = (float*)RTILE(9); float* XAf = XW + 64 * 65; bf16_t* TWD = (bf16_t*)(XAf + 64 * 65); bf16_t* ADl = TWD + 64 * 40;
    unsigned char* cb = lds + 15 * 9216;
    bf16_t* WUPt = (bf16_t*)cb; bf16_t* AUPt = WUPt + 64 * 40; float* CV = (float*)(cb + 10240); float* GL = CV + 320; float* SEG = GL + 64; float* LD = SEG + 512;
#undef RTILE
    const bf16_t* U = (const bf16_t*)(p.ws + WS_U);
    bf16_t* ORp = (bf16_t*)(p.ws + WS_OR); float* BC = (float*)(p.ws + WS_BC);
    const int n = tid >> 3, jq = tid & 7, j0 = jq * 8; const int i = d ? 63 - n : n;
    for (int e = tid; e < 2048; e += 512) { const int q = e >> 6, j = e & 63;
        WUPt[j * 40 + q] = f2bf(p.in[12][((size_t)(l * 2 + d) * 32 + q) * 256 + h * 64 + j]);
        AUPt[j * 40 + q] = f2bf(p.in[14][((size_t)(l * 2 + d) * 32 + q) * 256 + h * 64 + j]); }
    if (tid < 64) { CV[tid] = p.in[11][(l * 2 + d) * 256 + h * 64 + tid]; CV[64 + tid] = p.in[13][(l * 2 + d) * 256 + h * 64 + tid];
        CV[128 + tid] = p.in[16][l * 256 + h * 64 + tid]; CV[192 + tid] = p.in[17][l * 256 + h * 64 + tid]; CV[256 + tid] = p.in[18][l * 256 + h * 64 + tid]; }
    f32x4 accS[2]; accS[0] = ZERO4; accS[1] = ZERO4;
    u64_t* SB = (u64_t*)(p.ws + WS_SBR) + (size_t)sid * 2 * 4096; const unsigned fbase = (unsigned)l * 132u;
    float r8[8], k8[8], v8[8], x8[8];
    { const int n0_ = tid >> 3, j00 = (tid & 7) * 8; bool ic; int t0_; size_t rb_; chunk_coords(kblk, b, d, n0_, ic, t0_, rb_);
      uint4 q0[5], q1[5], q2[5], q3[5];
      lerp8_load(U, rb_ + n0_, h * 64 + j00, ic, t0_ + n0_, q0); lerp8_load(U, rb_ + n0_, 256 + h * 64 + j00, ic, t0_ + n0_, q1);
      lerp8_load(U, rb_ + n0_, 512 + h * 64 + j00, ic, t0_ + n0_, q2); lerp8_load(U, rb_ + n0_, 768 + j00, ic, t0_ + n0_, q3);
      float m0[8], m1[8], m2[8], m3[8]; const float* mup = p.in[10] + l * 896 + j00;
#pragma unroll
      for (int e = 0; e < 8; ++e) { m0[e] = mup[h * 64 + e]; m1[e] = mup[256 + h * 64 + e]; m2[e] = mup[512 + h * 64 + e]; m3[e] = mup[768 + e]; }
      lerp8_apply(q0, m0, r8); lerp8_apply(q1, m1, k8); lerp8_apply(q2, m2, v8); lerp8_apply(q3, m3, x8); }
    __syncthreads();
    for (int c = kblk; c < 132; c += nblk) {
        int tid2 = threadIdx.x; asm volatile("" : "+v"(tid2)); const int tid = tid2;
        const int wave = tid2 >> 6, lane = tid2 & 63, fr = tid2 & 15, fq = (tid2 >> 4) & 3, n = tid2 >> 3, jq = tid2 & 7;
        const int j0 = jq * 8; const int i = d ? 63 - n : n;
        const bool isctx = c < 4; const int cc = isctx ? c : c - 4; const int nch = isctx ? 4 : 128;
        const int t0 = (d ? (nch - 1 - cc) : cc) * 64;
        const size_t rowbase = isctx ? (size_t)(ML + b * TC + t0) : (size_t)(b * T + t0);
        const int t = t0 + n; const size_t row = rowbase + n;
        if (jq < 4) {
#pragma unroll
            for (int e = 0; e < 8; ++e) TWD[i * 40 + j0 + e] = f2bf(ftanh(x8[e]));
        } else {
#pragma unroll
            for (int e = 0; e < 8; ++e) ADl[i * 40 + j0 - 32 + e] = f2bf(x8[e]);
        }
        __syncthreads();
#pragma unroll
        for (int q = 0; q < 2; ++q) { const int tile = wave + 8 * q, tm = tile >> 2, tn = tile & 3, r0 = tm * 16 + fq * 4, cc2 = tn * 16 + fr;
            f32x4 a1 = ZERO4, a2 = ZERO4; mma_seg(a1, TWD, 40, WUPt, 40, tm, tn, 1, fr, fq); mma_seg(a2, ADl, 40, AUPt, 40, tm, tn, 1, fr, fq);
#pragma unroll
            for (int j = 0; j < 4; ++j) { XW[(r0 + j) * 65 + cc2] = a1[j]; XAf[(r0 + j) * 65 + cc2] = a2[j]; } }
        __syncthreads();
        float a8[8], kd8[8], kk8[8]; float ss = 0.f, bcp = 0.f;
#pragma unroll
        for (int e = 0; e < 8; ++e) { const int j = j0 + e; const float xw = XW[i * 65 + j] + CV[j], xa = XAf[i * 65 + j] + CV[64 + j];
            const float a = sigmoidf_(xa); const float wl = -softplusf_(-xw) - 0.5f; const float lw = -fexp(wl);
            const float kd = k8[e] * (1.f + (a - 1.f) * CV[192 + j]); const float kkr = k8[e] * CV[128 + j];
            ss += kkr * kkr; bcp += r8[e] * kd * CV[256 + j]; a8[e] = a; kd8[e] = kd; kk8[e] = kkr; XW[i * 65 + j] = lw; }
        ss += shx1(ss); ss += shx2(ss); ss += shx4(ss);
        bcp += shx1(bcp); bcp += shx2(bcp); bcp += shx4(bcp);
        { const float rn = rsqrtf(ss + 1e-12f);
#pragma unroll
          for (int e = 0; e < 8; ++e) kk8[e] *= rn; }
        if (jq == 0) BC[((size_t)d * M + row) * 4 + h] = bcp;
        __syncthreads();
        { const int sg = tid >> 6, j = tid & 63; float s = 0.f;
#pragma unroll
          for (int ii = 0; ii < 8; ++ii) s += XW[(sg * 8 + ii) * 65 + j];
          SEG[sg * 64 + j] = s;
          __syncthreads();
          float pre = 0.f; for (int s2 = 0; s2 < sg; ++s2) pre += SEG[s2 * 64 + j];
#pragma unroll
          for (int ii = 0; ii < 8; ++ii) { pre += XW[(sg * 8 + ii) * 65 + j]; XW[(sg * 8 + ii) * 65 + j] = pre; } }
        __syncthreads();
        { float o_kt[8], o_bt[8], o_kl[8], o_rt[8];
#pragma unroll
          for (int e = 0; e < 8; ++e) { const int j = j0 + e; const float lwi = XW[i * 65 + j], lwm = i > 0 ? XW[(i - 1) * 65 + j] : 0.f, lwl = XW[63 * 65 + j];
              const float em = fexp(lwm), ei = fexp(lwi), eni = fexp(-lwi), el = fexp(lwl - lwi); const float b_ = kk8[e] * a8[e];
              o_kt[e] = kk8[e] * em; o_bt[e] = b_ * eni; o_kl[e] = kd8[e] * eni; o_rt[e] = r8[e] * ei;
              KTt[j * 72 + i] = f2bf(o_kt[e]); BS[j * 136 + i] = f2bf(b_ * el); BS[j * 136 + 64 + i] = f2bf(kd8[e] * el); VT[j * 72 + i] = f2bf(v8[e]);
              if (i == 63) GL[j] = ei; }
          *(uint4*)(KT + i * 72 + j0) = pack8(o_kt); *(uint4*)(BTl + i * 72 + j0) = pack8(o_bt); *(uint4*)(KL + i * 72 + j0) = pack8(o_kl); *(uint4*)(RT + i * 72 + j0) = pack8(o_rt); }
        __syncthreads();
        const int cn = c + nblk; const bool have_next = cn < 132;
        uint4 pq0[5], pq1[5], pq2[5], pq3[5];
        if (have_next) { bool ic; int t0n; size_t rbn; chunk_coords(cn, b, d, n, ic, t0n, rbn);
            lerp8_load(U, rbn + n, h * 64 + j0, ic, t0n + n, pq0); lerp8_load(U, rbn + n, 256 + h * 64 + j0, ic, t0n + n, pq1);
            lerp8_load(U, rbn + n, 512 + h * 64 + j0, ic, t0n + n, pq2); lerp8_load(U, rbn + n, 768 + j0, ic, t0n + n, pq3); }
        { const uint4 z4 = {0u, 0u, 0u, 0u}; *(uint4*)(TW + (tid >> 3) * 136 + (tid & 7) * 8) = z4; }
#pragma unroll
        for (int q = 0; q < 2; ++q) { const int tile = wave + 8 * q, tm = tile >> 2, tn = tile & 3, r0 = tm * 16 + fq * 4, cx = tn * 16 + fr;
            f32x4 a1 = ZERO4, a2 = ZERO4, a3 = ZERO4, a4 = ZERO4;
            { const int ao = (tm * 16 + fr) * 72 + fq * 8, bo = (tn * 16 + fr) * 72 + fq * 8;
#pragma unroll
              for (int ks = 0; ks < 2; ++ks) { const bf16x8 fk = *(const bf16x8*)(KT + ao + ks * 32), fr_ = *(const bf16x8*)(RT + ao + ks * 32), fb = *(const bf16x8*)(BTl + bo + ks * 32), fl = *(const bf16x8*)(KL + bo + ks * 32);
                  a1 = __builtin_amdgcn_mfma_f32_16x16x32_bf16(fk, fb, a1, 0, 0, 0); a2 = __builtin_amdgcn_mfma_f32_16x16x32_bf16(fk, fl, a2, 0, 0, 0);
                  a3 = __builtin_amdgcn_mfma_f32_16x16x32_bf16(fr_, fb, a3, 0, 0, 0); a4 = __builtin_amdgcn_mfma_f32_16x16x32_bf16(fr_, fl, a4, 0, 0, 0); } }
#pragma unroll
            for (int j = 0; j < 4; ++j) { const int r = r0 + j; const float x0 = (cx < r) ? a1[j] : 0.f;
                LA[r * 72 + cx] = f2bf(x0); if (tm == tn) LD[tm * 256 + (r & 15) * 16 + (cx & 15)] = x0;
                LK[r * 72 + cx] = f2bf(cx < r ? a2[j] : 0.f); MB[r * 72 + cx] = f2bf(cx <= r ? a3[j] : 0.f); MK[r * 72 + cx] = f2bf(cx <= r ? a4[j] : 0.f); } }
        __syncthreads();
        trinv64<0>(LA, LD, TW, 136, TT, WT, nullptr, nullptr, nullptr, nullptr, tid, wave, fr, fq);
        f32x4 accO[2];
#pragma unroll
        for (int q = 0; q < 2; ++q) { const int tile = wave + 8 * q, tm = tile >> 2, tn = tile & 3, r0 = tm * 16 + fq * 4, cx = tn * 16 + fr;
            f32x4 a1 = ZERO4, a2 = ZERO4; mma_seg(a1, TW, 136, KTt, 72, tm, tn, 2, fr, fq); mma_seg(a2, LK, 72, VT, 72, tm, tn, 2, fr, fq);
#pragma unroll
            for (int j = 0; j < 4; ++j) TW[(r0 + j) * 136 + 64 + cx] = f2bf(a1[j]);
            st4bf(X1T + cx * 72 + r0, a2[0], a2[1], a2[2], a2[3]);
            accO[q] = ZERO4; mma_seg(accO[q], MK, 72, VT, 72, tm, tn, 2, fr, fq); }
        if (have_next) { float m0[8], m1[8], m2[8], m3[8]; const float* mup = p.in[10] + l * 896 + j0;
#pragma unroll
            for (int e = 0; e < 8; ++e) { m0[e] = mup[h * 64 + e]; m1[e] = mup[256 + h * 64 + e]; m2[e] = mup[512 + h * 64 + e]; m3[e] = mup[768 + e]; }
            lerp8_apply(pq0, m0, r8); lerp8_apply(pq1, m1, k8); lerp8_apply(pq2, m2, v8); lerp8_apply(pq3, m3, x8); }
        if (c > 0) { float sv[8]; recv_gran<8>(SB + (c & 1) * 4096 + tid, fbase + (unsigned)c, sv);
#pragma unroll
            for (int q = 0; q < 2; ++q)
#pragma unroll
                for (int j = 0; j < 4; ++j) accS[q][j] = sv[q * 4 + j];
        } else { accS[0] = ZERO4; accS[1] = ZERO4; }
#pragma unroll
        for (int q = 0; q < 2; ++q) { const int tile = wave + 8 * q, tm = tile >> 2, tn = tile & 3;
#pragma unroll
            for (int j = 0; j < 4; ++j) S0bf[(tm * 16 + fq * 4 + j) * 72 + tn * 16 + fr] = f2bf(accS[q][j]); }
        __syncthreads();
#pragma unroll
        for (int q = 0; q < 2; ++q) { const int tile = wave + 8 * q, tm = tile >> 2, tn = tile & 3, r0 = tm * 16 + fq * 4, cx = tn * 16 + fr;
            f32x4 a1 = ZERO4; mma_seg(a1, TW, 136, X1T, 72, tm, tn, 2, fr, fq); mma_seg(a1, TW + 64, 136, S0bf, 72, tm, tn, 2, fr, fq);
            st4bf(PT + cx * 72 + r0, -a1[0], -a1[1], -a1[2], -a1[3]); }
        __syncthreads();
        { u64_t* sbn = SB + ((c + 1) & 1) * 4096; const unsigned ep = fbase + (unsigned)c + 1u;
#pragma unroll
          for (int q = 0; q < 2; ++q) { const int tile = wave + 8 * q, tm = tile >> 2, tn = tile & 3, cx = tn * 16 + fr;
              const float g = GL[cx]; accS[q] = accS[q] * g;
              mma_seg(accS[q], PT, 72, BS, 136, tm, tn, 2, fr, fq); mma_seg(accS[q], VT, 72, BS + 64, 136, tm, tn, 2, fr, fq);
#pragma unroll
              for (int j = 0; j < 4; ++j) st_gran(sbn + (q * 4 + j) * 512 + tid, ep, accS[q][j]); } }
#pragma unroll
        for (int q = 0; q < 2; ++q) { const int tile = wave + 8 * q, tm = tile >> 2, tn = tile & 3, r0 = tm * 16 + fq * 4, cx = tn * 16 + fr;
            mma_seg(accO[q], RT, 72, S0bf, 72, tm, tn, 2, fr, fq); mma_seg(accO[q], MB, 72, PT, 72, tm, tn, 2, fr, fq);
#pragma unroll
            for (int j = 0; j < 4; ++j) { const int tt = r0 + j; const int nn = d ? 63 - tt : tt;
                ORp[((size_t)d * M + rowbase + nn) * 256 + h * 64 + cx] = f2bf(accO[q][j]); } }
        __syncthreads();
    }
}

__device__ __forceinline__ void gdn_scan(const Prm& p, int l, int sid, int kblk, int nblk, unsigned char* lds, int tid) {
    const int b = sid >> 3, h = (sid >> 1) & 3, d = sid & 1;
    bf16_t* STbf = (bf16_t*)lds; bf16_t* Qn = (bf16_t*)(lds + 17408); bf16_t* KNt = (bf16_t*)(lds + 34816); bf16_t* VT = (bf16_t*)(lds + 53248); bf16_t* QKd = (bf16_t*)(lds + 71680);
    bf16_t* XP = (bf16_t*)(lds + 80896);
    bf16_t *LA = XP, *TT = XP + 4608, *WT = XP + 2 * 4608, *TA = XP + 3 * 4608, *T1 = XP + 4 * 4608;
    bf16_t *VNt = LA, *VNs = TT, *RAW = QKd;
    bf16_t* KN = (bf16_t*)(lds + 126976); bf16_t* Wm = KN;
    float* GLs = (float*)(lds + 144384); float* GC = GLs + 64; float* BETA = GC + 64; float* SC1 = BETA + 64; float* CW = SC1 + 64; float* LD = CW + 1920;
    const bf16_t* U = (const bf16_t*)(p.ws + WS_U); bf16_t* OGp = (bf16_t*)(p.ws + WS_OG);
    for (int e = tid; e < 1920; e += 512) { const int tap = e / 384, cc = e % 384;
        const int ch = cc < 128 ? h * 128 + cc : cc < 256 ? 512 + h * 128 + (cc - 128) : 1024 + h * 128 + (cc - 256);
        CW[e] = p.in[21][((size_t)l * 5 + tap) * 1536 + ch]; }
    const float a_exp = fexp(p.in[22][(l * 2 + d) * 4 + h]); const float dtb = p.in[23][(l * 2 + d) * 4 + h];
    f32x4 accS[8];
#pragma unroll
    for (int q = 0; q < 8; ++q) accS[q] = ZERO4;
    u64_t* SB = (u64_t*)(p.ws + WS_SBG) + (size_t)sid * 2 * 16384; const unsigned fbase = (unsigned)l * 132u;
    uint4 rv[7]; gdn_raw_load(U, b, h, d, kblk, tid, rv);
    __syncthreads();
    for (int c = kblk; c < 132; c += nblk) {
        int tid2 = threadIdx.x; asm volatile("" : "+v"(tid2)); const int tid = tid2;
        const int wave = tid2 >> 6, lane = tid2 & 63, fr = tid2 & 15, fq = (tid2 >> 4) & 3, n = tid2 >> 3, jq = tid2 & 7;
        const int i = d ? 63 - n : n;
        const bool isctx = c < 4; const int cc = isctx ? c : c - 4; const int nch = isctx ? 4 : 128; const int slen = isctx ? TC : T;
        const int t0 = (d ? (nch - 1 - cc) : cc) * 64;
        const size_t seqbase = isctx ? (size_t)(ML + b * TC) : (size_t)(b * T);
        const size_t rowbase = seqbase + t0;
#pragma unroll
        for (int it = 0; it < 7; ++it) { const int pc = tid + it * 512; const int rr = pc / 48, pi = pc % 48; if (pc < 68 * 48) *(uint4*)(RAW + rr * 392 + pi * 8) = rv[it]; }
        __syncthreads();
        { float qv[16];
          const bf16_t* up = U + (rowbase + n) * LDU + C_GS; const float beta_n = sigmoidf_(bf2f(up[d * 4 + h]));
#pragma unroll
          for (int e = 0; e < 16; ++e) qv[e] = 0.f;
#pragma unroll
          for (int tap = 0; tap < 5; ++tap) { const uint4 r0 = *(const uint4*)(RAW + (n + tap) * 392 + jq * 16), r1 = *(const uint4*)(RAW + (n + tap) * 392 + jq * 16 + 8);
              const float* cw = CW + tap * 384 + jq * 16;
#pragma unroll
              for (int e = 0; e < 8; ++e) { qv[e] += cw[e] * bfe(r0, e); qv[8 + e] += cw[8 + e] * bfe(r1, e); } }
          float sq = 0.f;
#pragma unroll
          for (int e = 0; e < 16; ++e) { const float a = siluf_(qv[e]); qv[e] = a; sq += a * a; }
          sq += shx1(sq); sq += shx2(sq); sq += shx4(sq);
          { const float rq = rsqrtf(sq + 1e-6f) * 0.08838834764831845f;
#pragma unroll
            for (int e = 0; e < 16; ++e) qv[e] *= rq; }
          *(uint4*)(Qn + i * 136 + jq * 16) = pack8(qv); *(uint4*)(Qn + i * 136 + jq * 16 + 8) = pack8(qv + 8);
          __builtin_amdgcn_sched_barrier(0);
#pragma unroll
          for (int e = 0; e < 16; ++e) qv[e] = 0.f;
#pragma unroll
          for (int tap = 0; tap < 5; ++tap) { const uint4 r0 = *(const uint4*)(RAW + (n + tap) * 392 + 128 + jq * 16), r1 = *(const uint4*)(RAW + (n + tap) * 392 + 128 + jq * 16 + 8);
              const float* cw = CW + tap * 384 + 128 + jq * 16;
#pragma unroll
              for (int e = 0; e < 8; ++e) { qv[e] += cw[e] * bfe(r0, e); qv[8 + e] += cw[8 + e] * bfe(r1, e); } }
          float sk = 0.f;
#pragma unroll
          for (int e = 0; e < 16; ++e) { const float a = siluf_(qv[e]); qv[e] = a; sk += a * a; }
          sk += shx1(sk); sk += shx2(sk); sk += shx4(sk);
          { const float rk = rsqrtf(sk + 1e-6f);
#pragma unroll
            for (int e = 0; e < 16; ++e) { qv[e] *= rk; KNt[(jq * 16 + e) * 72 + (i ^ (jq << 3))] = f2bf(qv[e]); } }
          *(uint4*)(KN + i * 136 + jq * 16) = pack8(qv); *(uint4*)(KN + i * 136 + jq * 16 + 8) = pack8(qv + 8);
          __builtin_amdgcn_sched_barrier(0);
#pragma unroll
          for (int e = 0; e < 16; ++e) qv[e] = 0.f;
#pragma unroll
          for (int tap = 0; tap < 5; ++tap) { const uint4 r0 = *(const uint4*)(RAW + (n + tap) * 392 + 256 + jq * 16), r1 = *(const uint4*)(RAW + (n + tap) * 392 + 256 + jq * 16 + 8);
              const float* cw = CW + tap * 384 + 256 + jq * 16;
#pragma unroll
              for (int e = 0; e < 8; ++e) { qv[e] += cw[e] * bfe(r0, e); qv[8 + e] += cw[8 + e] * bfe(r1, e); } }
#pragma unroll
          for (int e = 0; e < 16; ++e) VT[(jq * 16 + e) * 72 + (i ^ (jq << 3))] = f2bf(siluf_(qv[e]) * beta_n);
          if (jq == 0) { const float sa = bf2f(up[8 + d * 4 + h]); BETA[i] = beta_n; GLs[i] = -a_exp * softplusf_(sa + dtb); } }
        __syncthreads();
        if (wave == 0) { float x = GLs[lane];
#pragma unroll
            for (int o = 1; o < 64; o <<= 1) { const float y = __int_as_float(__builtin_amdgcn_ds_bpermute((lane - o) << 2, __float_as_int(x))); if (lane >= o) x += y; }
            GC[lane] = x; SC1[lane] = BETA[lane] * fexp(x); }
        __syncthreads();
        if (c + nblk < 132) gdn_raw_load(U, b, h, d, c + nblk, tid, rv);
        { const uint4 z4 = {0u, 0u, 0u, 0u}; *(uint4*)(TA + (tid >> 3) * 72 + (tid & 7) * 8) = z4; *(uint4*)(T1 + (tid >> 3) * 72 + (tid & 7) * 8) = z4; }
#pragma unroll
        for (int q = 0; q < 2; ++q) { const int tix = wave + 8 * q, tm = tix >> 2, tn = tix & 3, r0 = tm * 16 + fq * 4, cx = tn * 16 + fr;
            f32x4 a1 = ZERO4, a2 = ZERO4;
            const bf16_t* bp = KN + (tn * 16 + fr) * 136 + fq * 8; const bf16_t* ap1 = KN + (tm * 16 + fr) * 136 + fq * 8; const bf16_t* ap2 = Qn + (tm * 16 + fr) * 136 + fq * 8;
#pragma unroll
            for (int ks = 0; ks < 4; ++ks) { const bf16x8 bfr = *(const bf16x8*)(bp + ks * 32);
                a1 = __builtin_amdgcn_mfma_f32_16x16x32_bf16(*(const bf16x8*)(ap1 + ks * 32), bfr, a1, 0, 0, 0);
                a2 = __builtin_amdgcn_mfma_f32_16x16x32_bf16(*(const bf16x8*)(ap2 + ks * 32), bfr, a2, 0, 0, 0); }
#pragma unroll
            for (int j = 0; j < 4; ++j) { const int r = r0 + j; const float dec = fexp(GC[r] - GC[cx]); const float x0 = (cx < r) ? a1[j] * BETA[r] * dec : 0.f;
                LA[r * 72 + cx] = f2bf(x0); if (tm == tn) LD[tm * 256 + (r & 15) * 16 + (cx & 15)] = x0;
                QKd[r * 72 + cx] = f2bf((cx <= r) ? a2[j] * dec : 0.f); } }
        __syncthreads();
        trinv64<1>(LA, LD, TA, 72, TT, WT, T1, nullptr, SC1, nullptr, tid, wave, fr, fq);
        { const bf16_t* bp = KNt + (wave * 16 + fr) * 72;
          const bf16x8 b0 = *(const bf16x8*)(bp + ((fq * 8) ^ (wave << 3))), b1 = *(const bf16x8*)(bp + ((32 + fq * 8) ^ (wave << 3)));
#pragma unroll
          for (int q = 0; q < 4; ++q) { const bf16_t* ap = T1 + (q * 16 + fr) * 72 + fq * 8; f32x4 a1 = ZERO4;
              a1 = __builtin_amdgcn_mfma_f32_16x16x32_bf16(*(const bf16x8*)ap, b0, a1, 0, 0, 0); a1 = __builtin_amdgcn_mfma_f32_16x16x32_bf16(*(const bf16x8*)(ap + 32), b1, a1, 0, 0, 0);
#pragma unroll
              for (int j = 0; j < 4; ++j) Wm[(q * 16 + fq * 4 + j) * 136 + wave * 16 + fr] = f2bf(-a1[j]); } }
        const float gl63 = GC[63]; const float eg = fexp(gl63);
        u64_t* sbn = SB + ((c + 1) & 1) * 16384; const unsigned ep = fbase + (unsigned)c + 1u;
#pragma unroll
        for (int vh = 0; vh < 2; ++vh) {
            if (c > 0) { float sv[16]; recv_gran<16>(SB + (c & 1) * 16384 + (vh * 16) * 512 + tid, fbase + (unsigned)c, sv);
#pragma unroll
                for (int q = 0; q < 4; ++q)
#pragma unroll
                    for (int j = 0; j < 4; ++j) accS[vh * 4 + q][j] = sv[q * 4 + j];
            } else {
#pragma unroll
                for (int q = 0; q < 4; ++q) accS[vh * 4 + q] = ZERO4; }
#pragma unroll
            for (int q = 0; q < 4; ++q) { const int tile = wave + 8 * q, tm = tile >> 3, tn = tile & 7;
#pragma unroll
                for (int j = 0; j < 4; ++j) STbf[(tm * 16 + fq * 4 + j) * 136 + tn * 16 + fr] = f2bf(accS[vh * 4 + q][j]); }
            __syncthreads();
#pragma unroll
            for (int q2 = 0; q2 < 2; ++q2) { const int tile = wave + 8 * q2, tm = tile >> 2, tn = tile & 3, r0 = tm * 16 + fq * 4, cx = tn * 16 + fr;
                f32x4 au = ZERO4; mma_seg_bs(au, TA, 72, VT + (vh * 64) * 72, 72, tm, tn, 2, fr, fq, (vh * 4 + tn) & 7);
                mma_seg(au, Wm, 136, STbf, 136, tm, tn, 4, fr, fq);
                st4bf(VNt + cx * 72 + r0, au[0], au[1], au[2], au[3]);
                st4bf(VNs + cx * 72 + r0, au[0] * fexp(gl63 - GC[r0]), au[1] * fexp(gl63 - GC[r0 + 1]), au[2] * fexp(gl63 - GC[r0 + 2]), au[3] * fexp(gl63 - GC[r0 + 3])); }
            __syncthreads();
            { const bf16_t* bp = KNt + (wave * 16 + fr) * 72;
              const bf16x8 b0 = *(const bf16x8*)(bp + ((fq * 8) ^ (wave << 3))), b1 = *(const bf16x8*)(bp + ((32 + fq * 8) ^ (wave << 3)));
#pragma unroll
              for (int q = 0; q < 4; ++q) { const bf16_t* ap = VNs + (q * 16 + fr) * 72 + fq * 8; f32x4 a1 = accS[vh * 4 + q] * eg;
                  a1 = __builtin_amdgcn_mfma_f32_16x16x32_bf16(*(const bf16x8*)ap, b0, a1, 0, 0, 0); a1 = __builtin_amdgcn_mfma_f32_16x16x32_bf16(*(const bf16x8*)(ap + 32), b1, a1, 0, 0, 0);
                  accS[vh * 4 + q] = a1;
#pragma unroll
                  for (int j = 0; j < 4; ++j) st_gran(sbn + ((vh * 4 + q) * 4 + j) * 512 + tid, ep, a1[j]); } }
#pragma unroll
            for (int q2 = 0; q2 < 2; ++q2) { const int tile = wave + 8 * q2, tm = tile >> 2, tn = tile & 3, r0 = tm * 16 + fq * 4, cx = tn * 16 + fr;
                f32x4 a1 = ZERO4, a2 = ZERO4; mma_seg(a1, Qn, 136, STbf, 136, tm, tn, 4, fr, fq); mma_seg(a2, QKd, 72, VNt, 72, tm, tn, 2, fr, fq);
#pragma unroll
                for (int j = 0; j < 4; ++j) { const int tt = r0 + j; const int nn = d ? 63 - tt : tt; const float o = fexp(GC[tt]) * a1[j] + a2[j];
                    OGp[((size_t)d * M + rowbase + nn) * 512 + h * 128 + vh * 64 + cx] = f2bf(o); } }
            __syncthreads();
        }
    }
}
__device__ __forceinline__ void fft1_item(const Prm& p, int item, unsigned char* lds, int tid) {
    const int b = item >> 7, t2 = item & 127; const int wave = tid >> 6, lane = tid & 63, fr = lane & 15, fq = lane >> 4;
    bf16_t* A1 = (bf16_t*)lds; bf16_t* Bt = A1 + 128 * 136;
    const bf16_t* U = (const bf16_t*)(p.ws + WS_U); bf16_t* MID = (bf16_t*)(p.ws + WS_MID);
    for (int e = tid; e < 4096; e += 512) { const int f1 = e >> 6, t1 = e & 63; const int m = (f1 * (128 * t1 + t2)) & 8191; const float s = __builtin_amdgcn_sinf((float)m * (1.f / 8192.f)), c = __builtin_amdgcn_cosf((float)m * (1.f / 8192.f));
        A1[f1 * 136 + t1] = f2bf(c); A1[f1 * 136 + 64 + t1] = f2bf(s); A1[(64 + f1) * 136 + t1] = f2bf(-s); A1[(64 + f1) * 136 + 64 + t1] = f2bf(c); }
    { const int t1 = tid >> 3, pc = tid & 7; const bf16_t* up = U + ((size_t)b * T + 128 * t1 + t2) * LDU + C_FZ + pc * 64;
#pragma unroll
      for (int g8 = 0; g8 < 8; ++g8) { const uint4 v = *(const uint4*)(up + g8 * 8); const int col = pc * 64 + g8 * 8; const int part = col >> 8, ch = col & 255;
#pragma unroll
          for (int e = 0; e < 8; ++e) Bt[(ch + e) * 136 + part * 64 + t1] = f2bf(bfe(v, e)); } }
    __syncthreads();
    f32x4 accs[16];
#pragma unroll
    for (int q = 0; q < 16; ++q) { const int tile = wave + 8 * q, tm = tile >> 4, tn = tile & 15; accs[q] = ZERO4; mma_seg(accs[q], A1, 136, Bt, 136, tm, tn, 4, fr, fq); }
    __syncthreads();
    bf16_t* ST = Bt;
#pragma unroll
    for (int q = 0; q < 16; ++q) { const int tile = wave + 8 * q, tm = tile >> 4, tn = tile & 15, r0 = tm * 16 + fq * 4, ch = tn * 16 + fr;
#pragma unroll
        for (int j = 0; j < 4; ++j) ST[(r0 + j) * 264 + ch] = f2bf(accs[q][j]); }
    __syncthreads();
#pragma unroll
    for (int it = 0; it < 8; ++it) { const int e = tid + it * 512; const int f1 = e >> 6, w = e & 63, po = w >> 5, ck = w & 31;
        *(uint4*)(MID + (((size_t)b * 64 + f1) * 128 + t2) * 512 + po * 256 + ck * 8) = *(const uint4*)(ST + (po * 64 + f1) * 264 + ck * 8); }
    __syncthreads();
}
__device__ __forceinline__ void fft2_item(const Prm& p, int item, unsigned char* lds, int tid) {
    const int b = item >> 7, f1 = (item >> 1) & 63, chh = item & 1; const int wave = tid >> 6, lane = tid & 63, fr = lane & 15, fq = lane >> 4;
    bf16_t* A2 = (bf16_t*)lds; bf16_t* Bt = A2 + 128 * 264;
    const bf16_t* MID = (const bf16_t*)(p.ws + WS_MID); bf16_t* Y = (bf16_t*)(p.ws + WS_Y);
    { const int t2 = tid >> 2, q = tid & 3, pi = q >> 1, hf = q & 1; const bf16_t* mp = MID + (((size_t)b * 64 + f1) * 128 + t2) * 512 + pi * 256 + chh * 128 + hf * 64;
#pragma unroll
      for (int g8 = 0; g8 < 8; ++g8) { const uint4 v = *(const uint4*)(mp + g8 * 8);
#pragma unroll
          for (int e = 0; e < 8; ++e) Bt[(hf * 64 + g8 * 8 + e) * 264 + pi * 128 + t2] = f2bf(bfe(v, e)); } }
    __syncthreads();
    for (int tile = wave; tile < 64; tile += 8) { const int tm = tile >> 3, tn = tile & 7, r0 = tm * 16 + fq * 4, ch = tn * 16 + fr;
        f32x4 acc = ZERO4; mma_seg(acc, A2, 264, Bt, 264, tm, tn, 8, fr, fq);
#pragma unroll
        for (int j = 0; j < 4; ++j) { const int f2 = r0 + j; Y[((size_t)b * T + f1 + 64 * f2) * 1024 + 768 + chh * 128 + ch] = f2bf(acc[j] * 0.011048543456039806f); } }
    __syncthreads();
}
__device__ __forceinline__ void fftc_item(const Prm& p, int item, unsigned char* lds, int tid) {
    const int b = item >> 4, ft = (item >> 2) & 3, cq = item & 3; const int wave = tid >> 6, lane = tid & 63, fr = lane & 15, fq = lane >> 4;
    bf16_t* A3 = (bf16_t*)lds; bf16_t* Bt = A3 + 64 * 520;
    const bf16_t* U = (const bf16_t*)(p.ws + WS_U); bf16_t* Y = (bf16_t*)(p.ws + WS_Y);
    for (int e = tid; e < 64 * 256; e += 512) { const int fl = e >> 8, t = e & 255; const int m = ((ft * 64 + fl) * t) & 255; const float s = __builtin_amdgcn_sinf((float)m * (1.f / 256.f)), c = __builtin_amdgcn_cosf((float)m * (1.f / 256.f));
        A3[fl * 520 + t] = f2bf(c); A3[fl * 520 + 256 + t] = f2bf(s); }
    { const int t = tid >> 1, pi = tid & 1; const bf16_t* up = U + ((size_t)ML + b * TC + t) * LDU + C_FZ + pi * 256 + cq * 64;
#pragma unroll
      for (int g8 = 0; g8 < 8; ++g8) { const uint4 v = *(const uint4*)(up + g8 * 8);
#pragma unroll
          for (int e = 0; e < 8; ++e) Bt[(g8 * 8 + e) * 520 + pi * 256 + t] = f2bf(bfe(v, e)); } }
    __syncthreads();
    for (int tile = wave; tile < 16; tile += 8) { const int tm = tile >> 2, tn = tile & 3, r0 = tm * 16 + fq * 4, ch = tn * 16 + fr;
        f32x4 acc = ZERO4; mma_seg(acc, A3, 520, Bt, 520, tm, tn, 16, fr, fq);
#pragma unroll
        for (int j = 0; j < 4; ++j) Y[((size_t)ML + b * TC + ft * 64 + r0 + j) * 1024 + 768 + cq * 64 + ch] = f2bf(acc[j] * 0.0625f); }
    __syncthreads();
}

__device__ __forceinline__ void rwkv_post_tile(const Prm& p, int l, int tile, unsigned char* lds, int tid_in) {
    int tid = threadIdx.x; asm volatile("" : "+v"(tid));
    const int wave = tid >> 6, lane = tid & 63, fr = lane & 15, fq = lane >> 4;
    bf16_t* GUPt = (bf16_t*)lds; bf16_t* SG = GUPt + 256 * 72; float* GATE = (float*)(SG + 64 * 72);
    const bf16_t* U = (const bf16_t*)(p.ws + WS_U); const bf16_t* ORp = (const bf16_t*)(p.ws + WS_OR); const float* BC = (const float*)(p.ws + WS_BC); bf16_t* Y = (bf16_t*)(p.ws + WS_Y);
    const int n = tid >> 3, jq = tid & 7; const size_t row = (size_t)tile * 64 + n; const bool isctx = row >= (size_t)ML; const int t = isctx ? (int)((row - ML) & (TC - 1)) : (int)(row & (T - 1));
    const float* mu = p.in[10] + l * 896;
    const int cb = jq * 32, hh = jq >> 1;
    uint4 oa[4], ob[4], vr0[5], vr1[5], vr2[5], vr3[5];
#pragma unroll
    for (int g8 = 0; g8 < 4; ++g8) { oa[g8] = *(const uint4*)(ORp + row * 256 + cb + g8 * 8); ob[g8] = *(const uint4*)(ORp + ((size_t)M + row) * 256 + cb + g8 * 8); }
    lerp8_load(U, row, 512 + cb, isctx, t, vr0); lerp8_load(U, row, 512 + cb + 8, isctx, t, vr1); lerp8_load(U, row, 512 + cb + 16, isctx, t, vr2); lerp8_load(U, row, 512 + cb + 24, isctx, t, vr3);
    const float bcs = BC[row * 4 + hh] + BC[((size_t)M + row) * 4 + hh];
    { float m8[8], g8[8];
      { const f32x4 ma = *(const f32x4*)(mu + 832 + jq * 8), mb = *(const f32x4*)(mu + 832 + jq * 8 + 4);
#pragma unroll
        for (int e = 0; e < 4; ++e) { m8[e] = ma[e]; m8[4 + e] = mb[e]; } }
      lerp8(U, row, 832 + jq * 8, isctx, t, m8, g8);
#pragma unroll
      for (int e = 0; e < 8; ++e) g8[e] = sigmoidf_(g8[e]);
      *(uint4*)(SG + n * 72 + jq * 8) = pack8(g8); }
    __syncthreads();
    for (int tl = wave; tl < 64; tl += 8) { const int tm = tl >> 4, tn = tl & 15, r0 = tm * 16 + fq * 4, cx = tn * 16 + fr;
        f32x4 acc = ZERO4; mma_seg(acc, SG, 72, GUPt, 72, tm, tn, 2, fr, fq);
#pragma unroll
        for (int j = 0; j < 4; ++j) GATE[(r0 + j) * 260 + cx] = acc[j]; }
    __syncthreads();
    { float o[32]; float s = 0.f;
#pragma unroll
      for (int g8 = 0; g8 < 4; ++g8)
#pragma unroll
          for (int e = 0; e < 8; ++e) { o[g8 * 8 + e] = bfe(oa[g8], e) + bfe(ob[g8], e); s += o[g8 * 8 + e]; }
      s += shx1(s); const float mean = s * (1.f / 64.f); float vs = 0.f;
#pragma unroll
      for (int e = 0; e < 32; ++e) { const float dd = o[e] - mean; vs += dd * dd; }
      vs += shx1(vs); const float rstd = rsqrtf(vs * (1.f / 64.f) + 64e-5f);
#pragma unroll
      for (int g8 = 0; g8 < 4; ++g8) { float m8[8], v8[8], y8[8], lg[8], lb[8];
          { const float* mp = mu + 512 + cb + g8 * 8; const float* gp = p.in[19] + l * 256 + cb + g8 * 8; const float* bp2 = p.in[20] + l * 256 + cb + g8 * 8;
            const f32x4 ma = *(const f32x4*)mp, mb = *(const f32x4*)(mp + 4), ga = *(const f32x4*)gp, gb = *(const f32x4*)(gp + 4), ba = *(const f32x4*)bp2, bb2 = *(const f32x4*)(bp2 + 4);
#pragma unroll
            for (int e = 0; e < 4; ++e) { m8[e] = ma[e]; m8[4 + e] = mb[e]; lg[e] = ga[e]; lg[4 + e] = gb[e]; lb[e] = ba[e]; lb[4 + e] = bb2[e]; } }
          if (g8 == 0) lerp8_apply(vr0, m8, v8); else if (g8 == 1) lerp8_apply(vr1, m8, v8); else if (g8 == 2) lerp8_apply(vr2, m8, v8); else lerp8_apply(vr3, m8, v8);
          const f32x4 ga0 = *(const f32x4*)(GATE + n * 260 + cb + g8 * 8), ga1 = *(const f32x4*)(GATE + n * 260 + cb + g8 * 8 + 4);
#pragma unroll
          for (int e = 0; e < 8; ++e) { const float yn = (o[g8 * 8 + e] - mean) * rstd * lg[e] + lb[e];
              y8[e] = (yn + bcs * v8[e]) * (e < 4 ? ga0[e] : ga1[e - 4]); }
          *(uint4*)(Y + row * 1024 + cb + g8 * 8) = pack8(y8); } }
    __syncthreads();
}
__device__ __forceinline__ void gdn_post_tile(const Prm& p, int l, int tile, int tid_in) {
    int tid = threadIdx.x; asm volatile("" : "+v"(tid));
    const bf16_t* U = (const bf16_t*)(p.ws + WS_U); const bf16_t* OGp = (const bf16_t*)(p.ws + WS_OG); bf16_t* Y = (bf16_t*)(p.ws + WS_Y);
    const int n = tid >> 3, jq = tid & 7; const size_t row = (size_t)tile * 64 + n; const int cb = jq * 64;
    uint4 oa[8], ob[8], zq[8];
#pragma unroll
    for (int g8 = 0; g8 < 8; ++g8) { oa[g8] = *(const uint4*)(OGp + row * 512 + cb + g8 * 8); ob[g8] = *(const uint4*)(OGp + ((size_t)M + row) * 512 + cb + g8 * 8);
        zq[g8] = *(const uint4*)(U + row * LDU + C_GZ + cb + g8 * 8); }
    float ss = 0.f;
#pragma unroll
    for (int g8 = 0; g8 < 8; ++g8)
#pragma unroll
        for (int e = 0; e < 8; ++e) { const float o = bfe(oa[g8], e) + bfe(ob[g8], e); ss += o * o; }
    ss += shx1(ss); const float rinv = rsqrtf(ss * (1.f / 128.f) + 1e-6f);
#pragma unroll
    for (int g8 = 0; g8 < 8; ++g8) { float y8[8], ng[8];
        { const float* np = p.in[24] + l * 128 + ((cb + g8 * 8) & 127); const f32x4 na = *(const f32x4*)np, nb2 = *(const f32x4*)(np + 4);
#pragma unroll
          for (int e = 0; e < 4; ++e) { ng[e] = na[e]; ng[4 + e] = nb2[e]; } }
#pragma unroll
        for (int e = 0; e < 8; ++e) { const float o = bfe(oa[g8], e) + bfe(ob[g8], e); const float z = bfe(zq[g8], e); y8[e] = o * rinv * ng[e] * siluf_(z); }
        *(uint4*)(Y + row * 1024 + 256 + cb + g8 * 8) = pack8(y8); }
}
__device__ __forceinline__ void post_phase(const Prm& p, int l, unsigned char* lds, int tid, int G) {
    const int bid = blockIdx.x; const int ntile = (l == 0) ? M / 64 : ML / 64;
    if (bid < ntile) { bf16_t* GUPt = (bf16_t*)lds;
        for (int e = tid; e < 64 * 256; e += 512) { const int q = e >> 8, c = e & 255; GUPt[c * 72 + q] = f2bf(p.in[15][((size_t)l * 64 + q) * 256 + c]); }
        __syncthreads();
#ifdef PROBE_RPOST
        for (int rp = 0; rp < PROBE_RPOST; ++rp)
#endif
        for (int tile = bid; tile < ntile; tile += G) rwkv_post_tile(p, l, tile, lds, tid); }
#ifdef PROBE_GPOST
    for (int rp = 0; rp < PROBE_GPOST; ++rp)
#endif
    for (int tile = bid; tile < ntile; tile += G) gdn_post_tile(p, l, tile, tid);
    __syncthreads();
    if (bid < 512) { bf16_t* A2 = (bf16_t*)lds;
        for (int e = tid; e < 128 * 128; e += 512) { const int f2 = e >> 7, t2 = e & 127; const int m = (f2 * t2) & 127; const float s = __builtin_amdgcn_sinf((float)m * (1.f / 128.f)), c = __builtin_amdgcn_cosf((float)m * (1.f / 128.f));
            A2[f2 * 264 + t2] = f2bf(c); A2[f2 * 264 + 128 + t2] = f2bf(s); }
        __syncthreads();
        for (int it = bid; it < 512; it += G) fft2_item(p, it, lds, tid); }
    if (l == 0 && bid >= G - 64) fftc_item(p, bid - (G - 64), lds, tid);
}

#ifndef PHMASK
#define PHMASK 0x3ffff
#endif
#define PH_IN(k) (((PHMASK >> (k)) & 1) && lo <= (k) && (k) < hi)
#ifndef DUPMASK
#define DUPMASK 0
#endif
#define PH_REP(k) for (int rep_ = 0; rep_ <= ((DUPMASK >> (k)) & 1); ++rep_)
#define PH_SYNC(k) do { if (PH_IN(k) && PH_IN((k) + 1)) { if ((k) == 0) grid.sync(); else xcd_barrier(xbar); } } while (0)
template <int L>
__device__ __forceinline__ void layer_phases(const Prm& p, cg::grid_group& grid, const XcdBarrier& xbar, unsigned char* lds, int lo, int hi) {
    constexpr int l = L; constexpr int base = 1 + 8 * L;
    if (PH_IN(base + 0)) PH_REP(base + 0) { int tid = threadIdx.x; asm volatile("" : "+v"(tid)); norm_phase(p, l, 0, tid, gridDim.x); }
    PH_SYNC(base + 0);
    if (PH_IN(base + 1)) PH_REP(base + 1) { unsigned char* ws = p.ws; const int G = gridDim.x, bid = blockIdx.x;
        pg8::Gemm g{(const bf16_t*)(ws + WS_HN), (const bf16_t*)(ws + WS_WIN) + (size_t)l * LDU * 1024, M, LDU, 1024}; pg8::StaticOrder S; S.init(M, LDU, G, bid);
        pg8::EpiBf16<0> E{(bf16_t*)(ws + WS_U), LDU};
        pg8::gemm_phase<pg8::EpiBf16<0>, pg8::StaticOrder, true, true>((PG8_LAS unsigned char*)lds, g, S, E); }
    PH_SYNC(base + 1);
    if (PH_IN(base + 2)) PH_REP(base + 2) { int tid = threadIdx.x; asm volatile("" : "+v"(tid)); const int G = gridDim.x, bid = blockIdx.x;
        if (G >= 256) { if (bid < 128) rwkv_scan(p, l, bid >> 2, bid & 3, 4, lds, tid); else if (bid < 256) gdn_scan(p, l, (bid - 128) >> 2, bid & 3, 4, lds, tid);
            if (bid < 128) for (int it = bid; it < 512; it += 128) fft1_item(p, it, lds, tid); }
        else { if (bid < 32) rwkv_scan(p, l, bid, 0, 1, lds, tid); else if (bid < 64) gdn_scan(p, l, bid - 32, 0, 1, lds, tid);
            else for (int it = bid - 64; it < 512; it += G - 64) fft1_item(p, it, lds, tid); } }
    PH_SYNC(base + 2);
    if (PH_IN(base + 3)) PH_REP(base + 3) { int tid = threadIdx.x; asm volatile("" : "+v"(tid)); post_phase(p, l, lds, tid, gridDim.x); }
    PH_SYNC(base + 3);
    if (PH_IN(base + 4)) PH_REP(base + 4) { unsigned char* ws = p.ws; const int G = gridDim.x, bid = blockIdx.x; const float* modl = (const float*)(ws + WS_MOD) + (size_t)l * 5 * 6144;
        constexpr int Mg = (l == 0) ? M : ML;
        pg8::Gemm g{(const bf16_t*)(ws + WS_Y), (const bf16_t*)(ws + WS_WOUT) + (size_t)l * 1024 * 1024, Mg, 1024, 1024}; pg8::StaticOrder S; S.init(Mg, 1024, G, bid);
        pg8::EpiResid E{l == 0 ? p.in[0] : p.out, l == 0 ? p.in[2] : (const float*)(ws + WS_XC), p.out, (float*)(ws + WS_XC), modl + 2 * 1024};
        pg8::gemm_phase<pg8::EpiResid, pg8::StaticOrder, true, true>((PG8_LAS unsigned char*)lds, g, S, E); }
    PH_SYNC(base + 4);
    if (PH_IN(base + 5)) PH_REP(base + 5) { int tid = threadIdx.x; asm volatile("" : "+v"(tid)); norm_phase(p, l, 1, tid, gridDim.x); }
    PH_SYNC(base + 5);
    if (PH_IN(base + 6)) PH_REP(base + 6) { unsigned char* ws = p.ws; const int G = gridDim.x, bid = blockIdx.x; constexpr int Mg = (l == 0) ? M : ML;
        pg8::Gemm g{(const bf16_t*)(ws + WS_HN), (const bf16_t*)(ws + WS_W1) + (size_t)l * 4096 * 1024, Mg, DFF, 1024}; pg8::StaticOrder S; S.init(Mg, DFF, G, bid);
        pg8::EpiBf16<1> E{(bf16_t*)(ws + WS_H), DFF};
        pg8::gemm_phase<pg8::EpiBf16<1>, pg8::StaticOrder, true, true>((PG8_LAS unsigned char*)lds, g, S, E); }
    PH_SYNC(base + 6);
    if (PH_IN(base + 7)) PH_REP(base + 7) { unsigned char* ws = p.ws; const int G = gridDim.x, bid = blockIdx.x; const float* modl = (const float*)(ws + WS_MOD) + (size_t)l * 5 * 6144; constexpr int Mg = (l == 0) ? M : ML;
        pg8::Gemm g{(const bf16_t*)(ws + WS_H), (const bf16_t*)(ws + WS_W2) + (size_t)l * 1024 * 4096, Mg, 1024, DFF}; pg8::StaticOrder S; S.init(Mg, 1024, G, bid);
        pg8::EpiResid E{p.out, (const float*)(ws + WS_XC), p.out, (float*)(ws + WS_XC), modl + 5 * 1024};
        pg8::gemm_phase<pg8::EpiResid, pg8::StaticOrder, true, true>((PG8_LAS unsigned char*)lds, g, S, E); }
    PH_SYNC(base + 7);
}
__global__ void __launch_bounds__(512, 2) mega_fwd(Prm p) {
    extern __shared__ __attribute__((aligned(16))) unsigned char lds[];
    cg::grid_group grid = cg::this_grid();
    const int lo = p.ph_lo, hi = p.ph_hi;
    if (threadIdx.x < 2) ((volatile LAS unsigned*)((LAS unsigned char*)lds + LDS_XB))[threadIdx.x] = 0u;
    __syncthreads();
#ifdef EXTRA_SYNCS
    for (int es = 0; es < EXTRA_SYNCS; ++es) grid.sync();
#endif
    if (PH_IN(0)) PH_REP(0) { int tid = threadIdx.x; asm volatile("" : "+v"(tid)); prep_phase(p, lds, tid, gridDim.x); }
    if (PH_IN(0) && PH_IN(1)) grid.sync();
    const XcdBarrier xbar = xcd_barrier_post((unsigned*)(p.ws + WS_BARW), (volatile LAS unsigned*)((LAS unsigned char*)lds + LDS_XB));
    layer_phases<0>(p, grid, xbar, lds, lo, hi);
    layer_phases<1>(p, grid, xbar, lds, lo, hi);
    if (PH_IN(NPH - 1)) { int tid = threadIdx.x; asm volatile("" : "+v"(tid)); norm_phase(p, 1, 2, tid, gridDim.x); }
}

#ifndef MK_SPLIT
#define MK_SPLIT 0
#endif
extern "C" void kernel_launch(void* const* d_in, const int* in_sizes, int n_in, void* d_out, int out_size, void* d_ws, size_t ws_size, hipStream_t stream) {
    static int grid = 0;
    if (grid == 0) {
        int dev = 0, cus = 0, per_cu = 0;
        if (n_in != 29 || out_size != ML * D || ws_size < WS_END2) { fprintf(stderr, "kernel_launch: unexpected problem shape (n_in %d out %d ws %zu)\n", n_in, out_size, ws_size); grid = -1; return; }
        hipGetDevice(&dev); hipDeviceGetAttribute(&cus, hipDeviceAttributeMultiprocessorCount, dev);
        if (hipFuncSetAttribute((const void*)mega_fwd, hipFuncAttributeMaxDynamicSharedMemorySize, LDS_BYTES) != hipSuccess) { fprintf(stderr, "kernel_launch: hipFuncSetAttribute failed\n"); grid = -1; return; }
        if (hipOccupancyMaxActiveBlocksPerMultiprocessor(&per_cu, (const void*)mega_fwd, 512, LDS_BYTES) != hipSuccess || per_cu < 1) { fprintf(stderr, "kernel_launch: occupancy query says %d blocks per CU\n", per_cu); grid = -1; return; }
        grid = cus * 1;
        if (grid > 256) grid = 256;
        if (grid < 128) { fprintf(stderr, "kernel_launch: needs >= 128 CUs\n"); grid = -1; return; }
    }
    if (grid < 0) return;
    Prm prm{};
    for (int i = 0; i < 29; ++i) prm.in[i] = (const float*)d_in[i];
    prm.out = (float*)d_out; prm.ws = (unsigned char*)d_ws;
#if MK_SPLIT
    for (int ph = 0; ph < NPH; ++ph) { prm.ph_lo = ph; prm.ph_hi = ph + 1; void* args[] = {&prm};
        hipError_t e = hipLaunchCooperativeKernel((const void*)mega_fwd, dim3(grid), dim3(512), args, LDS_BYTES, stream);
        if (e != hipSuccess) { fprintf(stderr, "kernel_launch: launch failed: %s\n", hipGetErrorString(e)); break; } }
#else
    prm.ph_lo = 0; prm.ph_hi = NPH; void* args[] = {&prm};
    hipError_t e = hipLaunchCooperativeKernel((const void*)mega_fwd, dim3(grid), dim3(512), args, LDS_BYTES, stream);
    if (e != hipSuccess) fprintf(stderr, "kernel_launch: cooperative launch failed: %s (grid %d)\n", hipGetErrorString(e), grid);
#endif
}
```

```cpp
#include <hip/hip_runtime.h>
#include <hip/hip_cooperative_groups.h>
#include <cstdio>
#include <cstdint>
namespace cg = cooperative_groups;
namespace pg8 {
#define PG8_LAS __attribute__((address_space(3)))
typedef unsigned short bf16_t;
typedef short bf16x8 __attribute__((ext_vector_type(8)));
typedef float f32x4 __attribute__((ext_vector_type(4)));
typedef unsigned u32x4 __attribute__((ext_vector_type(4)));
constexpr int BM = 256, BK = 64, HALF = 128, HTB = HALF * BK * 2  , STAGE_BYTES = 8 * HTB, NXCD = 8, WGM = 8;

__host__ __device__ __forceinline__ int lds_byte(int r, int c) { const int st = (r >> 4) * 2 + (c >> 5), rr = r & 15, cc = c & 31, ob = rr * 64 + cc * 2; return st * 1024 + (ob ^ (((ob >> 9) & 1) << 5)); }
__host__ __device__ __forceinline__ void stage_rc(int b, int& R, int& C) { const int st = b / 1024, sb = b % 1024, swz = sb ^ (((sb >> 9) & 1) << 5); R = (st >> 1) * 16 + swz / 64; C = (st & 1) * 32 + (swz % 64) / 2; }
__host__ __device__ __forceinline__ int perm32(int rho) { const int n = rho >> 4, i = rho & 15; return 8 * (i >> 2) + 4 * n + (i & 3); }

struct Unit { int pm, pn; };
struct Gemm { const bf16_t* A; const bf16_t* Bt; int M, N, K; };

struct StaticOrder {
    int nM, nN, nwg, G, c;
    __host__ __device__ void init(int M, int N, int G_, int c_) { nM = M / BM; nN = N / BM; nwg = nM * nN; G = G_; c = c_; }
    __host__ __device__ bool next(int i, Unit& u) const {
        const long L = (long)i * G + c; if (L >= nwg) return false;
        int wgid = (int)L; { const int q = nwg / NXCD, r = nwg % NXCD, xcd = wgid % NXCD, off = wgid / NXCD; wgid = (xcd < r ? xcd * (q + 1) : r * (q + 1) + (xcd - r) * q) + off; }
        const int nig = WGM * nN, gid = wgid / nig, fm = gid * WGM, gsz = (nM - fm) < WGM ? (nM - fm) : WGM;
        u.pm = fm + ((wgid % nig) % gsz); u.pn = (wgid % nig) / gsz; return true;
    }
    __device__ __forceinline__ void a_ready(const Unit&) const {}
    __device__ __forceinline__ void done(const Unit&) const {}
};

typedef __bf16 bf16x2_t __attribute__((ext_vector_type(2)));
typedef float f32x2_t __attribute__((ext_vector_type(2)));
__device__ __forceinline__ unsigned cvt_pk_bf16(float lo, float hi) { const f32x2_t v = {lo, hi}; const bf16x2_t b = __builtin_convertvector(v, bf16x2_t); return __builtin_bit_cast(unsigned, b); }
template <int ACT  > struct EpiBf16 {
    static constexpr bool PERM = true, AFTER_DRAIN = false;
    bf16_t* O; int ldc;
    __device__ __forceinline__ void operator()(const f32x4 (&acc)[2][2][4][2], const Unit& u, int wr, int wc, int fr, int fq) const {
        const int row0 = u.pm * BM + wr * 64 + fr; const int col0 = u.pn * BM + wc * 32 + 8 * fq;
#pragma unroll
        for (int ai = 0; ai < 2; ++ai)
#pragma unroll
            for (int m = 0; m < 4; ++m) { bf16_t* rowp = O + (size_t)(row0 + ai * HALF + m * 16) * ldc + col0;
#pragma unroll
                for (int bj = 0; bj < 2; ++bj) { f32x4 v0 = acc[ai][bj][m][0], v1 = acc[ai][bj][m][1];
                    if (ACT == 1) {
#pragma unroll
                        for (int e = 0; e < 4; ++e) { float a = v0[e] > 0.f ? v0[e] : 0.f; v0[e] = a * a; float b = v1[e] > 0.f ? v1[e] : 0.f; v1[e] = b * b; } }
                    u32x4 w; w.x = cvt_pk_bf16(v0[0], v0[1]); w.y = cvt_pk_bf16(v0[2], v0[3]); w.z = cvt_pk_bf16(v1[0], v1[1]); w.w = cvt_pk_bf16(v1[2], v1[3]);
                    *(u32x4*)(rowp + bj * HALF) = w; } }
    }
};
struct EpiResid {
    static constexpr bool PERM = true, AFTER_DRAIN = false;
    const float* rin_lat; const float* rin_ctx; float* rout_lat; float* rout_ctx; const float* gate;
    __device__ __forceinline__ void operator()(const f32x4 (&acc)[2][2][4][2], const Unit& u, int wr, int wc, int fr, int fq) const {
        const bool lat = u.pm < 128; const int bb = lat ? (u.pm >> 5) : 4;
        const int rbase = (lat ? u.pm * 256 : (u.pm - 128) * 256) + wr * 64 + fr;
        const float* rin = lat ? rin_lat : rin_ctx; float* rout = lat ? rout_lat : rout_ctx;
        const int col0 = u.pn * BM + wc * 32 + 8 * fq;
        const float* gv = gate + bb * 6144 + col0;
        f32x4 g[2][2];
#pragma unroll
        for (int bj = 0; bj < 2; ++bj)
#pragma unroll
            for (int n = 0; n < 2; ++n) g[bj][n] = *(const f32x4*)(gv + bj * HALF + 4 * n);
#pragma unroll
        for (int ai = 0; ai < 2; ++ai)
#pragma unroll
            for (int m = 0; m < 4; ++m) { const size_t ro = (size_t)(rbase + ai * HALF + m * 16) * 1024 + col0;
#pragma unroll
                for (int bj = 0; bj < 2; ++bj) {
                    const f32x4 x0 = *(const f32x4*)(rin + ro + bj * HALF), x1 = *(const f32x4*)(rin + ro + bj * HALF + 4);
                    *(f32x4*)(rout + ro + bj * HALF) = x0 + g[bj][0] * acc[ai][bj][m][0];
                    *(f32x4*)(rout + ro + bj * HALF + 4) = x1 + g[bj][1] * acc[ai][bj][m][1]; } }
    }
};
struct EpiResidN {
    static constexpr bool PERM = true, AFTER_DRAIN = false;
    const float* rin_lat; const float* rin_ctx; float* rout_lat; float* rout_ctx; const float* gate;
    bf16_t* XB; float* SS; const float* gvec; const float* scn;
    __device__ __forceinline__ void operator()(const f32x4 (&acc)[2][2][4][2], const Unit& u, int wr, int wc, int fr, int fq) const {
        const bool lat = u.pm < 128; const int bb = lat ? (u.pm >> 5) : 4;
        const int rbase = (lat ? u.pm * 256 : (u.pm - 128) * 256) + wr * 64 + fr; const int grow = u.pm * 256 + wr * 64 + fr;
        const float* rin = lat ? rin_lat : rin_ctx; float* rout = lat ? rout_lat : rout_ctx;
        const int col0 = u.pn * BM + wc * 32 + 8 * fq;
        const float* gv = gate + bb * 6144 + col0;
        f32x4 g[2][2], gs[2][2];
#pragma unroll
        for (int bj = 0; bj < 2; ++bj)
#pragma unroll
            for (int n = 0; n < 2; ++n) { g[bj][n] = *(const f32x4*)(gv + bj * HALF + 4 * n);
                gs[bj][n] = *(const f32x4*)(gvec + col0 + bj * HALF + 4 * n) * (*(const f32x4*)(scn + bb * 6144 + col0 + bj * HALF + 4 * n) + 1.f); }
#pragma unroll
        for (int ai = 0; ai < 2; ++ai)
#pragma unroll
            for (int m = 0; m < 4; ++m) { const size_t ro = (size_t)(rbase + ai * HALF + m * 16) * 1024 + col0; bf16_t* xb = XB + (size_t)(grow + ai * HALF + m * 16) * 1024 + col0; float ssq = 0.f;
#pragma unroll
                for (int bj = 0; bj < 2; ++bj) {
                    const f32x4 x0 = *(const f32x4*)(rin + ro + bj * HALF), x1 = *(const f32x4*)(rin + ro + bj * HALF + 4);
                    const f32x4 o0 = x0 + g[bj][0] * acc[ai][bj][m][0], o1 = x1 + g[bj][1] * acc[ai][bj][m][1];
                    *(f32x4*)(rout + ro + bj * HALF) = o0; *(f32x4*)(rout + ro + bj * HALF + 4) = o1;
                    ssq += (o0[0] * o0[0] + o0[1] * o0[1]) + (o0[2] * o0[2] + o0[3] * o0[3]) + (o1[0] * o1[0] + o1[1] * o1[1]) + (o1[2] * o1[2] + o1[3] * o1[3]);
                    const f32x4 y0 = o0 * gs[bj][0], y1 = o1 * gs[bj][1];
                    u32x4 w; w.x = cvt_pk_bf16(y0[0], y0[1]); w.y = cvt_pk_bf16(y0[2], y0[3]); w.z = cvt_pk_bf16(y1[0], y1[1]); w.w = cvt_pk_bf16(y1[2], y1[3]);
                    *(u32x4*)(xb + bj * HALF) = w; }
                ssq += __shfl_xor(ssq, 16); ssq += __shfl_xor(ssq, 32);
                if (fq == 0) __hip_atomic_fetch_add(SS + grow + ai * HALF + m * 16, ssq, __ATOMIC_RELAXED, __HIP_MEMORY_SCOPE_AGENT); }
    }
};
template <int ACT  > struct EpiBf16RS {
    static constexpr bool PERM = true, AFTER_DRAIN = false;
    bf16_t* O; int ldc; const float* SS; const float* bias; int ldb;
    __device__ __forceinline__ void operator()(const f32x4 (&acc)[2][2][4][2], const Unit& u, int wr, int wc, int fr, int fq) const {
        const int row0 = u.pm * BM + wr * 64 + fr; const int col0 = u.pn * BM + wc * 32 + 8 * fq; const int bb = u.pm < 128 ? (u.pm >> 5) : 4;
        const float* bp = bias + (size_t)bb * ldb + col0;
        f32x4 bv[2][2];
#pragma unroll
        for (int bj = 0; bj < 2; ++bj)
#pragma unroll
            for (int n = 0; n < 2; ++n) bv[bj][n] = *(const f32x4*)(bp + bj * HALF + 4 * n);
#pragma unroll
        for (int ai = 0; ai < 2; ++ai)
#pragma unroll
            for (int m = 0; m < 4; ++m) { const int r = row0 + ai * HALF + m * 16; const float rinv = __builtin_amdgcn_rsqf(SS[r] * (1.f / 1024.f) + 1e-6f);
                bf16_t* rowp = O + (size_t)r * ldc + col0;
#pragma unroll
                for (int bj = 0; bj < 2; ++bj) { f32x4 v0 = acc[ai][bj][m][0] * rinv + bv[bj][0], v1 = acc[ai][bj][m][1] * rinv + bv[bj][1];
                    if (ACT == 1) {
#pragma unroll
                        for (int e = 0; e < 4; ++e) { float a = v0[e] > 0.f ? v0[e] : 0.f; v0[e] = a * a; float b = v1[e] > 0.f ? v1[e] : 0.f; v1[e] = b * b; } }
                    u32x4 w; w.x = cvt_pk_bf16(v0[0], v0[1]); w.y = cvt_pk_bf16(v0[2], v0[3]); w.z = cvt_pk_bf16(v1[0], v1[1]); w.w = cvt_pk_bf16(v1[2], v1[3]);
                    *(u32x4*)(rowp + bj * HALF) = w; } }
    }
};
template <class Epi, class Sched, bool ALIGN_EPI = false, bool SP2 = false>
__device__ __forceinline__ void gemm_phase(PG8_LAS unsigned char* lds, const Gemm g, const Sched& S, const Epi& E) {
    int tid_l = threadIdx.x; asm volatile("" : "+v"(tid_l));
    const int tid = tid_l, wid = __builtin_amdgcn_readfirstlane(tid >> 6), lane = tid & 63, wr = wid >> 2, wc = wid & 3, fr = lane & 15, fq = lane >> 4;
    const int K = g.K, nt = K / BK;
    unsigned voffA[2], voffB[2];
#pragma unroll
    for (int i = 0; i < 2; ++i) { int R, C; stage_rc(tid * 16 + i * 8192, R, C); const int Rb = Epi::PERM ? ((R & ~31) + perm32(R & 31)) : R;
        voffA[i] = (unsigned)(R * K + C) * 2u; voffB[i] = (unsigned)(Rb * K + C) * 2u; }
    const size_t kstep = (size_t)(BK * 2);
    const size_t hstep = (size_t)HALF * K * 2;
    const size_t tstep = 2 * hstep;
    const unsigned ldsw = (unsigned)wid * 1024u;
    const int aoff = lds_byte(wr * 64 + fr, fq * 8), boff = lds_byte(wc * 32 + fr, fq * 8);
#define PG8_SA(b, h) (((b) * 2 + (h)) * HTB)
#define PG8_SB(b, h) ((4 + (b) * 2 + (h)) * HTB)
#define PG8_STAGE(bufoff, gbase, voff) do { _Pragma("unroll") for (int _i = 0; _i < 2; ++_i) \
        __builtin_amdgcn_global_load_lds((const unsigned*)((const char*)(gbase) + (voff)[_i]), (PG8_LAS unsigned*)(lds + (bufoff) + ldsw + _i * 8192), 16, 0, 0); } while (0)
#define PG8_LDA(dst, b, h) do { _Pragma("unroll") for (int m = 0; m < 4; ++m) _Pragma("unroll") for (int k = 0; k < 2; ++k) dst[m][k] = *(const PG8_LAS bf16x8*)(lds + PG8_SA(b, h) + aoff + m * 2048 + k * 1024); } while (0)
#define PG8_LDB(dst, b, h) do { _Pragma("unroll") for (int n = 0; n < 2; ++n) _Pragma("unroll") for (int k = 0; k < 2; ++k) dst[n][k] = *(const PG8_LAS bf16x8*)(lds + PG8_SB(b, h) + boff + n * 2048 + k * 1024); } while (0)
#define PG8_MMA(ai, bj, At, Bt) do { __builtin_amdgcn_s_setprio(1); _Pragma("unroll") for (int m = 0; m < 4; ++m) _Pragma("unroll") for (int n = 0; n < 2; ++n) _Pragma("unroll") for (int k = 0; k < 2; ++k) \
        acc[ai][bj][m][n] = __builtin_amdgcn_mfma_f32_16x16x32_bf16(Bt[n][k], At[m][k], acc[ai][bj][m][n], 0, 0, 0); __builtin_amdgcn_s_setprio(0); } while (0)
#define PG8_WAIT_V(n) asm volatile("s_waitcnt vmcnt(" #n ")" ::: "memory")
#define PG8_WAIT_L(n) asm volatile("s_waitcnt lgkmcnt(" #n ")" ::: "memory")
#define PG8_BAR __builtin_amdgcn_s_barrier()
#define PG8_SCHED __builtin_amdgcn_sched_barrier(0)
    Unit cur, nxt; int ui = 0;
    if (!S.next(0, cur)) return;
    f32x4 acc[2][2][4][2];
#pragma unroll
    for (int a = 0; a < 2; ++a)
#pragma unroll
        for (int b = 0; b < 2; ++b)
#pragma unroll
            for (int m = 0; m < 4; ++m)
#pragma unroll
                for (int n = 0; n < 2; ++n) acc[a][b][m][n] = (f32x4){0.f, 0.f, 0.f, 0.f};
    bf16x8 At[4][2], B0[2][2], B1[2][2];
    const char* cA = (const char*)g.A + (size_t)cur.pm * tstep; const char* cB = (const char*)g.Bt + (size_t)cur.pn * tstep;
    S.a_ready(cur);
    if constexpr (SP2) {
        PG8_STAGE(PG8_SB(0, 0), cB, voffB); PG8_STAGE(PG8_SB(0, 1), cB + hstep, voffB); PG8_STAGE(PG8_SA(0, 0), cA, voffA); PG8_STAGE(PG8_SA(0, 1), cA + hstep, voffA);
        if (wr == 1) PG8_BAR;
        PG8_WAIT_V(2); PG8_BAR;
        PG8_STAGE(PG8_SB(1, 0), cB + kstep, voffB); PG8_STAGE(PG8_SA(1, 0), cA + kstep, voffA); PG8_STAGE(PG8_SB(1, 1), cB + hstep + kstep, voffB);
        PG8_WAIT_V(6); PG8_BAR;
    } else {
        PG8_STAGE(PG8_SB(0, 0), cB, voffB); PG8_STAGE(PG8_SA(0, 0), cA, voffA); PG8_STAGE(PG8_SB(0, 1), cB + hstep, voffB); PG8_STAGE(PG8_SA(0, 1), cA + hstep, voffA);
        if (wr == 1) PG8_BAR;
        PG8_WAIT_V(4); PG8_BAR;
        PG8_STAGE(PG8_SB(1, 0), cB + kstep, voffB); PG8_STAGE(PG8_SA(1, 0), cA + kstep, voffA); PG8_STAGE(PG8_SB(1, 1), cB + hstep + kstep, voffB);
        PG8_WAIT_V(6); PG8_BAR;
    }
    for (;;) {
        const bool has_next = S.next(ui + 1, nxt);
        const char* nA = has_next ? (const char*)g.A + (size_t)nxt.pm * tstep : cA; const char* nB = has_next ? (const char*)g.Bt + (size_t)nxt.pn * tstep : cB;
        for (int t = 0; t < nt; t += 2) {
            const bool last = (t == nt - 2);
            const char* a1 = cA + (size_t)(t + 1) * kstep;
            const char* a2 = last ? nA : cA + (size_t)(t + 2) * kstep; const char* b2 = last ? nB : cB + (size_t)(t + 2) * kstep;
            const char* a3 = a2 + kstep; const char* b3 = b2 + kstep;
            if (last && has_next) S.a_ready(nxt);
            if constexpr (SP2) {
            PG8_LDB(B0, 0, 0); PG8_LDB(B1, 0, 1); PG8_SCHED; PG8_LDA(At, 0, 0); PG8_STAGE(PG8_SA(1, 1), a1 + hstep, voffA);
            PG8_WAIT_V(8); PG8_WAIT_L(0); PG8_BAR; PG8_MMA(0, 0, At, B0); PG8_MMA(0, 1, At, B1); PG8_BAR; PG8_SCHED;
            PG8_LDA(At, 0, 1); PG8_STAGE(PG8_SB(0, 0), b2, voffB); PG8_STAGE(PG8_SB(0, 1), b2 + hstep, voffB); PG8_STAGE(PG8_SA(0, 0), a2, voffA);
            PG8_WAIT_V(8); PG8_WAIT_L(0); PG8_BAR; PG8_MMA(1, 0, At, B0); PG8_MMA(1, 1, At, B1); PG8_BAR; PG8_SCHED;
            PG8_LDB(B0, 1, 0); PG8_LDB(B1, 1, 1); PG8_SCHED; PG8_LDA(At, 1, 0); PG8_STAGE(PG8_SA(0, 1), a2 + hstep, voffA);
            PG8_WAIT_V(8); PG8_WAIT_L(0); PG8_BAR; PG8_MMA(0, 0, At, B0); PG8_MMA(0, 1, At, B1); PG8_BAR; PG8_SCHED;
            PG8_LDA(At, 1, 1); PG8_STAGE(PG8_SB(1, 0), b3, voffB); PG8_STAGE(PG8_SB(1, 1), b3 + hstep, voffB); PG8_STAGE(PG8_SA(1, 0), a3, voffA);
            PG8_WAIT_V(8); PG8_WAIT_L(0); PG8_BAR; PG8_MMA(1, 0, At, B0); PG8_MMA(1, 1, At, B1); PG8_BAR; PG8_SCHED;
            } else {
            PG8_LDB(B0, 0, 0); PG8_SCHED; PG8_LDA(At, 0, 0); PG8_STAGE(PG8_SA(1, 1), a1 + hstep, voffA);
            PG8_WAIT_L(8); PG8_BAR; PG8_WAIT_L(0); PG8_MMA(0, 0, At, B0); PG8_BAR; PG8_SCHED;
            PG8_LDB(B1, 0, 1); PG8_STAGE(PG8_SB(0, 0), b2, voffB);
            PG8_BAR; PG8_WAIT_L(0); PG8_MMA(0, 1, At, B1); PG8_BAR;
            PG8_LDA(At, 0, 1); PG8_STAGE(PG8_SA(0, 0), a2, voffA);
            PG8_BAR; PG8_WAIT_L(0); PG8_MMA(1, 0, At, B0); PG8_BAR; PG8_SCHED;
            PG8_STAGE(PG8_SB(0, 1), b2 + hstep, voffB);
            PG8_WAIT_V(6); PG8_BAR; PG8_MMA(1, 1, At, B1); PG8_BAR;
            PG8_LDB(B0, 1, 0); PG8_SCHED; PG8_LDA(At, 1, 0); PG8_STAGE(PG8_SA(0, 1), a2 + hstep, voffA);
            PG8_WAIT_L(8); PG8_BAR; PG8_WAIT_L(0); PG8_MMA(0, 0, At, B0); PG8_BAR; PG8_SCHED;
            PG8_LDB(B1, 1, 1); PG8_STAGE(PG8_SB(1, 0), b3, voffB);
            PG8_BAR; PG8_WAIT_L(0); PG8_MMA(0, 1, At, B1); PG8_BAR;
            PG8_LDA(At, 1, 1); PG8_STAGE(PG8_SA(1, 0), a3, voffA);
            PG8_BAR; PG8_WAIT_L(0); PG8_MMA(1, 0, At, B0); PG8_BAR; PG8_SCHED;
            PG8_STAGE(PG8_SB(1, 1), b3 + hstep, voffB);
            PG8_WAIT_V(6); PG8_BAR; PG8_MMA(1, 1, At, B1); PG8_BAR;
            }
        }
        if constexpr (ALIGN_EPI) { if (wr == 0) PG8_BAR; }
        if constexpr (!Epi::AFTER_DRAIN) { E(acc, cur, wr, wc, fr, fq); S.done(cur); }
        if (!has_next) break;
#pragma unroll
        for (int a = 0; a < 2; ++a)
#pragma unroll
            for (int b = 0; b < 2; ++b)
#pragma unroll
                for (int m = 0; m < 4; ++m)
#pragma unroll
                    for (int n = 0; n < 2; ++n) acc[a][b][m][n] = (f32x4){0.f, 0.f, 0.f, 0.f};
        cur = nxt; cA = nA; cB = nB; ++ui;
        if constexpr (ALIGN_EPI) { if (wr == 1) PG8_BAR; }
    }
    PG8_WAIT_V(0);
    if constexpr (!ALIGN_EPI) { if (wr == 0) PG8_BAR; }
    PG8_BAR;
    if constexpr (Epi::AFTER_DRAIN) { E.fused(acc, cur, wr, wc, fr, fq, lds, wid, lane); S.done(cur); }
#undef PG8_SA
#undef PG8_SB
#undef PG8_STAGE
#undef PG8_LDA
#undef PG8_LDB
#undef PG8_MMA
#undef PG8_WAIT_V
#undef PG8_WAIT_L
#undef PG8_BAR
#undef PG8_SCHED
}
}
typedef unsigned short bf16_t;
typedef short bf16x8 __attribute__((ext_vector_type(8)));
typedef float f32x4 __attribute__((ext_vector_type(4)));
constexpr int NB = 4, T = 8192, TC = 256, D = 1024, DFF = 4096;
constexpr int ML = NB * T, MC = NB * TC, M = ML + MC;
constexpr int LDU = 3584;
constexpr int NPLAIN = 2960, WIN_N = 3216;
constexpr int C_GQ = 896, C_GK = 1408, C_GV = 1920, C_GZ = 2432, C_GS = 2944, C_FZ = 2960;
constexpr size_t MiB = 1u << 20;
constexpr size_t WS_MOD = MiB / 2;
constexpr size_t WS_BC = 3 * MiB / 4;
constexpr size_t WS_WIN = 2 * MiB;
constexpr size_t WS_WOUT = 16 * MiB;
constexpr size_t WS_W1 = 20 * MiB;
constexpr size_t WS_W2 = 36 * MiB;
constexpr size_t WS_XC = 52 * MiB;
constexpr size_t WS_HN = 56 * MiB;
constexpr size_t WS_MID = 56 * MiB;
constexpr size_t WS_OR = 88 * MiB;
constexpr size_t WS_U = 122 * MiB;
constexpr size_t WS_OG = 353 * MiB;
constexpr size_t WS_Y = 419 * MiB;
constexpr size_t WS_H = 122 * MiB;
constexpr size_t WS_END = 485 * MiB;
constexpr size_t WS_BARW = 0;
constexpr int LDS_XB = 159680;
constexpr size_t WS_SBR = 485 * MiB;
constexpr size_t WS_SBG = 487 * MiB;
constexpr size_t WS_END2 = 495 * MiB;
constexpr size_t WS_SS = 495 * MiB;
constexpr size_t WS_ZEND = 496 * MiB;
constexpr size_t WS_BIAS = 496 * MiB;
constexpr size_t WS_END3 = 497 * MiB;
constexpr int LDS_BYTES = 159744;
constexpr int NPH = 18;

struct Prm { const float* in[29]; float* out; unsigned char* ws; int ph_lo, ph_hi; };

__device__ __forceinline__ bf16_t f2bf(float f) { const __bf16 b = (__bf16)f; return __builtin_bit_cast(unsigned short, b); }
__device__ __forceinline__ float bf2f(bf16_t h) { return __uint_as_float(((unsigned)h) << 16); }
__device__ __forceinline__ unsigned pk2(float lo, float hi) { return pg8::cvt_pk_bf16(lo, hi); }
__device__ __forceinline__ float bfe(const uint4& q, int e) { const unsigned w = (e < 2) ? q.x : (e < 4) ? q.y : (e < 6) ? q.z : q.w; return (e & 1) ? __uint_as_float(w & 0xffff0000u) : __uint_as_float(w << 16); }
__device__ __forceinline__ uint4 pack8(const float* v) { uint4 o; o.x = pk2(v[0], v[1]); o.y = pk2(v[2], v[3]); o.z = pk2(v[4], v[5]); o.w = pk2(v[6], v[7]); return o; }
__device__ __forceinline__ float wave_sum(float v) {
#pragma unroll
    for (int o = 1; o < 64; o <<= 1) v += __shfl_xor(v, o);
    return v;
}
__device__ __forceinline__ float fexp(float x) { return __expf(x); }
__device__ __forceinline__ float frcp(float x) { return __builtin_amdgcn_rcpf(x); }
__device__ __forceinline__ float sigmoidf_(float x) { return frcp(1.f + fexp(-x)); }
__device__ __forceinline__ float softplusf_(float z) { const float e = fexp(z); return z > 20.f ? z : (e < 1e-3f ? e * (1.f - 0.5f * e) : __logf(1.f + e)); }
__device__ __forceinline__ float ftanh(float x) { return 1.f - 2.f * frcp(1.f + fexp(2.f * x)); }
__device__ __forceinline__ float siluf_(float x) { return x * frcp(1.f + fexp(-x)); }
__device__ __forceinline__ float shx1(float v) { return __int_as_float(__builtin_amdgcn_ds_swizzle(__float_as_int(v), 0x041F)); }
__device__ __forceinline__ float shx2(float v) { return __int_as_float(__builtin_amdgcn_ds_swizzle(__float_as_int(v), 0x081F)); }
__device__ __forceinline__ float shx4(float v) { return __int_as_float(__builtin_amdgcn_ds_swizzle(__float_as_int(v), 0x101F)); }
typedef unsigned long long u64_t;
__device__ __forceinline__ void st_gran(u64_t* g, unsigned epoch, float v) { __hip_atomic_store(g, ((u64_t)epoch << 32) | (u64_t)__float_as_uint(v), __ATOMIC_RELAXED, __HIP_MEMORY_SCOPE_AGENT); }
template <int N>
__device__ __forceinline__ void recv_gran(const u64_t* g, unsigned epoch, float (&out)[N]) {
    unsigned spins = 0;
    for (;;) { bool ok = true;
#pragma unroll
        for (int k = 0; k < N; ++k) { const u64_t x = __hip_atomic_load(g + k * 512, __ATOMIC_RELAXED, __HIP_MEMORY_SCOPE_AGENT); out[k] = __uint_as_float((unsigned)x); ok = ok && ((unsigned)(x >> 32) == epoch); }
        if (ok || ++spins > (1u << 20)) break; __builtin_amdgcn_s_sleep(2); }
}
#define LDS_WAIT() asm volatile("s_waitcnt lgkmcnt(0)" ::: "memory")

__device__ __forceinline__ void mma_seg(f32x4& acc, const bf16_t* A, int lda, const bf16_t* Bt, int ldb, int tm, int tn, int ksteps, int fr, int fq) {
    const bf16_t* ap = A + (tm * 16 + fr) * lda + fq * 8; const bf16_t* bp = Bt + (tn * 16 + fr) * ldb + fq * 8;
    for (int ks = 0; ks < ksteps; ++ks) {
        const bf16x8 a = *(const bf16x8*)(ap + ks * 32); const bf16x8 b = *(const bf16x8*)(bp + ks * 32);
        acc = __builtin_amdgcn_mfma_f32_16x16x32_bf16(a, b, acc, 0, 0, 0);
    }
}
#define ZERO4 ((f32x4){0.f, 0.f, 0.f, 0.f})
__device__ __forceinline__ void st4bf(bf16_t* dst, float a, float b, float c, float d) { uint2 w; w.x = pk2(a, b); w.y = pk2(c, d); *(uint2*)dst = w; }
__device__ __forceinline__ void mma_seg_bs(f32x4& acc, const bf16_t* A, int lda, const bf16_t* Bt, int ldb, int tm, int tn, int ksteps, int fr, int fq, int g) {
    const bf16_t* ap = A + (tm * 16 + fr) * lda + fq * 8; const bf16_t* bp = Bt + (tn * 16 + fr) * ldb;
    for (int ks = 0; ks < ksteps; ++ks) {
        const bf16x8 a = *(const bf16x8*)(ap + ks * 32); const bf16x8 b = *(const bf16x8*)(bp + ((ks * 32 + fq * 8) ^ (g << 3)));
        acc = __builtin_amdgcn_mfma_f32_16x16x32_bf16(a, b, acc, 0, 0, 0);
    }
}

#define LAS __attribute__((address_space(3)))
#define XB_TMO      128
#define XB_XCNT(j)  (256  + 64 * (j))
#define XB_XSUB(j)  (1280 + 64 * (j))
#define XB_XGEN(j)  (2304 + 64 * (j))
#define XB_TOP      3328
#define XB_TOPGEN   3392
#define XCD_BAR_WORDS 3456
#define XB_SPIN_CAP (1u << 18)

__device__ __forceinline__ unsigned xb_ld(unsigned* p)              { return __hip_atomic_load(p, __ATOMIC_RELAXED, __HIP_MEMORY_SCOPE_AGENT); }
__device__ __forceinline__ unsigned xb_add(unsigned* p, unsigned v) { return __hip_atomic_fetch_add(p, v, __ATOMIC_RELAXED, __HIP_MEMORY_SCOPE_AGENT); }
__device__ __forceinline__ unsigned xb_xcc_id() { return (unsigned)__builtin_amdgcn_s_getreg((3 << 11) | 20) & 0xFu; }
#define XB_SPIN(cond, bar) do { unsigned _sp = 0; while (cond) { __builtin_amdgcn_s_sleep(1); \
    if ((++_sp & 255u) == 0u) { if (xb_ld(&(bar)[XB_TMO])) break; if (_sp > XB_SPIN_CAP) { atomicAdd(&(bar)[XB_TMO], 1u); break; } } } } while (0)

struct XcdBarrier {
    unsigned* bar; unsigned x;
    volatile LAS unsigned* st;
};

__device__ __forceinline__ XcdBarrier xcd_barrier_post(unsigned* bar, volatile LAS unsigned* st) {
    XcdBarrier b; b.bar = bar; b.x = xb_xcc_id(); b.st = st;
    if (threadIdx.x == 0) (void)xb_add(&bar[XB_XCNT(b.x)], 1u);
    return b;
}
__device__ __forceinline__ void xcd_barrier_complete(unsigned* bar, unsigned x, unsigned& nloc, unsigned& nx) {
    const unsigned G = gridDim.x * gridDim.y * gridDim.z;
    unsigned sum, cnt, mine, sp = 0u;
    for (;;) {
        sum = 0u; cnt = 0u; mine = 0u;
#pragma unroll
        for (unsigned j = 0; j < 16; ++j) { const unsigned c = xb_ld(&bar[XB_XCNT(j)]); sum += c; cnt += (c > 0u) ? 1u : 0u; mine = (j == x) ? c : mine; }
        if (sum == G) break;
        __builtin_amdgcn_s_sleep(1);
        if ((++sp & 255u) == 0u) { if (xb_ld(&bar[XB_TMO])) break; if (sp > XB_SPIN_CAP) { atomicAdd(&bar[XB_TMO], 1u); break; } }
    }
    nloc = mine > 0u ? mine : 1u; nx = cnt > 0u ? cnt : 1u;
}

__device__ __forceinline__ void xcd_barrier(const XcdBarrier& b) {
    asm volatile("s_waitcnt vmcnt(0)" ::: "memory");
    __syncthreads();
    if (threadIdx.x == 0) {
        unsigned* bar = b.bar;
        __builtin_amdgcn_s_waitcnt(0);
        unsigned nloc = b.st[0], nx = b.st[1];
        if (nloc == 0u) { xcd_barrier_complete(bar, b.x, nloc, nx); b.st[0] = nloc; b.st[1] = nx; }
        const unsigned old = xb_add(&bar[XB_XSUB(b.x)], 1u);
        const unsigned gen = old / nloc;
        if (old + 1u == (gen + 1u) * nloc) {
            __builtin_amdgcn_fence(__ATOMIC_RELEASE, "agent");
            asm volatile("s_waitcnt vmcnt(0)" ::: "memory");
            const unsigned og = xb_add(&bar[XB_TOP], 1u);
            const unsigned tg = og / nx;
            if (og + 1u == (tg + 1u) * nx) xb_add(&bar[XB_TOPGEN], 1u);
            else XB_SPIN(xb_ld(&bar[XB_TOPGEN]) == tg, bar);
            __builtin_amdgcn_fence(__ATOMIC_ACQUIRE, "agent");
            xb_add(&bar[XB_XGEN(b.x)], 1u);
            asm volatile("s_waitcnt vmcnt(0)" ::: "memory");
        } else {
            XB_SPIN(xb_ld(&bar[XB_XGEN(b.x)]) == gen, bar);
            __builtin_amdgcn_fence(__ATOMIC_ACQUIRE, "agent");
            asm volatile("s_waitcnt vmcnt(0)" ::: "memory");
        }
    }
    __syncthreads();
}

__device__ __forceinline__ void transpose_item(const float* W, int K, int N, int nlimit, bf16_t* WT, float* scr, int item, int lane) {
    const int nblk = (nlimit + 31) / 32, kb = item / nblk, nb = item % nblk, k0 = 64 * kb, n0 = 32 * nb;
    const int nn = n0 + (lane & 31); const bool ok = nn < nlimit;
#pragma unroll 8
    for (int i = 0; i < 32; ++i) { const int kk = 2 * i + (lane >> 5); scr[kk * 33 + (lane & 31)] = ok ? W[(size_t)(k0 + kk) * N + nn] : 0.f; }
    LDS_WAIT();
    const int c = lane & 7;
#pragma unroll
    for (int j = 0; j < 4; ++j) { const int n = (lane >> 3) + 8 * j; const float* s = scr + (8 * c) * 33 + n;
        uint4 o; o.x = pk2(s[0 * 33], s[1 * 33]); o.y = pk2(s[2 * 33], s[3 * 33]); o.z = pk2(s[4 * 33], s[5 * 33]); o.w = pk2(s[6 * 33], s[7 * 33]);
        if (n0 + n < nlimit) *(uint4*)(WT + (size_t)(n0 + n) * K + k0 + 8 * c) = o; }
    LDS_WAIT();
}

__device__ __forceinline__ void prep_phase(const Prm& p, unsigned char* lds, int tid, int G) {
    const int wave = tid >> 6, lane = tid & 63, bid = blockIdx.x;
    unsigned char* ws = p.ws;
    for (int it = bid; it < 448; it += G) {
        if (it < 192) {
            const int l = it / 96, j0 = (it % 96) * 64;
            float* SIL = (float*)lds; float* RED = SIL + 5 * 1024;
            for (int e = tid; e < 5120; e += 512) { const float cv = e < 4096 ? p.in[1][e] : p.in[3][e - 4096]; SIL[e] = cv / (1.f + expf(-cv)); }
            __syncthreads();
            float a0 = 0.f, a1 = 0.f, a2 = 0.f, a3 = 0.f, a4 = 0.f;
            const float* wm = p.in[6] + ((size_t)l * 1024 + wave * 128) * 6144 + j0 + lane;
#pragma unroll 8
            for (int k = 0; k < 128; ++k) { const float w = wm[(size_t)k * 6144]; const int kk = wave * 128 + k;
                a0 += SIL[kk] * w; a1 += SIL[1024 + kk] * w; a2 += SIL[2048 + kk] * w; a3 += SIL[3072 + kk] * w; a4 += SIL[4096 + kk] * w; }
            RED[(wave * 5 + 0) * 64 + lane] = a0; RED[(wave * 5 + 1) * 64 + lane] = a1; RED[(wave * 5 + 2) * 64 + lane] = a2; RED[(wave * 5 + 3) * 64 + lane] = a3; RED[(wave * 5 + 4) * 64 + lane] = a4;
            __syncthreads();
            if (tid < 320) { const int bb = tid >> 6, ln = tid & 63; float s = p.in[7][l * 6144 + j0 + ln];
                for (int w = 0; w < 8; ++w) s += RED[(w * 5 + bb) * 64 + ln];
                ((float*)(ws + WS_MOD))[(l * 5 + bb) * 6144 + j0 + ln] = s; }
            __syncthreads();
        } else {
            const int f = it - 192; const int l = f >> 7, g = (f >> 5) & 3, part = (f >> 4) & 1, kc = f & 15;
            float* PP = (float*)lds; float* WCH = PP + 64 * 65; float* WF = WCH + 64 * 65; float* TB = WF + 64 * 65;
            for (int e = tid; e < 4096; e += 512) { const int r = e >> 6, c = e & 63;
                WF[r * 65 + c] = p.in[25][((size_t)(l * 4 + g) * 64 + r) * 64 + c];
                WCH[r * 65 + c] = p.in[8][((size_t)l * 1024 + kc * 64 + r) * WIN_N + NPLAIN + g * 64 + c]; }
            if (tid < 64) { float s, c; sincospif((float)tid / 32.f, &s, &c); TB[tid] = 0.125f * (part ? -s : c); }
            __syncthreads();
            { const int c = tid >> 3, d0 = (tid & 7) * 8; float acc[8];
#pragma unroll
              for (int e = 0; e < 8; ++e) acc[e] = 0.f;
              for (int c2 = 0; c2 < 64; ++c2) { const float tb = TB[(c * c2) & 63];
#pragma unroll
                  for (int e = 0; e < 8; ++e) acc[e] += tb * WF[c2 * 65 + d0 + e]; }
#pragma unroll
              for (int e = 0; e < 8; ++e) PP[c * 65 + d0 + e] = acc[e]; }
            __syncthreads();
            { const int d = tid >> 3, ko = tid & 7; float acc[8];
#pragma unroll
              for (int e = 0; e < 8; ++e) acc[e] = 0.f;
              for (int c = 0; c < 64; ++c) { const float pv = PP[c * 65 + d];
#pragma unroll
                  for (int e = 0; e < 8; ++e) acc[e] += WCH[(ko * 8 + e) * 65 + c] * pv; }
              bf16_t* wt = (bf16_t*)(ws + WS_WIN) + ((size_t)l * LDU + C_FZ + part * 256 + g * 64 + d) * 1024 + kc * 64 + ko * 8;
              *(uint4*)wt = pack8(acc); }
            __syncthreads();
        }
    }
    { const int gt = bid * 512 + tid, NG = G * 512; const uint4 z = {0u, 0u, 0u, 0u};
      for (int e = gt; e < 2 * 112 * 128; e += NG) { const int l = e / (112 * 128), r = e % (112 * 128);
          *(uint4*)((bf16_t*)(ws + WS_WIN) + ((size_t)l * LDU + 3472) * 1024 + (size_t)r * 8) = z; } }
    if (bid == 0) { const uint4 z = {0u, 0u, 0u, 0u}; for (int e = tid; e < 16384 / 16; e += 512) *(uint4*)(ws + WS_BARW + (size_t)e * 16) = z; }
    { const int gt = bid * 512 + tid, NG = G * 512; const uint4 z = {0u, 0u, 0u, 0u};
      for (int e = gt; e < (int)((WS_ZEND - WS_SBR) / 16); e += NG) *(uint4*)(ws + WS_SBR + (size_t)e * 16) = z; }
    float* scr = (float*)(lds + wave * 8448);
    const int gw = bid * 8 + wave, NGW = G * 8;
    for (int it = gw; it < 2 * 6096; it += NGW) {
        const int l = it / 6096; int r = it % 6096;
        if (r < 1488) { transpose_item(p.in[8] + (size_t)l * 1024 * WIN_N, 1024, WIN_N, NPLAIN, (bf16_t*)(ws + WS_WIN) + (size_t)l * LDU * 1024, scr, r, lane); continue; } r -= 1488;
        if (r < 512) { transpose_item(p.in[9] + (size_t)l * 1024 * 1024, 1024, 1024, 1024, (bf16_t*)(ws + WS_WOUT) + (size_t)l * 1024 * 1024, scr, r, lane); continue; } r -= 512;
        if (r < 2048) { transpose_item(p.in[26] + (size_t)l * 1024 * 4096, 1024, 4096, 4096, (bf16_t*)(ws + WS_W1) + (size_t)l * 4096 * 1024, scr, r, lane); continue; } r -= 2048;
        transpose_item(p.in[27] + (size_t)l * 4096 * 1024, 4096, 1024, 1024, (bf16_t*)(ws + WS_W2) + (size_t)l * 1024 * 4096, scr, r, lane);
    }
    __syncthreads();
}

__device__ __forceinline__ void bias_items(const Prm& p, int tid, int G) {
    const int wave = tid >> 6, lane = tid & 63; const int gw = blockIdx.x * 8 + wave, NGW = G * 8;
    float* BI = (float*)(p.ws + WS_BIAS);
    for (int it = gw; it < 3584 + 4096 + 4096; it += NGW) {
        int s, n; if (it < 3584) { s = 0; n = it; } else if (it < 3584 + 4096) { s = 1; n = it - 3584; } else { s = 2; n = it - 3584 - 4096; }
        const int l = (s == 1) ? 0 : 1; const int slot = (s == 0) ? 0 : 3; const int N = (s == 0) ? 3584 : 4096;
        const bf16_t* wt = (s == 0) ? (const bf16_t*)(p.ws + WS_WIN) + ((size_t)LDU + n) * 1024 : (const bf16_t*)(p.ws + WS_W1) + ((size_t)l * 4096 + n) * 1024;
        float* out = BI + (s == 0 ? 0 : (s == 1 ? 5 * 3584 : 5 * 3584 + 5 * 4096));
        const float* modl = (const float*)(p.ws + WS_MOD) + (size_t)l * 5 * 6144 + slot * 1024;
        const uint4 w0 = *(const uint4*)(wt + lane * 16), w1 = *(const uint4*)(wt + lane * 16 + 8);
        float wv[16];
#pragma unroll
        for (int e = 0; e < 8; ++e) { wv[e] = bfe(w0, e); wv[8 + e] = bfe(w1, e); }
#pragma unroll
        for (int bb = 0; bb < 5; ++bb) { const float* sh = modl + bb * 6144 + lane * 16; float a = 0.f;
#pragma unroll
            for (int e4 = 0; e4 < 4; ++e4) { const f32x4 sv = *(const f32x4*)(sh + e4 * 4); a += (sv[0] * wv[e4 * 4] + sv[1] * wv[e4 * 4 + 1]) + (sv[2] * wv[e4 * 4 + 2] + sv[3] * wv[e4 * 4 + 3]); }
            a = wave_sum(a); if (lane == 0) out[(size_t)bb * N + n] = a; }
    }
}

__device__ __forceinline__ void norm_phase(const Prm& p, int l, int mode, int tid, int G) {
    const int wave = tid >> 6, lane = tid & 63; const int gw = blockIdx.x * 8 + wave, NGW = G * 8;
    const int nrows = (mode == 2 || (mode == 1 && l == 1)) ? ML : M;
    const float* gvec = mode == 2 ? p.in[28] : (mode == 1 ? p.in[5] + l * 1024 : p.in[4] + l * 1024);
    const float* modb = (const float*)(p.ws + WS_MOD) + (size_t)l * 5 * 6144;
    bf16_t* HN = (bf16_t*)(p.ws + WS_HN);
    const bool first = (l == 0 && mode == 0);
    for (int row = gw; row < nrows; row += NGW) {
        const bool lat = row < ML; const int bb = lat ? (row >> 13) : 4;
        const float* src = lat ? ((first ? p.in[0] : p.out) + (size_t)row * 1024) : ((first ? p.in[2] : (const float*)(p.ws + WS_XC)) + (size_t)(row - ML) * 1024);
        f32x4 v[4]; float ss = 0.f;
#pragma unroll
        for (int j = 0; j < 4; ++j) { v[j] = *(const f32x4*)(src + j * 256 + lane * 4); ss += (v[j][0] * v[j][0] + v[j][1] * v[j][1]) + (v[j][2] * v[j][2] + v[j][3] * v[j][3]); }
        const float rinv = rsqrtf(wave_sum(ss) * (1.f / 1024.f) + 1e-6f);
        if (mode == 2) {
#pragma unroll
            for (int j = 0; j < 4; ++j) { const f32x4 g = *(const f32x4*)(gvec + j * 256 + lane * 4); *(f32x4*)(p.out + (size_t)row * 1024 + j * 256 + lane * 4) = v[j] * rinv * g; }
        } else {
            const float* sh = modb + bb * 6144 + (mode ? 3 : 0) * 1024; const float* sc = modb + bb * 6144 + (mode ? 4 : 1) * 1024;
#pragma unroll
            for (int j = 0; j < 4; ++j) { const int c = j * 256 + lane * 4; const f32x4 g = *(const f32x4*)(gvec + c), s1 = *(const f32x4*)(sh + c), s2 = *(const f32x4*)(sc + c);
                const f32x4 y = (v[j] * rinv * g) * (s2 + 1.f) + s1;
                uint2 o; o.x = pk2(y[0], y[1]); o.y = pk2(y[2], y[3]); *(uint2*)(HN + (size_t)row * 1024 + c) = o; }
        }
    }
}

__device__ __forceinline__ void lerp8(const bf16_t* U, size_t row, int col, bool isctx, int t, const float* mu, float* out) {
    const bf16_t* bp = U + row * LDU + col;
    const uint4 own = *(const uint4*)bp; const uint4 z = {0u, 0u, 0u, 0u};
    uint4 n0, n1, n2, n3;
    if (isctx) { n0 = (t > 0) ? *(const uint4*)(bp - LDU) : z; n1 = (t < TC - 1) ? *(const uint4*)(bp + LDU) : z; n2 = n0; n3 = n1; }
    else { const int gx = t & 63, gy = t >> 6;
        n0 = (gx > 0) ? *(const uint4*)(bp - LDU) : z; n1 = (gx < 63) ? *(const uint4*)(bp + LDU) : z;
        n2 = (gy > 0) ? *(const uint4*)(bp - 64 * LDU) : z; n3 = (gy < 127) ? *(const uint4*)(bp + 64 * LDU) : z; }
#pragma unroll
    for (int e = 0; e < 8; ++e) { const float o = bfe(own, e); const float nb = (e & 3) == 0 ? bfe(n0, e) : (e & 3) == 1 ? bfe(n1, e) : (e & 3) == 2 ? bfe(n2, e) : bfe(n3, e);
        out[e] = o + mu[e] * (nb - o); }
}

__device__ __forceinline__ void lerp8_load(const bf16_t* U, size_t row, int col, bool isctx, int t, uint4 (&r)[5]) {
    const bf16_t* bp = U + row * LDU + col; const uint4 z = {0u, 0u, 0u, 0u};
    r[0] = *(const uint4*)bp;
    if (isctx) { r[1] = (t > 0) ? *(const uint4*)(bp - LDU) : z; r[2] = (t < TC - 1) ? *(const uint4*)(bp + LDU) : z; r[3] = r[1]; r[4] = r[2]; }
    else { const int gx = t & 63, gy = t >> 6;
        r[1] = (gx > 0) ? *(const uint4*)(bp - LDU) : z; r[2] = (gx < 63) ? *(const uint4*)(bp + LDU) : z;
        r[3] = (gy > 0) ? *(const uint4*)(bp - 64 * LDU) : z; r[4] = (gy < 127) ? *(const uint4*)(bp + 64 * LDU) : z; }
}
__device__ __forceinline__ void lerp8_apply(const uint4 (&r)[5], const float* mu, float* out) {
#pragma unroll
    for (int e = 0; e < 8; ++e) { const float o = bfe(r[0], e); const float nb = (e & 3) == 0 ? bfe(r[1], e) : (e & 3) == 1 ? bfe(r[2], e) : (e & 3) == 2 ? bfe(r[3], e) : bfe(r[4], e);
        out[e] = o + mu[e] * (nb - o); }
}
__device__ __forceinline__ void chunk_coords(int c, int b, int d, int n, bool& isctx, int& t0, size_t& rowbase) {
    isctx = c < 4; const int cc = isctx ? c : c - 4; const int nch = isctx ? 4 : 128;
    t0 = (d ? (nch - 1 - cc) : cc) * 64; rowbase = isctx ? (size_t)(ML + b * TC + t0) : (size_t)(b * T + t0); (void)n;
}
__device__ __forceinline__ void gdn_raw_load(const bf16_t* U, int b, int h, int d, int c, int tid, uint4 (&rv)[7]) {
    const bool isctx = c < 4; const int cc = isctx ? c : c - 4; const int nch = isctx ? 4 : 128; const int slen = isctx ? TC : T;
    const int t0 = (d ? (nch - 1 - cc) : cc) * 64; const size_t seqbase = isctx ? (size_t)(ML + b * TC) : (size_t)(b * T);
#pragma unroll
    for (int it = 0; it < 7; ++it) { const int pc = tid + it * 512; const int rr = pc / 48, pi = pc % 48; const int tt = t0 - 2 + rr;
        const int col = pi < 16 ? C_GQ + h * 128 + pi * 8 : pi < 32 ? C_GK + h * 128 + (pi - 16) * 8 : C_GV + h * 128 + (pi - 32) * 8;
        rv[it] = (uint4){0u, 0u, 0u, 0u}; if (pc < 68 * 48 && tt >= 0 && tt < slen) rv[it] = *(const uint4*)(U + (seqbase + tt) * LDU + col); }
}

template <int MODE>
__device__ __forceinline__ void trinv64(const bf16_t* LA, const float* LD, bf16_t* TA, int ldt, bf16_t* TT, bf16_t* WT, bf16_t* T1, bf16_t* T2, const float* s1, const float* s2, int tid, int wave, int fr, int fq) {
    if (wave == 0) { const int bi = (tid & 63) >> 4, cc = tid & 15; const float* A = LD + bi * 256; float dcol[16];
#pragma unroll
        for (int r = 0; r < 16; ++r) { float v = (r == cc) ? 1.f : 0.f;
#pragma unroll
            for (int j = 0; j < r; ++j) v -= A[r * 16 + j] * dcol[j];
            dcol[r] = v; }
#pragma unroll
        for (int r = 0; r < 16; ++r) { const int R = bi * 16 + r, Cc = bi * 16 + cc; const bf16_t bv = f2bf(dcol[r]); TA[R * ldt + Cc] = bv; TT[Cc * 72 + R] = bv;
            if (MODE == 1) T1[R * 72 + Cc] = f2bf(dcol[r] * s1[Cc]); }
    } else { for (int e = tid - 64; e < 4096; e += 448) { const int r = e >> 6, c = e & 63; if ((r >> 4) != (c >> 4)) TT[r * 72 + c] = 0; WT[r * 72 + c] = 0; } }
    __syncthreads();
    if (wave < 2) { const int tm = 2 * wave + 1, tn = 2 * wave, ko = 32 * wave, r0 = tm * 16 + fq * 4, c = tn * 16 + fr;
        f32x4 acc = ZERO4; mma_seg(acc, LA + ko, 72, TT + ko, 72, tm, tn, 1, fr, fq);
#pragma unroll
        for (int j = 0; j < 4; ++j) WT[c * 72 + r0 + j] = f2bf(acc[j]); }
    __syncthreads();
    if (wave < 2) { const int tm = 2 * wave + 1, tn = 2 * wave, ko = 32 * wave, r0 = tm * 16 + fq * 4, c = tn * 16 + fr;
        f32x4 acc = ZERO4; mma_seg(acc, TA + ko, ldt, WT + ko, 72, tm, tn, 1, fr, fq);
#pragma unroll
        for (int j = 0; j < 4; ++j) { const float v = -acc[j]; const bf16_t bv = f2bf(v); TA[(r0 + j) * ldt + c] = bv; TT[c * 72 + r0 + j] = bv;
            if (MODE == 1) T1[(r0 + j) * 72 + c] = f2bf(v * s1[c]); } }
    __syncthreads();
    if (wave < 4) { const int tm = 2 + (wave >> 1), tn = wave & 1, r0 = tm * 16 + fq * 4, c = tn * 16 + fr;
        f32x4 acc = ZERO4; mma_seg(acc, LA, 72, TT, 72, tm, tn, 1, fr, fq);
#pragma unroll
        for (int j = 0; j < 4; ++j) WT[c * 72 + r0 + j] = f2bf(acc[j]); }
    __syncthreads();
    if (wave < 4) { const int tm = 2 + (wave >> 1), tn = wave & 1, r0 = tm * 16 + fq * 4, c = tn * 16 + fr;
        f32x4 acc = ZERO4; mma_seg(acc, TA + 32, ldt, WT + 32, 72, tm, tn, 1, fr, fq);
#pragma unroll
        for (int j = 0; j < 4; ++j) { const float v = -acc[j]; TA[(r0 + j) * ldt + c] = f2bf(v);
            if (MODE == 1) T1[(r0 + j) * 72 + c] = f2bf(v * s1[c]); } }
    __syncthreads();
}
__device__ __forceinline__ void rwkv_scan(const Prm& p, int l, int sid, int kblk, int nblk, unsigned char* lds, int tid) {
    const int b = sid >> 3, h = (sid >> 1) & 3, d = sid & 1;
    const int wave = tid >> 6, lane = tid & 63, fr = lane & 15, fq = lane >> 4;
    bf16_t* TL = (bf16_t*)lds;
#define RTILE(i) (TL + (i) * 4608)
    bf16_t *S0bf = RTILE(0), *KT = RTILE(1), *BTl = RTILE(2), *KL = RTILE(3), *KTt = RTILE(4), *RT = RTILE(5), *VT = RTILE(6), *BS = RTILE(7),
           *LK = RTILE(9), *MB = RTILE(10), *MK = RTILE(11), *LA = RTILE(14), *TT = RTILE(1), *WT = RTILE(2),
           *TW = RTILE(12), *X1T = RTILE(1), *PT = RTILE(2);
    float* XW = (float*)RTILE(9); float* XAf = XW + 64 * 65; bf16_t* TWD = (bf16_t*)(XAf + 64 * 65); bf16_t* ADl = TWD + 64 * 40;
    unsigned char* cb = lds + 15 * 9216;
    bf16_t* WUPt = (bf16_t*)cb; bf16_t* AUPt = WUPt + 64 * 40; float* CV = (float*)(cb + 10240); float* GL = CV + 320; float* SEG = GL + 64; float* LD = SEG + 512;
#undef RTILE
    const bf16_t* U = (const bf16_t*)(p.ws + WS_U);
    bf16_t* ORp = (bf16_t*)(p.ws + WS_OR); float* BC = (float*)(p.ws + WS_BC);
    const int n = tid >> 3, jq = tid & 7, j0 = jq * 8; const int i = d ? 63 - n : n;
    for (int e = tid; e < 2048; e += 512) { const int q = e >> 6, j = e & 63;
        WUPt[j * 40 + q] = f2bf(p.in[12][((size_t)(l * 2 + d) * 32 + q) * 256 + h * 64 + j]);
        AUPt[j * 40 + q] = f2bf(p.in[14][((size_t)(l * 2 + d) * 32 + q) * 256 + h * 64 + j]); }
    if (tid < 64) { CV[tid] = p.in[11][(l * 2 + d) * 256 + h * 64 + tid]; CV[64 + tid] = p.in[13][(l * 2 + d) * 256 + h * 64 + tid];
        CV[128 + tid] = p.in[16][l * 256 + h * 64 + tid]; CV[192 + tid] = p.in[17][l * 256 + h * 64 + tid]; CV[256 + tid] = p.in[18][l * 256 + h * 64 + tid]; }
    f32x4 accS[2]; accS[0] = ZERO4; accS[1] = ZERO4;
    u64_t* SB = (u64_t*)(p.ws + WS_SBR) + (size_t)sid * 2 * 4096; const unsigned fbase = (unsigned)l * 132u;
    float r8[8], k8[8], v8[8], x8[8];
    { const int n0_ = tid >> 3, j00 = (tid & 7) * 8; bool ic; int t0_; size_t rb_; chunk_coords(kblk, b, d, n0_, ic, t0_, rb_);
      uint4 q0[5], q1[5], q2[5], q3[5];
      lerp8_load(U, rb_ + n0_, h * 64 + j00, ic, t0_ + n0_, q0); lerp8_load(U, rb_ + n0_, 256 + h * 64 + j00, ic, t0_ + n0_, q1);
      lerp8_load(U, rb_ + n0_, 512 + h * 64 + j00, ic, t0_ + n0_, q2); lerp8_load(U, rb_ + n0_, 768 + j00, ic, t0_ + n0_, q3);
      float m0[8], m1[8], m2[8], m3[8]; const float* mup = p.in[10] + l * 896 + j00;
#pragma unroll
      for (int e = 0; e < 8; ++e) { m0[e] = mup[h * 64 + e]; m1[e] = mup[256 + h * 64 + e]; m2[e] = mup[512 + h * 64 + e]; m3[e] = mup[768 + e]; }
      lerp8_apply(q0, m0, r8); lerp8_apply(q1, m1, k8); lerp8_apply(q2, m2, v8); lerp8_apply(q3, m3, x8); }
    __syncthreads();
    for (int c = kblk; c < 132; c += nblk) {
        int tid2 = threadIdx.x; asm volatile("" : "+v"(tid2)); const int tid = tid2;
        const int wave = tid2 >> 6, lane = tid2 & 63, fr = tid2 & 15, fq = (tid2 >> 4) & 3, n = tid2 >> 3, jq = tid2 & 7;
        const int j0 = jq * 8; const int i = d ? 63 - n : n;
        const bool isctx = c < 4; const int cc = isctx ? c : c - 4; const int nch = isctx ? 4 : 128;
        const int t0 = (d ? (nch - 1 - cc) : cc) * 64;
        const size_t rowbase = isctx ? (size_t)(ML + b * TC + t0) : (size_t)(b * T + t0);
        const int t = t0 + n; const size_t row = rowbase + n;
        if (jq < 4) {
#pragma unroll
            for (int e = 0; e < 8; ++e) TWD[i * 40 + j0 + e] = f2bf(ftanh(x8[e]));
        } else {
#pragma unroll
            for (int e = 0; e < 8; ++e) ADl[i * 40 + j0 - 32 + e] = f2bf(x8[e]);
        }
        __syncthreads();
#pragma unroll
        for (int q = 0; q < 2; ++q) { const int tile = wave + 8 * q, tm = tile >> 2, tn = tile & 3, r0 = tm * 16 + fq * 4, cc2 = tn * 16 + fr;
            f32x4 a1 = ZERO4, a2 = ZERO4; mma_seg(a1, TWD, 40, WUPt, 40, tm, tn, 1, fr, fq); mma_seg(a2, ADl, 40, AUPt, 40, tm, tn, 1, fr, fq);
#pragma unroll
            for (int j = 0; j < 4; ++j) { XW[(r0 + j) * 65 + cc2] = a1[j]; XAf[(r0 + j) * 65 + cc2] = a2[j]; } }
        __syncthreads();
        float a8[8], kd8[8], kk8[8]; float ss = 0.f, bcp = 0.f;
#pragma unroll
        for (int e = 0; e < 8; ++e) { const int j = j0 + e; const float xw = XW[i * 65 + j] + CV[j], xa = XAf[i * 65 + j] + CV[64 + j];
            const float a = sigmoidf_(xa); const float wl = -softplusf_(-xw) - 0.5f; const float lw = -fexp(wl);
            const float kd = k8[e] * (1.f + (a - 1.f) * CV[192 + j]); const float kkr = k8[e] * CV[128 + j];
            ss += kkr * kkr; bcp += r8[e] * kd * CV[256 + j]; a8[e] = a; kd8[e] = kd; kk8[e] = kkr; XW[i * 65 + j] = lw; }
        ss += shx1(ss); ss += shx2(ss); ss += shx4(ss);
        bcp += shx1(bcp); bcp += shx2(bcp); bcp += shx4(bcp);
        { const float rn = rsqrtf(ss + 1e-12f);
#pragma unroll
          for (int e = 0; e < 8; ++e) kk8[e] *= rn; }
        if (jq == 0) BC[((size_t)d * M + row) * 4 + h] = bcp;
        __syncthreads();
        { const int sg = tid >> 6, j = tid & 63; float s = 0.f;
#pragma unroll
          for (int ii = 0; ii < 8; ++ii) s += XW[(sg * 8 + ii) * 65 + j];
          SEG[sg * 64 + j] = s;
          __syncthreads();
          float pre = 0.f; for (int s2 = 0; s2 < sg; ++s2) pre += SEG[s2 * 64 + j];
#pragma unroll
          for (int ii = 0; ii < 8; ++ii) { pre += XW[(sg * 8 + ii) * 65 + j]; XW[(sg * 8 + ii) * 65 + j] = pre; } }
        __syncthreads();
        { float o_kt[8], o_bt[8], o_kl[8], o_rt[8];
#pragma unroll
          for (int e = 0; e < 8; ++e) { const int j = j0 + e; const float lwi = XW[i * 65 + j], lwm = i > 0 ? XW[(i - 1) * 65 + j] : 0.f, lwl = XW[63 * 65 + j];
              const float em = fexp(lwm), ei = fexp(lwi), eni = fexp(-lwi), el = fexp(lwl - lwi); const float b_ = kk8[e] * a8[e];
              o_kt[e] = kk8[e] * em; o_bt[e] = b_ * eni; o_kl[e] = kd8[e] * eni; o_rt[e] = r8[e] * ei;
              KTt[j * 72 + i] = f2bf(o_kt[e]); BS[j * 136 + i] = f2bf(b_ * el); BS[j * 136 + 64 + i] = f2bf(kd8[e] * el); VT[j * 72 + i] = f2bf(v8[e]);
              if (i == 63) GL[j] = ei; }
          *(uint4*)(KT + i * 72 + j0) = pack8(o_kt); *(uint4*)(BTl + i * 72 + j0) = pack8(o_bt); *(uint4*)(KL + i * 72 + j0) = pack8(o_kl); *(uint4*)(RT + i * 72 + j0) = pack8(o_rt); }
        __syncthreads();
        const int cn = c + nblk; const bool have_next = cn < 132;
        uint4 pq0[5], pq1[5], pq2[5], pq3[5];
        if (have_next) { bool ic; int t0n; size_t rbn; chunk_coords(cn, b, d, n, ic, t0n, rbn);
            lerp8_load(U, rbn + n, h * 64 + j0, ic, t0n + n, pq0); lerp8_load(U, rbn + n, 256 + h * 64 + j0, ic, t0n + n, pq1);
            lerp8_load(U, rbn + n, 512 + h * 64 + j0, ic, t0n + n, pq2); lerp8_load(U, rbn + n, 768 + j0, ic, t0n + n, pq3); }
        { const uint4 z4 = {0u, 0u, 0u, 0u}; *(uint4*)(TW + (tid >> 3) * 136 + (tid & 7) * 8) = z4; }
#pragma unroll
        for (int q = 0; q < 2; ++q) { const int tile = wave + 8 * q, tm = tile >> 2, tn = tile & 3, r0 = tm * 16 + fq * 4, cx = tn * 16 + fr;
            f32x4 a1 = ZERO4, a2 = ZERO4, a3 = ZERO4, a4 = ZERO4;
            { const int ao = (tm * 16 + fr) * 72 + fq * 8, bo = (tn * 16 + fr) * 72 + fq * 8;
#pragma unroll
              for (int ks = 0; ks < 2; ++ks) { const bf16x8 fk = *(const bf16x8*)(KT + ao + ks * 32), fr_ = *(const bf16x8*)(RT + ao + ks * 32), fb = *(const bf16x8*)(BTl + bo + ks * 32), fl = *(const bf16x8*)(KL + bo + ks * 32);
                  a1 = __builtin_amdgcn_mfma_f32_16x16x32_bf16(fk, fb, a1, 0, 0, 0); a2 = __builtin_amdgcn_mfma_f32_16x16x32_bf16(fk, fl, a2, 0, 0, 0);
                  a3 = __builtin_amdgcn_mfma_f32_16x16x32_bf16(fr_, fb, a3, 0, 0, 0); a4 = __builtin_amdgcn_mfma_f32_16x16x32_bf16(fr_, fl, a4, 0, 0, 0); } }
#pragma unroll
            for (int j = 0; j < 4; ++j) { const int r = r0 + j; const float x0 = (cx < r) ? a1[j] : 0.f;
                LA[r * 72 + cx] = f2bf(x0); if (tm == tn) LD[tm * 256 + (r & 15) * 16 + (cx & 15)] = x0;
                LK[r * 72 + cx] = f2bf(cx < r ? a2[j] : 0.f); MB[r * 72 + cx] = f2bf(cx <= r ? a3[j] : 0.f); MK[r * 72 + cx] = f2bf(cx <= r ? a4[j] : 0.f); } }
        __syncthreads();
        trinv64<0>(LA, LD, TW, 136, TT, WT, nullptr, nullptr, nullptr, nullptr, tid, wave, fr, fq);
        f32x4 accO[2];
#pragma unroll
        for (int q = 0; q < 2; ++q) { const int tile = wave + 8 * q, tm = tile >> 2, tn = tile & 3, r0 = tm * 16 + fq * 4, cx = tn * 16 + fr;
            f32x4 a1 = ZERO4, a2 = ZERO4; mma_seg(a1, TW, 136, KTt, 72, tm, tn, 2, fr, fq); mma_seg(a2, LK, 72, VT, 72, tm, tn, 2, fr, fq);
#pragma unroll
            for (int j = 0; j < 4; ++j) TW[(r0 + j) * 136 + 64 + cx] = f2bf(a1[j]);
            st4bf(X1T + cx * 72 + r0, a2[0], a2[1], a2[2], a2[3]);
            accO[q] = ZERO4; mma_seg(accO[q], MK, 72, VT, 72, tm, tn, 2, fr, fq); }
        if (have_next) { float m0[8], m1[8], m2[8], m3[8]; const float* mup = p.in[10] + l * 896 + j0;
#pragma unroll
            for (int e = 0; e < 8; ++e) { m0[e] = mup[h * 64 + e]; m1[e] = mup[256 + h * 64 + e]; m2[e] = mup[512 + h * 64 + e]; m3[e] = mup[768 + e]; }
            lerp8_apply(pq0, m0, r8); lerp8_apply(pq1, m1, k8); lerp8_apply(pq2, m2, v8); lerp8_apply(pq3, m3, x8); }
        if (c > 0) { float sv[8]; recv_gran<8>(SB + (c & 1) * 4096 + tid, fbase + (unsigned)c, sv);
#pragma unroll
            for (int q = 0; q < 2; ++q)
#pragma unroll
                for (int j = 0; j < 4; ++j) accS[q][j] = sv[q * 4 + j];
        } else { accS[0] = ZERO4; accS[1] = ZERO4; }
#pragma unroll
        for (int q = 0; q < 2; ++q) { const int tile = wave + 8 * q, tm = tile >> 2, tn = tile & 3;
#pragma unroll
            for (int j = 0; j < 4; ++j) S0bf[(tm * 16 + fq * 4 + j) * 72 + tn * 16 + fr] = f2bf(accS[q][j]); }
        __syncthreads();
#pragma unroll
        for (int q = 0; q < 2; ++q) { const int tile = wave + 8 * q, tm = tile >> 2, tn = tile & 3, r0 = tm * 16 + fq * 4, cx = tn * 16 + fr;
            f32x4 a1 = ZERO4; mma_seg(a1, TW, 136, X1T, 72, tm, tn, 2, fr, fq); mma_seg(a1, TW + 64, 136, S0bf, 72, tm, tn, 2, fr, fq);
            st4bf(PT + cx * 72 + r0, -a1[0], -a1[1], -a1[2], -a1[3]); }
        __syncthreads();
        { u64_t* sbn = SB + ((c + 1) & 1) * 4096; const unsigned ep = fbase + (unsigned)c + 1u;
#pragma unroll
          for (int q = 0; q < 2; ++q) { const int tile = wave + 8 * q, tm = tile >> 2, tn = tile & 3, cx = tn * 16 + fr;
              const float g = GL[cx]; accS[q] = accS[q] * g;
              mma_seg(accS[q], PT, 72, BS, 136, tm, tn, 2, fr, fq); mma_seg(accS[q], VT, 72, BS + 64, 136, tm, tn, 2, fr, fq);
#pragma unroll
              for (int j = 0; j < 4; ++j) st_gran(sbn + (q * 4 + j) * 512 + tid, ep, accS[q][j]); } }
#pragma unroll
        for (int q = 0; q < 2; ++q) { const int tile = wave + 8 * q, tm = tile >> 2, tn = tile & 3, r0 = tm * 16 + fq * 4, cx = tn * 16 + fr;
            mma_seg(accO[q], RT, 72, S0bf, 72, tm, tn, 2, fr, fq); mma_seg(accO[q], MB, 72, PT, 72, tm, tn, 2, fr, fq);
#pragma unroll
            for (int j = 0; j < 4; ++j) { const int tt = r0 + j; const int nn = d ? 63 - tt : tt;
                ORp[((size_t)d * M + rowbase + nn) * 256 + h * 64 + cx] = f2bf(accO[q][j]); } }
        __syncthreads();
    }
}

__device__ __forceinline__ void gdn_scan(const Prm& p, int l, int sid, int kblk, int nblk, unsigned char* lds, int tid) {
    const int b = sid >> 3, h = (sid >> 1) & 3, d = sid & 1;
    bf16_t* STbf = (bf16_t*)lds; bf16_t* Qn = (bf16_t*)(lds + 17408); bf16_t* KNt = (bf16_t*)(lds + 34816); bf16_t* VT = (bf16_t*)(lds + 53248); bf16_t* QKd = (bf16_t*)(lds + 71680);
    bf16_t* XP = (bf16_t*)(lds + 80896);
    bf16_t *LA = XP, *TT = XP + 4608, *WT = XP + 2 * 4608, *TA = XP + 3 * 4608, *T1 = XP + 4 * 4608;
    bf16_t *VNt = LA, *VNs = TT, *RAW = QKd;
    bf16_t* KN = (bf16_t*)(lds + 126976); bf16_t* Wm = KN;
    float* GLs = (float*)(lds + 144384); float* GC = GLs + 64; float* BETA = GC + 64; float* SC1 = BETA + 64; float* CW = SC1 + 64; float* LD = CW + 1920;
    const bf16_t* U = (const bf16_t*)(p.ws + WS_U); bf16_t* OGp = (bf16_t*)(p.ws + WS_OG);
    for (int e = tid; e < 1920; e += 512) { const int tap = e / 384, cc = e % 384;
        const int ch = cc < 128 ? h * 128 + cc : cc < 256 ? 512 + h * 128 + (cc - 128) : 1024 + h * 128 + (cc - 256);
        CW[e] = p.in[21][((size_t)l * 5 + tap) * 1536 + ch]; }
    const float a_exp = fexp(p.in[22][(l * 2 + d) * 4 + h]); const float dtb = p.in[23][(l * 2 + d) * 4 + h];
    f32x4 accS[8];
#pragma unroll
    for (int q = 0; q < 8; ++q) accS[q] = ZERO4;
    u64_t* SB = (u64_t*)(p.ws + WS_SBG) + (size_t)sid * 2 * 16384; const unsigned fbase = (unsigned)l * 132u;
    uint4 rv[7]; gdn_raw_load(U, b, h, d, kblk, tid, rv);
    __syncthreads();
    for (int c = kblk; c < 132; c += nblk) {
        int tid2 = threadIdx.x; asm volatile("" : "+v"(tid2)); const int tid = tid2;
        const int wave = tid2 >> 6, lane = tid2 & 63, fr = tid2 & 15, fq = (tid2 >> 4) & 3, n = tid2 >> 3, jq = tid2 & 7;
        const int i = d ? 63 - n : n;
        const bool isctx = c < 4; const int cc = isctx ? c : c - 4; const int nch = isctx ? 4 : 128; const int slen = isctx ? TC : T;
        const int t0 = (d ? (nch - 1 - cc) : cc) * 64;
        const size_t seqbase = isctx ? (size_t)(ML + b * TC) : (size_t)(b * T);
        const size_t rowbase = seqbase + t0;
#pragma unroll
        for (int it = 0; it < 7; ++it) { const int pc = tid + it * 512; const int rr = pc / 48, pi = pc % 48; if (pc < 68 * 48) *(uint4*)(RAW + rr * 392 + pi * 8) = rv[it]; }
        __syncthreads();
        { float qv[16];
          const bf16_t* up = U + (rowbase + n) * LDU + C_GS; const float beta_n = sigmoidf_(bf2f(up[d * 4 + h]));
#pragma unroll
          for (int e = 0; e < 16; ++e) qv[e] = 0.f;
#pragma unroll
          for (int tap = 0; tap < 5; ++tap) { const uint4 r0 = *(const uint4*)(RAW + (n + tap) * 392 + jq * 16), r1 = *(const uint4*)(RAW + (n + tap) * 392 + jq * 16 + 8);
              const float* cw = CW + tap * 384 + jq * 16;
#pragma unroll
              for (int e = 0; e < 8; ++e) { qv[e] += cw[e] * bfe(r0, e); qv[8 + e] += cw[8 + e] * bfe(r1, e); } }
          float sq = 0.f;
#pragma unroll
          for (int e = 0; e < 16; ++e) { const float a = siluf_(qv[e]); qv[e] = a; sq += a * a; }
          sq += shx1(sq); sq += shx2(sq); sq += shx4(sq);
          { const float rq = rsqrtf(sq + 1e-6f) * 0.08838834764831845f;
#pragma unroll
            for (int e = 0; e < 16; ++e) qv[e] *= rq; }
          *(uint4*)(Qn + i * 136 + jq * 16) = pack8(qv); *(uint4*)(Qn + i * 136 + jq * 16 + 8) = pack8(qv + 8);
          __builtin_amdgcn_sched_barrier(0);
#pragma unroll
          for (int e = 0; e < 16; ++e) qv[e] = 0.f;
#pragma unroll
          for (int tap = 0; tap < 5; ++tap) { const uint4 r0 = *(const uint4*)(RAW + (n + tap) * 392 + 128 + jq * 16), r1 = *(const uint4*)(RAW + (n + tap) * 392 + 128 + jq * 16 + 8);
              const float* cw = CW + tap * 384 + 128 + jq * 16;
#pragma unroll
              for (int e = 0; e < 8; ++e) { qv[e] += cw[e] * bfe(r0, e); qv[8 + e] += cw[8 + e] * bfe(r1, e); } }
          float sk = 0.f;
#pragma unroll
          for (int e = 0; e < 16; ++e) { const float a = siluf_(qv[e]); qv[e] = a; sk += a * a; }
          sk += shx1(sk); sk += shx2(sk); sk += shx4(sk);
          { const float rk = rsqrtf(sk + 1e-6f);
#pragma unroll
            for (int e = 0; e < 16; ++e) { qv[e] *= rk; KNt[(jq * 16 + e) * 72 + (i ^ (jq << 3))] = f2bf(qv[e]); } }
          *(uint4*)(KN + i * 136 + jq * 16) = pack8(qv); *(uint4*)(KN + i * 136 + jq * 16 + 8) = pack8(qv + 8);
          __builtin_amdgcn_sched_barrier(0);
#pragma unroll
          for (int e = 0; e < 16; ++e) qv[e] = 0.f;
#pragma unroll
          for (int tap = 0; tap < 5; ++tap) { const uint4 r0 = *(const uint4*)(RAW + (n + tap) * 392 + 256 + jq * 16), r1 = *(const uint4*)(RAW + (n + tap) * 392 + 256 + jq * 16 + 8);
              const float* cw = CW + tap * 384 + 256 + jq * 16;
#pragma unroll
              for (int e = 0; e < 8; ++e) { qv[e] += cw[e] * bfe(r0, e); qv[8 + e] += cw[8 + e] * bfe(r1, e); } }
#pragma unroll
          for (int e = 0; e < 16; ++e) VT[(jq * 16 + e) * 72 + (i ^ (jq << 3))] = f2bf(siluf_(qv[e]) * beta_n);
          if (jq == 0) { const float sa = bf2f(up[8 + d * 4 + h]); BETA[i] = beta_n; GLs[i] = -a_exp * softplusf_(sa + dtb); } }
        __syncthreads();
        if (wave == 0) { float x = GLs[lane];
#pragma unroll
            for (int o = 1; o < 64; o <<= 1) { const float y = __int_as_float(__builtin_amdgcn_ds_bpermute((lane - o) << 2, __float_as_int(x))); if (lane >= o) x += y; }
            GC[lane] = x; SC1[lane] = BETA[lane] * fexp(x); }
        __syncthreads();
        if (c + nblk < 132) gdn_raw_load(U, b, h, d, c + nblk, tid, rv);
        { const uint4 z4 = {0u, 0u, 0u, 0u}; *(uint4*)(TA + (tid >> 3) * 72 + (tid & 7) * 8) = z4; *(uint4*)(T1 + (tid >> 3) * 72 + (tid & 7) * 8) = z4; }
#pragma unroll
        for (int q = 0; q < 2; ++q) { const int tix = wave + 8 * q, tm = tix >> 2, tn = tix & 3, r0 = tm * 16 + fq * 4, cx = tn * 16 + fr;
            f32x4 a1 = ZERO4, a2 = ZERO4;
            const bf16_t* bp = KN + (tn * 16 + fr) * 136 + fq * 8; const bf16_t* ap1 = KN + (tm * 16 + fr) * 136 + fq * 8; const bf16_t* ap2 = Qn + (tm * 16 + fr) * 136 + fq * 8;
#pragma unroll
            for (int ks = 0; ks < 4; ++ks) { const bf16x8 bfr = *(const bf16x8*)(bp + ks * 32);
                a1 = __builtin_amdgcn_mfma_f32_16x16x32_bf16(*(const bf16x8*)(ap1 + ks * 32), bfr, a1, 0, 0, 0);
                a2 = __builtin_amdgcn_mfma_f32_16x16x32_bf16(*(const bf16x8*)(ap2 + ks * 32), bfr, a2, 0, 0, 0); }
#pragma unroll
            for (int j = 0; j < 4; ++j) { const int r = r0 + j; const float dec = fexp(GC[r] - GC[cx]); const float x0 = (cx < r) ? a1[j] * BETA[r] * dec : 0.f;
                LA[r * 72 + cx] = f2bf(x0); if (tm == tn) LD[tm * 256 + (r & 15) * 16 + (cx & 15)] = x0;
                QKd[r * 72 + cx] = f2bf((cx <= r) ? a2[j] * dec : 0.f); } }
        __syncthreads();
        trinv64<1>(LA, LD, TA, 72, TT, WT, T1, nullptr, SC1, nullptr, tid, wave, fr, fq);
        { const bf16_t* bp = KNt + (wave * 16 + fr) * 72;
          const bf16x8 b0 = *(const bf16x8*)(bp + ((fq * 8) ^ (wave << 3))), b1 = *(const bf16x8*)(bp + ((32 + fq * 8) ^ (wave << 3)));
#pragma unroll
          for (int q = 0; q < 4; ++q) { const bf16_t* ap = T1 + (q * 16 + fr) * 72 + fq * 8; f32x4 a1 = ZERO4;
              a1 = __builtin_amdgcn_mfma_f32_16x16x32_bf16(*(const bf16x8*)ap, b0, a1, 0, 0, 0); a1 = __builtin_amdgcn_mfma_f32_16x16x32_bf16(*(const bf16x8*)(ap + 32), b1, a1, 0, 0, 0);
#pragma unroll
              for (int j = 0; j < 4; ++j) Wm[(q * 16 + fq * 4 + j) * 136 + wave * 16 + fr] = f2bf(-a1[j]); } }
        const float gl63 = GC[63]; const float eg = fexp(gl63);
        u64_t* sbn = SB + ((c + 1) & 1) * 16384; const unsigned ep = fbase + (unsigned)c + 1u;
#pragma unroll
        for (int vh = 0; vh < 2; ++vh) {
            if (c > 0) { float sv[16]; recv_gran<16>(SB + (c & 1) * 16384 + (vh * 16) * 512 + tid, fbase + (unsigned)c, sv);
#pragma unroll
                for (int q = 0; q < 4; ++q)
#pragma unroll
                    for (int j = 0; j < 4; ++j) accS[vh * 4 + q][j] = sv[q * 4 + j];
            } else {
#pragma unroll
                for (int q = 0; q < 4; ++q) accS[vh * 4 + q] = ZERO4; }
#pragma unroll
            for (int q = 0; q < 4; ++q) { const int tile = wave + 8 * q, tm = tile >> 3, tn = tile & 7;
#pragma unroll
                for (int j = 0; j < 4; ++j) STbf[(tm * 16 + fq * 4 + j) * 136 + tn * 16 + fr] = f2bf(accS[vh * 4 + q][j]); }
            __syncthreads();
#pragma unroll
            for (int q2 = 0; q2 < 2; ++q2) { const int tile = wave + 8 * q2, tm = tile >> 2, tn = tile & 3, r0 = tm * 16 + fq * 4, cx = tn * 16 + fr;
                f32x4 au = ZERO4; mma_seg_bs(au, TA, 72, VT + (vh * 64) * 72, 72, tm, tn, 2, fr, fq, (vh * 4 + tn) & 7);
                mma_seg(au, Wm, 136, STbf, 136, tm, tn, 4, fr, fq);
                st4bf(VNt + cx * 72 + r0, au[0], au[1], au[2], au[3]);
                st4bf(VNs + cx * 72 + r0, au[0] * fexp(gl63 - GC[r0]), au[1] * fexp(gl63 - GC[r0 + 1]), au[2] * fexp(gl63 - GC[r0 + 2]), au[3] * fexp(gl63 - GC[r0 + 3])); }
            __syncthreads();
            { const bf16_t* bp = KNt + (wave * 16 + fr) * 72;
              const bf16x8 b0 = *(const bf16x8*)(bp + ((fq * 8) ^ (wave << 3))), b1 = *(const bf16x8*)(bp + ((32 + fq * 8) ^ (wave << 3)));
#pragma unroll
              for (int q = 0; q < 4; ++q) { const bf16_t* ap = VNs + (q * 16 + fr) * 72 + fq * 8; f32x4 a1 = accS[vh * 4 + q] * eg;
                  a1 = __builtin_amdgcn_mfma_f32_16x16x32_bf16(*(const bf16x8*)ap, b0, a1, 0, 0, 0); a1 = __builtin_amdgcn_mfma_f32_16x16x32_bf16(*(const bf16x8*)(ap + 32), b1, a1, 0, 0, 0);
                  accS[vh * 4 + q] = a1;
#pragma unroll
                  for (int j = 0; j < 4; ++j) st_gran(sbn + ((vh * 4 + q) * 4 + j) * 512 + tid, ep, a1[j]); } }
#pragma unroll
            for (int q2 = 0; q2 < 2; ++q2) { const int tile = wave + 8 * q2, tm = tile >> 2, tn = tile & 3, r0 = tm * 16 + fq * 4, cx = tn * 16 + fr;
                f32x4 a1 = ZERO4, a2 = ZERO4; mma_seg(a1, Qn, 136, STbf, 136, tm, tn, 4, fr, fq); mma_seg(a2, QKd, 72, VNt, 72, tm, tn, 2, fr, fq);
#pragma unroll
                for (int j = 0; j < 4; ++j) { const int tt = r0 + j; const int nn = d ? 63 - tt : tt; const float o = fexp(GC[tt]) * a1[j] + a2[j];
                    OGp[((size_t)d * M + rowbase + nn) * 512 + h * 128 + vh * 64 + cx] = f2bf(o); } }
            __syncthreads();
        }
    }
}
__device__ __forceinline__ void fft1_item(const Prm& p, int item, unsigned char* lds, int tid) {
    const int b = item >> 7, t2 = item & 127; const int wave = tid >> 6, lane = tid & 63, fr = lane & 15, fq = lane >> 4;
    bf16_t* A1 = (bf16_t*)lds; bf16_t* Bt = A1 + 128 * 136;
    const bf16_t* U = (const bf16_t*)(p.ws + WS_U); bf16_t* MID = (bf16_t*)(p.ws + WS_MID);
    for (int e = tid; e < 4096; e += 512) { const int f1 = e >> 6, t1 = e & 63; const int m = (f1 * (128 * t1 + t2)) & 8191; const float s = __builtin_amdgcn_sinf((float)m * (1.f / 8192.f)), c = __builtin_amdgcn_cosf((float)m * (1.f / 8192.f));
        A1[f1 * 136 + t1] = f2bf(c); A1[f1 * 136 + 64 + t1] = f2bf(s); A1[(64 + f1) * 136 + t1] = f2bf(-s); A1[(64 + f1) * 136 + 64 + t1] = f2bf(c); }
    { const int t1 = tid >> 3, pc = tid & 7; const bf16_t* up = U + ((size_t)b * T + 128 * t1 + t2) * LDU + C_FZ + pc * 64;
#pragma unroll
      for (int g8 = 0; g8 < 8; ++g8) { const uint4 v = *(const uint4*)(up + g8 * 8); const int col = pc * 64 + g8 * 8; const int part = col >> 8, ch = col & 255;
#pragma unroll
          for (int e = 0; e < 8; ++e) Bt[(ch + e) * 136 + part * 64 + t1] = f2bf(bfe(v, e)); } }
    __syncthreads();
    for (int tile = wave; tile < 128; tile += 8) { const int tm = tile >> 4, tn = tile & 15, r0 = tm * 16 + fq * 4, ch = tn * 16 + fr;
        f32x4 acc = ZERO4; mma_seg(acc, A1, 136, Bt, 136, tm, tn, 4, fr, fq);
#pragma unroll
        for (int j = 0; j < 4; ++j) { const int r = r0 + j, po = r >> 6, f1 = r & 63;
            MID[(((size_t)b * 64 + f1) * 128 + t2) * 512 + po * 256 + ch] = f2bf(acc[j]); } }
    __syncthreads();
}
__device__ __forceinline__ void fft2_item(const Prm& p, int item, unsigned char* lds, int tid) {
    const int b = item >> 7, f1 = (item >> 1) & 63, chh = item & 1; const int wave = tid >> 6, lane = tid & 63, fr = lane & 15, fq = lane >> 4;
    bf16_t* A2 = (bf16_t*)lds; bf16_t* Bt = A2 + 128 * 264;
    const bf16_t* MID = (const bf16_t*)(p.ws + WS_MID); bf16_t* Y = (bf16_t*)(p.ws + WS_Y);
    { const int t2 = tid >> 2, q = tid & 3, pi = q >> 1, hf = q & 1; const bf16_t* mp = MID + (((size_t)b * 64 + f1) * 128 + t2) * 512 + pi * 256 + chh * 128 + hf * 64;
#pragma unroll
      for (int g8 = 0; g8 < 8; ++g8) { const uint4 v = *(const uint4*)(mp + g8 * 8);
#pragma unroll
          for (int e = 0; e < 8; ++e) Bt[(hf * 64 + g8 * 8 + e) * 264 + pi * 128 + t2] = f2bf(bfe(v, e)); } }
    __syncthreads();
    for (int tile = wave; tile < 64; tile += 8) { const int tm = tile >> 3, tn = tile & 7, r0 = tm * 16 + fq * 4, ch = tn * 16 + fr;
        f32x4 acc = ZERO4; mma_seg(acc, A2, 264, Bt, 264, tm, tn, 8, fr, fq);
#pragma unroll
        for (int j = 0; j < 4; ++j) { const int f2 = r0 + j; Y[((size_t)b * T + f1 + 64 * f2) * 1024 + 768 + chh * 128 + ch] = f2bf(acc[j] * 0.011048543456039806f); } }
    __syncthreads();
}
__device__ __forceinline__ void fftc_item(const Prm& p, int item, unsigned char* lds, int tid) {
    const int b = item >> 4, ft = (item >> 2) & 3, cq = item & 3; const int wave = tid >> 6, lane = tid & 63, fr = lane & 15, fq = lane >> 4;
    bf16_t* A3 = (bf16_t*)lds; bf16_t* Bt = A3 + 64 * 520;
    const bf16_t* U = (const bf16_t*)(p.ws + WS_U); bf16_t* Y = (bf16_t*)(p.ws + WS_Y);
    for (int e = tid; e < 64 * 256; e += 512) { const int fl = e >> 8, t = e & 255; const int m = ((ft * 64 + fl) * t) & 255; const float s = __builtin_amdgcn_sinf((float)m * (1.f / 256.f)), c = __builtin_amdgcn_cosf((float)m * (1.f / 256.f));
        A3[fl * 520 + t] = f2bf(c); A3[fl * 520 + 256 + t] = f2bf(s); }
    { const int t = tid >> 1, pi = tid & 1; const bf16_t* up = U + ((size_t)ML + b * TC + t) * LDU + C_FZ + pi * 256 + cq * 64;
#pragma unroll
      for (int g8 = 0; g8 < 8; ++g8) { const uint4 v = *(const uint4*)(up + g8 * 8);
#pragma unroll
          for (int e = 0; e < 8; ++e) Bt[(g8 * 8 + e) * 520 + pi * 256 + t] = f2bf(bfe(v, e)); } }
    __syncthreads();
    for (int tile = wave; tile < 16; tile += 8) { const int tm = tile >> 2, tn = tile & 3, r0 = tm * 16 + fq * 4, ch = tn * 16 + fr;
        f32x4 acc = ZERO4; mma_seg(acc, A3, 520, Bt, 520, tm, tn, 16, fr, fq);
#pragma unroll
        for (int j = 0; j < 4; ++j) Y[((size_t)ML + b * TC + ft * 64 + r0 + j) * 1024 + 768 + cq * 64 + ch] = f2bf(acc[j] * 0.0625f); }
    __syncthreads();
}

__device__ __forceinline__ void rwkv_post_tile(const Prm& p, int l, int tile, unsigned char* lds, int tid_in) {
    int tid = threadIdx.x; asm volatile("" : "+v"(tid));
    const int wave = tid >> 6, lane = tid & 63, fr = lane & 15, fq = lane >> 4;
    bf16_t* GUPt = (bf16_t*)lds; bf16_t* SG = GUPt + 256 * 72; float* GATE = (float*)(SG + 64 * 72);
    const bf16_t* U = (const bf16_t*)(p.ws + WS_U); const bf16_t* ORp = (const bf16_t*)(p.ws + WS_OR); const float* BC = (const float*)(p.ws + WS_BC); bf16_t* Y = (bf16_t*)(p.ws + WS_Y);
    const int n = tid >> 3, jq = tid & 7; const size_t row = (size_t)tile * 64 + n; const bool isctx = row >= (size_t)ML; const int t = isctx ? (int)((row - ML) & (TC - 1)) : (int)(row & (T - 1));
    const float* mu = p.in[10] + l * 896;
    const int cb = jq * 32, hh = jq >> 1;
    uint4 oa[4], ob[4], vr0[5], vr1[5], vr2[5], vr3[5];
#pragma unroll
    for (int g8 = 0; g8 < 4; ++g8) { oa[g8] = *(const uint4*)(ORp + row * 256 + cb + g8 * 8); ob[g8] = *(const uint4*)(ORp + ((size_t)M + row) * 256 + cb + g8 * 8); }
    lerp8_load(U, row, 512 + cb, isctx, t, vr0); lerp8_load(U, row, 512 + cb + 8, isctx, t, vr1); lerp8_load(U, row, 512 + cb + 16, isctx, t, vr2); lerp8_load(U, row, 512 + cb + 24, isctx, t, vr3);
    const float bcs = BC[row * 4 + hh] + BC[((size_t)M + row) * 4 + hh];
    { float m8[8], g8[8];
      { const f32x4 ma = *(const f32x4*)(mu + 832 + jq * 8), mb = *(const f32x4*)(mu + 832 + jq * 8 + 4);
#pragma unroll
        for (int e = 0; e < 4; ++e) { m8[e] = ma[e]; m8[4 + e] = mb[e]; } }
      lerp8(U, row, 832 + jq * 8, isctx, t, m8, g8);
#pragma unroll
      for (int e = 0; e < 8; ++e) g8[e] = sigmoidf_(g8[e]);
      *(uint4*)(SG + n * 72 + jq * 8) = pack8(g8); }
    __syncthreads();
    for (int tl = wave; tl < 64; tl += 8) { const int tm = tl >> 4, tn = tl & 15, r0 = tm * 16 + fq * 4, cx = tn * 16 + fr;
        f32x4 acc = ZERO4; mma_seg(acc, SG, 72, GUPt, 72, tm, tn, 2, fr, fq);
#pragma unroll
        for (int j = 0; j < 4; ++j) GATE[(r0 + j) * 260 + cx] = acc[j]; }
    __syncthreads();
    { float o[32]; float s = 0.f;
#pragma unroll
      for (int g8 = 0; g8 < 4; ++g8)
#pragma unroll
          for (int e = 0; e < 8; ++e) { o[g8 * 8 + e] = bfe(oa[g8], e) + bfe(ob[g8], e); s += o[g8 * 8 + e]; }
      s += shx1(s); const float mean = s * (1.f / 64.f); float vs = 0.f;
#pragma unroll
      for (int e = 0; e < 32; ++e) { const float dd = o[e] - mean; vs += dd * dd; }
      vs += shx1(vs); const float rstd = rsqrtf(vs * (1.f / 64.f) + 64e-5f);
#pragma unroll
      for (int g8 = 0; g8 < 4; ++g8) { float m8[8], v8[8], y8[8], lg[8], lb[8];
          { const float* mp = mu + 512 + cb + g8 * 8; const float* gp = p.in[19] + l * 256 + cb + g8 * 8; const float* bp2 = p.in[20] + l * 256 + cb + g8 * 8;
            const f32x4 ma = *(const f32x4*)mp, mb = *(const f32x4*)(mp + 4), ga = *(const f32x4*)gp, gb = *(const f32x4*)(gp + 4), ba = *(const f32x4*)bp2, bb2 = *(const f32x4*)(bp2 + 4);
#pragma unroll
            for (int e = 0; e < 4; ++e) { m8[e] = ma[e]; m8[4 + e] = mb[e]; lg[e] = ga[e]; lg[4 + e] = gb[e]; lb[e] = ba[e]; lb[4 + e] = bb2[e]; } }
          if (g8 == 0) lerp8_apply(vr0, m8, v8); else if (g8 == 1) lerp8_apply(vr1, m8, v8); else if (g8 == 2) lerp8_apply(vr2, m8, v8); else lerp8_apply(vr3, m8, v8);
          const f32x4 ga0 = *(const f32x4*)(GATE + n * 260 + cb + g8 * 8), ga1 = *(const f32x4*)(GATE + n * 260 + cb + g8 * 8 + 4);
#pragma unroll
          for (int e = 0; e < 8; ++e) { const float yn = (o[g8 * 8 + e] - mean) * rstd * lg[e] + lb[e];
              y8[e] = (yn + bcs * v8[e]) * (e < 4 ? ga0[e] : ga1[e - 4]); }
          *(uint4*)(Y + row * 1024 + cb + g8 * 8) = pack8(y8); } }
    __syncthreads();
}
__device__ __forceinline__ void gdn_post_tile(const Prm& p, int l, int tile, int tid_in) {
    int tid = threadIdx.x; asm volatile("" : "+v"(tid));
    const bf16_t* U = (const bf16_t*)(p.ws + WS_U); const bf16_t* OGp = (const bf16_t*)(p.ws + WS_OG); bf16_t* Y = (bf16_t*)(p.ws + WS_Y);
    const int n = tid >> 3, jq = tid & 7; const size_t row = (size_t)tile * 64 + n; const int cb = jq * 64;
    uint4 oa[8], ob[8], zq[8];
#pragma unroll
    for (int g8 = 0; g8 < 8; ++g8) { oa[g8] = *(const uint4*)(OGp + row * 512 + cb + g8 * 8); ob[g8] = *(const uint4*)(OGp + ((size_t)M + row) * 512 + cb + g8 * 8);
        zq[g8] = *(const uint4*)(U + row * LDU + C_GZ + cb + g8 * 8); }
    float ss = 0.f;
#pragma unroll
    for (int g8 = 0; g8 < 8; ++g8)
#pragma unroll
        for (int e = 0; e < 8; ++e) { const float o = bfe(oa[g8], e) + bfe(ob[g8], e); ss += o * o; }
    ss += shx1(ss); const float rinv = rsqrtf(ss * (1.f / 128.f) + 1e-6f);
#pragma unroll
    for (int g8 = 0; g8 < 8; ++g8) { float y8[8], ng[8];
        { const float* np = p.in[24] + l * 128 + ((cb + g8 * 8) & 127); const f32x4 na = *(const f32x4*)np, nb2 = *(const f32x4*)(np + 4);
#pragma unroll
          for (int e = 0; e < 4; ++e) { ng[e] = na[e]; ng[4 + e] = nb2[e]; } }
#pragma unroll
        for (int e = 0; e < 8; ++e) { const float o = bfe(oa[g8], e) + bfe(ob[g8], e); const float z = bfe(zq[g8], e); y8[e] = o * rinv * ng[e] * siluf_(z); }
        *(uint4*)(Y + row * 1024 + 256 + cb + g8 * 8) = pack8(y8); }
}
__device__ __forceinline__ void post_phase(const Prm& p, int l, unsigned char* lds, int tid, int G) {
    const int bid = blockIdx.x; const int ntile = (l == 0) ? M / 64 : ML / 64;
    if (bid < ntile) { bf16_t* GUPt = (bf16_t*)lds;
        for (int e = tid; e < 64 * 256; e += 512) { const int q = e >> 8, c = e & 255; GUPt[c * 72 + q] = f2bf(p.in[15][((size_t)l * 64 + q) * 256 + c]); }
        __syncthreads();
#ifdef PROBE_RPOST
        for (int rp = 0; rp < PROBE_RPOST; ++rp)
#endif
        for (int tile = bid; tile < ntile; tile += G) rwkv_post_tile(p, l, tile, lds, tid); }
#ifdef PROBE_GPOST
    for (int rp = 0; rp < PROBE_GPOST; ++rp)
#endif
    for (int tile = bid; tile < ntile; tile += G) gdn_post_tile(p, l, tile, tid);
    __syncthreads();
    if (bid < 512) { bf16_t* A2 = (bf16_t*)lds;
        for (int e = tid; e < 128 * 128; e += 512) { const int f2 = e >> 7, t2 = e & 127; const int m = (f2 * t2) & 127; const float s = __builtin_amdgcn_sinf((float)m * (1.f / 128.f)), c = __builtin_amdgcn_cosf((float)m * (1.f / 128.f));
            A2[f2 * 264 + t2] = f2bf(c); A2[f2 * 264 + 128 + t2] = f2bf(s); }
        __syncthreads();
        for (int it = bid; it < 512; it += G) fft2_item(p, it, lds, tid); }
    if (l == 0 && bid >= G - 64) fftc_item(p, bid - (G - 64), lds, tid);
}

#ifndef PHMASK
#define PHMASK 0x3ffff
#endif
#define PH_IN(k) (((PHMASK >> (k)) & 1) && lo <= (k) && (k) < hi)
#ifndef DUPMASK
#define DUPMASK 0
#endif
#define PH_REP(k) for (int rep_ = 0; rep_ <= ((DUPMASK >> (k)) & 1); ++rep_)
#define PH_SYNC(k) do { if (PH_IN(k) && PH_IN((k) + 1)) { if ((k) == 0) grid.sync(); else xcd_barrier(xbar); } } while (0)
template <int L>
__device__ __forceinline__ void layer_phases(const Prm& p, cg::grid_group& grid, const XcdBarrier& xbar, unsigned char* lds, int lo, int hi) {
    constexpr int l = L; constexpr int base = 1 + 8 * L;
    if (L == 0) { if (PH_IN(base + 0)) PH_REP(base + 0) { int tid = threadIdx.x; asm volatile("" : "+v"(tid)); norm_phase(p, l, 0, tid, gridDim.x); bias_items(p, tid, gridDim.x); }
        PH_SYNC(base + 0); }
    if (PH_IN(base + 1)) PH_REP(base + 1) { unsigned char* ws = p.ws; const int G = gridDim.x, bid = blockIdx.x;
        pg8::Gemm g{(const bf16_t*)(ws + WS_HN), (const bf16_t*)(ws + WS_WIN) + (size_t)l * LDU * 1024, M, LDU, 1024}; pg8::StaticOrder S; S.init(M, LDU, G, bid);
        if (L == 0) { pg8::EpiBf16<0> E{(bf16_t*)(ws + WS_U), LDU};
            pg8::gemm_phase<pg8::EpiBf16<0>, pg8::StaticOrder, true, true>((PG8_LAS unsigned char*)lds, g, S, E); }
        else { pg8::EpiBf16RS<0> E{(bf16_t*)(ws + WS_U), LDU, (const float*)(ws + WS_SS) + 2 * M, (const float*)(ws + WS_BIAS), 3584};
            pg8::gemm_phase<pg8::EpiBf16RS<0>, pg8::StaticOrder, true, true>((PG8_LAS unsigned char*)lds, g, S, E); } }
    PH_SYNC(base + 1);
    if (PH_IN(base + 2)) PH_REP(base + 2) { int tid = threadIdx.x; asm volatile("" : "+v"(tid)); const int G = gridDim.x, bid = blockIdx.x;
        if (G >= 256) { if (bid < 128) rwkv_scan(p, l, bid >> 2, bid & 3, 4, lds, tid); else if (bid < 256) gdn_scan(p, l, (bid - 128) >> 2, bid & 3, 4, lds, tid);
            if (bid < 128) for (int it = bid; it < 512; it += 128) fft1_item(p, it, lds, tid); }
        else { if (bid < 32) rwkv_scan(p, l, bid, 0, 1, lds, tid); else if (bid < 64) gdn_scan(p, l, bid - 32, 0, 1, lds, tid);
            else for (int it = bid - 64; it < 512; it += G - 64) fft1_item(p, it, lds, tid); } }
    PH_SYNC(base + 2);
    if (PH_IN(base + 3)) PH_REP(base + 3) { int tid = threadIdx.x; asm volatile("" : "+v"(tid)); post_phase(p, l, lds, tid, gridDim.x); }
    PH_SYNC(base + 3);
    if (PH_IN(base + 4)) PH_REP(base + 4) { unsigned char* ws = p.ws; const int G = gridDim.x, bid = blockIdx.x; const float* modl = (const float*)(ws + WS_MOD) + (size_t)l * 5 * 6144;
        constexpr int Mg = (l == 0) ? M : ML;
        pg8::Gemm g{(const bf16_t*)(ws + WS_Y), (const bf16_t*)(ws + WS_WOUT) + (size_t)l * 1024 * 1024, Mg, 1024, 1024}; pg8::StaticOrder S; S.init(Mg, 1024, G, bid);
        pg8::EpiResidN E{l == 0 ? p.in[0] : p.out, l == 0 ? p.in[2] : (const float*)(ws + WS_XC), p.out, (float*)(ws + WS_XC), modl + 2 * 1024,
                         (bf16_t*)(ws + WS_HN), (float*)(ws + WS_SS) + l * M, p.in[5] + l * 1024, modl + 4 * 1024};
        pg8::gemm_phase<pg8::EpiResidN, pg8::StaticOrder, true, true>((PG8_LAS unsigned char*)lds, g, S, E); }
    PH_SYNC(base + 4);
    if (PH_IN(base + 6)) PH_REP(base + 6) { unsigned char* ws = p.ws; const int G = gridDim.x, bid = blockIdx.x; constexpr int Mg = (l == 0) ? M : ML;
        pg8::Gemm g{(const bf16_t*)(ws + WS_HN), (const bf16_t*)(ws + WS_W1) + (size_t)l * 4096 * 1024, Mg, DFF, 1024}; pg8::StaticOrder S; S.init(Mg, DFF, G, bid);
        pg8::EpiBf16RS<1> E{(bf16_t*)(ws + WS_H), DFF, (const float*)(ws + WS_SS) + l * M, (const float*)(ws + WS_BIAS) + 5 * 3584 + l * 5 * 4096, 4096};
        pg8::gemm_phase<pg8::EpiBf16RS<1>, pg8::StaticOrder, true, true>((PG8_LAS unsigned char*)lds, g, S, E); }
    PH_SYNC(base + 6);
    if (PH_IN(base + 7)) PH_REP(base + 7) { unsigned char* ws = p.ws; const int G = gridDim.x, bid = blockIdx.x; const float* modl = (const float*)(ws + WS_MOD) + (size_t)l * 5 * 6144; constexpr int Mg = (l == 0) ? M : ML;
        pg8::Gemm g{(const bf16_t*)(ws + WS_H), (const bf16_t*)(ws + WS_W2) + (size_t)l * 1024 * 4096, Mg, 1024, DFF}; pg8::StaticOrder S; S.init(Mg, 1024, G, bid);
        if (L == 0) { const float* modn = (const float*)(ws + WS_MOD) + (size_t)5 * 6144;
            pg8::EpiResidN E{p.out, (const float*)(ws + WS_XC), p.out, (float*)(ws + WS_XC), modl + 5 * 1024, (bf16_t*)(ws + WS_HN), (float*)(ws + WS_SS) + 2 * M, p.in[4] + 1024, modn + 1 * 1024};
            pg8::gemm_phase<pg8::EpiResidN, pg8::StaticOrder, true, true>((PG8_LAS unsigned char*)lds, g, S, E); }
        else { pg8::EpiResid E{p.out, (const float*)(ws + WS_XC), p.out, (float*)(ws + WS_XC), modl + 5 * 1024};
            pg8::gemm_phase<pg8::EpiResid, pg8::StaticOrder, true, true>((PG8_LAS unsigned char*)lds, g, S, E); } }
    PH_SYNC(base + 7);
}
__global__ void __launch_bounds__(512, 2) mega_fwd(Prm p) {
    extern __shared__ __attribute__((aligned(16))) unsigned char lds[];
    cg::grid_group grid = cg::this_grid();
    const int lo = p.ph_lo, hi = p.ph_hi;
    if (threadIdx.x < 2) ((volatile LAS unsigned*)((LAS unsigned char*)lds + LDS_XB))[threadIdx.x] = 0u;
    __syncthreads();
#ifdef EXTRA_SYNCS
    for (int es = 0; es < EXTRA_SYNCS; ++es) grid.sync();
#endif
    if (PH_IN(0)) PH_REP(0) { int tid = threadIdx.x; asm volatile("" : "+v"(tid)); prep_phase(p, lds, tid, gridDim.x); }
    if (PH_IN(0) && PH_IN(1)) grid.sync();
    const XcdBarrier xbar = xcd_barrier_post((unsigned*)(p.ws + WS_BARW), (volatile LAS unsigned*)((LAS unsigned char*)lds + LDS_XB));
    layer_phases<0>(p, grid, xbar, lds, lo, hi);
    layer_phases<1>(p, grid, xbar, lds, lo, hi);
    if (PH_IN(NPH - 1)) { int tid = threadIdx.x; asm volatile("" : "+v"(tid)); norm_phase(p, 1, 2, tid, gridDim.x); }
}

#ifndef MK_SPLIT
#define MK_SPLIT 0
#endif
extern "C" void kernel_launch(void* const* d_in, const int* in_sizes, int n_in, void* d_out, int out_size, void* d_ws, size_t ws_size, hipStream_t stream) {
    static int grid = 0;
    if (grid == 0) {
        int dev = 0, cus = 0, per_cu = 0;
        if (n_in != 29 || out_size != ML * D || ws_size < WS_END3) { fprintf(stderr, "kernel_launch: unexpected problem shape (n_in %d out %d ws %zu)\n", n_in, out_size, ws_size); grid = -1; return; }
        hipGetDevice(&dev); hipDeviceGetAttribute(&cus, hipDeviceAttributeMultiprocessorCount, dev);
        if (hipFuncSetAttribute((const void*)mega_fwd, hipFuncAttributeMaxDynamicSharedMemorySize, LDS_BYTES) != hipSuccess) { fprintf(stderr, "kernel_launch: hipFuncSetAttribute failed\n"); grid = -1; return; }
        if (hipOccupancyMaxActiveBlocksPerMultiprocessor(&per_cu, (const void*)mega_fwd, 512, LDS_BYTES) != hipSuccess || per_cu < 1) { fprintf(stderr, "kernel_launch: occupancy query says %d blocks per CU\n", per_cu); grid = -1; return; }
        grid = cus * 1;
        if (grid > 256) grid = 256;
        if (grid < 128) { fprintf(stderr, "kernel_launch: needs >= 128 CUs\n"); grid = -1; return; }
    }
    if (grid < 0) return;
    Prm prm{};
    for (int i = 0; i < 29; ++i) prm.in[i] = (const float*)d_in[i];
    prm.out = (float*)d_out; prm.ws = (unsigned char*)d_ws;
#if MK_SPLIT
    for (int ph = 0; ph < NPH; ++ph) { prm.ph_lo = ph; prm.ph_hi = ph + 1; void* args[] = {&prm};
        hipError_t e = hipLaunchCooperativeKernel((const void*)mega_fwd, dim3(grid), dim3(512), args, LDS_BYTES, stream);
        if (e != hipSuccess) { fprintf(stderr, "kernel_launch: launch failed: %s\n", hipGetErrorString(e)); break; } }
#else
    prm.ph_lo = 0; prm.ph_hi = NPH; void* args[] = {&prm};
    hipError_t e = hipLaunchCooperativeKernel((const void*)mega_fwd, dim3(grid), dim3(512), args, LDS_BYTES, stream);
    if (e != hipSuccess) fprintf(stderr, "kernel_launch: cooperative launch failed: %s (grid %d)\n", hipGetErrorString(e), grid);
#endif
}
```

```cpp
#include <hip/hip_runtime.h>
#include <hip/hip_cooperative_groups.h>
#include <cstdio>
#include <cstdint>
namespace cg = cooperative_groups;
namespace pg8 {
#define PG8_LAS __attribute__((address_space(3)))
typedef unsigned short bf16_t;
typedef short bf16x8 __attribute__((ext_vector_type(8)));
typedef float f32x4 __attribute__((ext_vector_type(4)));
typedef unsigned u32x4 __attribute__((ext_vector_type(4)));
constexpr int BM = 256, BK = 64, HALF = 128, HTB = HALF * BK * 2  , STAGE_BYTES = 8 * HTB, NXCD = 8, WGM = 8;

__host__ __device__ __forceinline__ int lds_byte(int r, int c) { const int st = (r >> 4) * 2 + (c >> 5), rr = r & 15, cc = c & 31, ob = rr * 64 + cc * 2; return st * 1024 + (ob ^ (((ob >> 9) & 1) << 5)); }
__host__ __device__ __forceinline__ void stage_rc(int b, int& R, int& C) { const int st = b / 1024, sb = b % 1024, swz = sb ^ (((sb >> 9) & 1) << 5); R = (st >> 1) * 16 + swz / 64; C = (st & 1) * 32 + (swz % 64) / 2; }
__host__ __device__ __forceinline__ int perm32(int rho) { const int n = rho >> 4, i = rho & 15; return 8 * (i >> 2) + 4 * n + (i & 3); }

struct Unit { int pm, pn, ord; };
struct Gemm { const bf16_t* A; const bf16_t* Bt; int M, N, K; };

struct StaticOrder {
    int nM, nN, nwg, G, c;
    __host__ __device__ void init(int M, int N, int G_, int c_) { nM = M / BM; nN = N / BM; nwg = nM * nN; G = G_; c = c_; }
    __host__ __device__ bool next(int i, Unit& u) const {
        const long L = (long)i * G + c; if (L >= nwg) return false;
        int wgid = (int)L; { const int q = nwg / NXCD, r = nwg % NXCD, xcd = wgid % NXCD, off = wgid / NXCD; wgid = (xcd < r ? xcd * (q + 1) : r * (q + 1) + (xcd - r) * q) + off; }
        const int nig = WGM * nN, gid = wgid / nig, fm = gid * WGM, gsz = (nM - fm) < WGM ? (nM - fm) : WGM;
        u.pm = fm + ((wgid % nig) % gsz); u.pn = (wgid % nig) / gsz; u.ord = i; return true;
    }
    __device__ __forceinline__ void a_ready(const Unit&) const {}
    __device__ __forceinline__ void done(const Unit&) const {}
};

typedef __bf16 bf16x2_t __attribute__((ext_vector_type(2)));
typedef float f32x2_t __attribute__((ext_vector_type(2)));
__device__ __forceinline__ unsigned cvt_pk_bf16(float lo, float hi) { const f32x2_t v = {lo, hi}; const bf16x2_t b = __builtin_convertvector(v, bf16x2_t); return __builtin_bit_cast(unsigned, b); }
template <int ACT  > struct EpiBf16 {
    static constexpr bool PERM = true, AFTER_DRAIN = false;
    bf16_t* O; int ldc;
    __device__ __forceinline__ void operator()(const f32x4 (&acc)[2][2][4][2], const Unit& u, int wr, int wc, int fr, int fq) const {
        const int row0 = u.pm * BM + wr * 64 + fr; const int col0 = u.pn * BM + wc * 32 + 8 * fq;
#pragma unroll
        for (int ai = 0; ai < 2; ++ai)
#pragma unroll
            for (int m = 0; m < 4; ++m) { bf16_t* rowp = O + (size_t)(row0 + ai * HALF + m * 16) * ldc + col0;
#pragma unroll
                for (int bj = 0; bj < 2; ++bj) { f32x4 v0 = acc[ai][bj][m][0], v1 = acc[ai][bj][m][1];
                    if (ACT == 1) {
#pragma unroll
                        for (int e = 0; e < 4; ++e) { float a = v0[e] > 0.f ? v0[e] : 0.f; v0[e] = a * a; float b = v1[e] > 0.f ? v1[e] : 0.f; v1[e] = b * b; } }
                    u32x4 w; w.x = cvt_pk_bf16(v0[0], v0[1]); w.y = cvt_pk_bf16(v0[2], v0[3]); w.z = cvt_pk_bf16(v1[0], v1[1]); w.w = cvt_pk_bf16(v1[2], v1[3]);
                    *(u32x4*)(rowp + bj * HALF) = w; } }
    }
};
struct EpiResid {
    static constexpr bool PERM = true, AFTER_DRAIN = false;
    const float* rin_lat; const float* rin_ctx; float* rout_lat; float* rout_ctx; const float* gate;
    __device__ __forceinline__ void operator()(const f32x4 (&acc)[2][2][4][2], const Unit& u, int wr, int wc, int fr, int fq) const {
        const bool lat = u.pm < 128; const int bb = lat ? (u.pm >> 5) : 4;
        const int rbase = (lat ? u.pm * 256 : (u.pm - 128) * 256) + wr * 64 + fr;
        const float* rin = lat ? rin_lat : rin_ctx; float* rout = lat ? rout_lat : rout_ctx;
        const int col0 = u.pn * BM + wc * 32 + 8 * fq;
        const float* gv = gate + bb * 6144 + col0;
        f32x4 g[2][2];
#pragma unroll
        for (int bj = 0; bj < 2; ++bj)
#pragma unroll
            for (int n = 0; n < 2; ++n) g[bj][n] = *(const f32x4*)(gv + bj * HALF + 4 * n);
#pragma unroll
        for (int ai = 0; ai < 2; ++ai)
#pragma unroll
            for (int m = 0; m < 4; ++m) { const size_t ro = (size_t)(rbase + ai * HALF + m * 16) * 1024 + col0;
#pragma unroll
                for (int bj = 0; bj < 2; ++bj) {
                    const f32x4 x0 = *(const f32x4*)(rin + ro + bj * HALF), x1 = *(const f32x4*)(rin + ro + bj * HALF + 4);
                    *(f32x4*)(rout + ro + bj * HALF) = x0 + g[bj][0] * acc[ai][bj][m][0];
                    *(f32x4*)(rout + ro + bj * HALF + 4) = x1 + g[bj][1] * acc[ai][bj][m][1]; } }
    }
};
struct EpiResidN {
    static constexpr bool PERM = true, AFTER_DRAIN = false;
    const float* rin_lat; const float* rin_ctx; float* rout_lat; float* rout_ctx; const float* gate;
    bf16_t* XB; float* SS; const float* gvec; const float* scn;
    __device__ __forceinline__ void operator()(const f32x4 (&acc)[2][2][4][2], const Unit& u, int wr, int wc, int fr, int fq) const {
        const bool lat = u.pm < 128; const int bb = lat ? (u.pm >> 5) : 4;
        const int rbase = (lat ? u.pm * 256 : (u.pm - 128) * 256) + wr * 64 + fr; const int grow = u.pm * 256 + wr * 64 + fr;
        const float* rin = lat ? rin_lat : rin_ctx; float* rout = lat ? rout_lat : rout_ctx;
        const int col0 = u.pn * BM + wc * 32 + 8 * fq;
        const float* gv = gate + bb * 6144 + col0;
        f32x4 g[2][2], gs[2][2];
#pragma unroll
        for (int bj = 0; bj < 2; ++bj)
#pragma unroll
            for (int n = 0; n < 2; ++n) { g[bj][n] = *(const f32x4*)(gv + bj * HALF + 4 * n);
                gs[bj][n] = *(const f32x4*)(gvec + col0 + bj * HALF + 4 * n) * (*(const f32x4*)(scn + bb * 6144 + col0 + bj * HALF + 4 * n) + 1.f); }
#pragma unroll
        for (int ai = 0; ai < 2; ++ai)
#pragma unroll
            for (int m = 0; m < 4; ++m) { const size_t ro = (size_t)(rbase + ai * HALF + m * 16) * 1024 + col0; bf16_t* xb = XB + (size_t)(grow + ai * HALF + m * 16) * 1024 + col0; float ssq = 0.f;
#pragma unroll
                for (int bj = 0; bj < 2; ++bj) {
                    const f32x4 x0 = *(const f32x4*)(rin + ro + bj * HALF), x1 = *(const f32x4*)(rin + ro + bj * HALF + 4);
                    const f32x4 o0 = x0 + g[bj][0] * acc[ai][bj][m][0], o1 = x1 + g[bj][1] * acc[ai][bj][m][1];
                    *(f32x4*)(rout + ro + bj * HALF) = o0; *(f32x4*)(rout + ro + bj * HALF + 4) = o1;
                    ssq += (o0[0] * o0[0] + o0[1] * o0[1]) + (o0[2] * o0[2] + o0[3] * o0[3]) + (o1[0] * o1[0] + o1[1] * o1[1]) + (o1[2] * o1[2] + o1[3] * o1[3]);
                    const f32x4 y0 = o0 * gs[bj][0], y1 = o1 * gs[bj][1];
                    u32x4 w; w.x = cvt_pk_bf16(y0[0], y0[1]); w.y = cvt_pk_bf16(y0[2], y0[3]); w.z = cvt_pk_bf16(y1[0], y1[1]); w.w = cvt_pk_bf16(y1[2], y1[3]);
                    *(u32x4*)(xb + bj * HALF) = w; }
                ssq += __shfl_xor(ssq, 16); ssq += __shfl_xor(ssq, 32);
                if (fq == 0) __hip_atomic_fetch_add(SS + grow + ai * HALF + m * 16, ssq, __ATOMIC_RELAXED, __HIP_MEMORY_SCOPE_AGENT); }
    }
};
template <int ACT  > struct EpiBf16RS {
    static constexpr bool PERM = true, AFTER_DRAIN = false;
    bf16_t* O; int ldc; const PG8_LAS float* tab;
    __device__ __forceinline__ void operator()(const f32x4 (&acc)[2][2][4][2], const Unit& u, int wr, int wc, int fr, int fq) const {
        const int row0 = u.pm * BM + wr * 64 + fr; const int col0 = u.pn * BM + wc * 32 + 8 * fq;
        const PG8_LAS float* tr = tab + u.ord * 512 + wr * 64 + fr; const PG8_LAS float* tb = tab + u.ord * 512 + 256 + wc * 32 + 8 * fq;
        f32x4 bv[2][2];
#pragma unroll
        for (int bj = 0; bj < 2; ++bj)
#pragma unroll
            for (int n = 0; n < 2; ++n) bv[bj][n] = *(const PG8_LAS f32x4*)(tb + bj * HALF + 4 * n);
#pragma unroll
        for (int ai = 0; ai < 2; ++ai)
#pragma unroll
            for (int m = 0; m < 4; ++m) { const int r = row0 + ai * HALF + m * 16; const float rinv = tr[ai * HALF + m * 16];
                bf16_t* rowp = O + (size_t)r * ldc + col0;
#pragma unroll
                for (int bj = 0; bj < 2; ++bj) { f32x4 v0 = acc[ai][bj][m][0] * rinv + bv[bj][0], v1 = acc[ai][bj][m][1] * rinv + bv[bj][1];
                    if (ACT == 1) {
#pragma unroll
                        for (int e = 0; e < 4; ++e) { float a = v0[e] > 0.f ? v0[e] : 0.f; v0[e] = a * a; float b = v1[e] > 0.f ? v1[e] : 0.f; v1[e] = b * b; } }
                    u32x4 w; w.x = cvt_pk_bf16(v0[0], v0[1]); w.y = cvt_pk_bf16(v0[2], v0[3]); w.z = cvt_pk_bf16(v1[0], v1[1]); w.w = cvt_pk_bf16(v1[2], v1[3]);
                    *(u32x4*)(rowp + bj * HALF) = w; } }
    }
};
template <class Epi, class Sched, bool ALIGN_EPI = false, bool SP2 = false>
__device__ __forceinline__ void gemm_phase(PG8_LAS unsigned char* lds, const Gemm g, const Sched& S, const Epi& E) {
    int tid_l = threadIdx.x; asm volatile("" : "+v"(tid_l));
    const int tid = tid_l, wid = __builtin_amdgcn_readfirstlane(tid >> 6), lane = tid & 63, wr = wid >> 2, wc = wid & 3, fr = lane & 15, fq = lane >> 4;
    const int K = g.K, nt = K / BK;
    unsigned voffA[2], voffB[2];
#pragma unroll
    for (int i = 0; i < 2; ++i) { int R, C; stage_rc(tid * 16 + i * 8192, R, C); const int Rb = Epi::PERM ? ((R & ~31) + perm32(R & 31)) : R;
        voffA[i] = (unsigned)(R * K + C) * 2u; voffB[i] = (unsigned)(Rb * K + C) * 2u; }
    const size_t kstep = (size_t)(BK * 2);
    const size_t hstep = (size_t)HALF * K * 2;
    const size_t tstep = 2 * hstep;
    const unsigned ldsw = (unsigned)wid * 1024u;
    const int aoff = lds_byte(wr * 64 + fr, fq * 8), boff = lds_byte(wc * 32 + fr, fq * 8);
#define PG8_SA(b, h) (((b) * 2 + (h)) * HTB)
#define PG8_SB(b, h) ((4 + (b) * 2 + (h)) * HTB)
#define PG8_STAGE(bufoff, gbase, voff) do { _Pragma("unroll") for (int _i = 0; _i < 2; ++_i) \
        __builtin_amdgcn_global_load_lds((const unsigned*)((const char*)(gbase) + (voff)[_i]), (PG8_LAS unsigned*)(lds + (bufoff) + ldsw + _i * 8192), 16, 0, 0); } while (0)
#define PG8_LDA(dst, b, h) do { _Pragma("unroll") for (int m = 0; m < 4; ++m) _Pragma("unroll") for (int k = 0; k < 2; ++k) dst[m][k] = *(const PG8_LAS bf16x8*)(lds + PG8_SA(b, h) + aoff + m * 2048 + k * 1024); } while (0)
#define PG8_LDB(dst, b, h) do { _Pragma("unroll") for (int n = 0; n < 2; ++n) _Pragma("unroll") for (int k = 0; k < 2; ++k) dst[n][k] = *(const PG8_LAS bf16x8*)(lds + PG8_SB(b, h) + boff + n * 2048 + k * 1024); } while (0)
#define PG8_MMA(ai, bj, At, Bt) do { __builtin_amdgcn_s_setprio(1); _Pragma("unroll") for (int m = 0; m < 4; ++m) _Pragma("unroll") for (int n = 0; n < 2; ++n) _Pragma("unroll") for (int k = 0; k < 2; ++k) \
        acc[ai][bj][m][n] = __builtin_amdgcn_mfma_f32_16x16x32_bf16(Bt[n][k], At[m][k], acc[ai][bj][m][n], 0, 0, 0); __builtin_amdgcn_s_setprio(0); } while (0)
#define PG8_WAIT_V(n) asm volatile("s_waitcnt vmcnt(" #n ")" ::: "memory")
#define PG8_WAIT_L(n) asm volatile("s_waitcnt lgkmcnt(" #n ")" ::: "memory")
#define PG8_BAR __builtin_amdgcn_s_barrier()
#define PG8_SCHED __builtin_amdgcn_sched_barrier(0)
    Unit cur, nxt; int ui = 0;
    if (!S.next(0, cur)) return;
    f32x4 acc[2][2][4][2];
#pragma unroll
    for (int a = 0; a < 2; ++a)
#pragma unroll
        for (int b = 0; b < 2; ++b)
#pragma unroll
            for (int m = 0; m < 4; ++m)
#pragma unroll
                for (int n = 0; n < 2; ++n) acc[a][b][m][n] = (f32x4){0.f, 0.f, 0.f, 0.f};
    bf16x8 At[4][2], B0[2][2], B1[2][2];
    const char* cA = (const char*)g.A + (size_t)cur.pm * tstep; const char* cB = (const char*)g.Bt + (size_t)cur.pn * tstep;
    S.a_ready(cur);
    if constexpr (SP2) {
        PG8_STAGE(PG8_SB(0, 0), cB, voffB); PG8_STAGE(PG8_SB(0, 1), cB + hstep, voffB); PG8_STAGE(PG8_SA(0, 0), cA, voffA); PG8_STAGE(PG8_SA(0, 1), cA + hstep, voffA);
        if (wr == 1) PG8_BAR;
        PG8_WAIT_V(2); PG8_BAR;
        PG8_STAGE(PG8_SB(1, 0), cB + kstep, voffB); PG8_STAGE(PG8_SA(1, 0), cA + kstep, voffA); PG8_STAGE(PG8_SB(1, 1), cB + hstep + kstep, voffB);
        PG8_WAIT_V(6); PG8_BAR;
    } else {
        PG8_STAGE(PG8_SB(0, 0), cB, voffB); PG8_STAGE(PG8_SA(0, 0), cA, voffA); PG8_STAGE(PG8_SB(0, 1), cB + hstep, voffB); PG8_STAGE(PG8_SA(0, 1), cA + hstep, voffA);
        if (wr == 1) PG8_BAR;
        PG8_WAIT_V(4); PG8_BAR;
        PG8_STAGE(PG8_SB(1, 0), cB + kstep, voffB); PG8_STAGE(PG8_SA(1, 0), cA + kstep, voffA); PG8_STAGE(PG8_SB(1, 1), cB + hstep + kstep, voffB);
        PG8_WAIT_V(6); PG8_BAR;
    }
    for (;;) {
        const bool has_next = S.next(ui + 1, nxt);
        const char* nA = has_next ? (const char*)g.A + (size_t)nxt.pm * tstep : cA; const char* nB = has_next ? (const char*)g.Bt + (size_t)nxt.pn * tstep : cB;
        for (int t = 0; t < nt; t += 2) {
            const bool last = (t == nt - 2);
            const char* a1 = cA + (size_t)(t + 1) * kstep;
            const char* a2 = last ? nA : cA + (size_t)(t + 2) * kstep; const char* b2 = last ? nB : cB + (size_t)(t + 2) * kstep;
            const char* a3 = a2 + kstep; const char* b3 = b2 + kstep;
            if (last && has_next) S.a_ready(nxt);
            if constexpr (SP2) {
            PG8_LDB(B0, 0, 0); PG8_LDB(B1, 0, 1); PG8_SCHED; PG8_LDA(At, 0, 0); PG8_STAGE(PG8_SA(1, 1), a1 + hstep, voffA);
            PG8_WAIT_V(8); PG8_WAIT_L(0); PG8_BAR; PG8_MMA(0, 0, At, B0); PG8_MMA(0, 1, At, B1); PG8_BAR; PG8_SCHED;
            PG8_LDA(At, 0, 1); PG8_STAGE(PG8_SB(0, 0), b2, voffB); PG8_STAGE(PG8_SB(0, 1), b2 + hstep, voffB); PG8_STAGE(PG8_SA(0, 0), a2, voffA);
            PG8_WAIT_V(8); PG8_WAIT_L(0); PG8_BAR; PG8_MMA(1, 0, At, B0); PG8_MMA(1, 1, At, B1); PG8_BAR; PG8_SCHED;
            PG8_LDB(B0, 1, 0); PG8_LDB(B1, 1, 1); PG8_SCHED; PG8_LDA(At, 1, 0); PG8_STAGE(PG8_SA(0, 1), a2 + hstep, voffA);
            PG8_WAIT_V(8); PG8_WAIT_L(0); PG8_BAR; PG8_MMA(0, 0, At, B0); PG8_MMA(0, 1, At, B1); PG8_BAR; PG8_SCHED;
            PG8_LDA(At, 1, 1); PG8_STAGE(PG8_SB(1, 0), b3, voffB); PG8_STAGE(PG8_SB(1, 1), b3 + hstep, voffB); PG8_STAGE(PG8_SA(1, 0), a3, voffA);
            PG8_WAIT_V(8); PG8_WAIT_L(0); PG8_BAR; PG8_MMA(1, 0, At, B0); PG8_MMA(1, 1, At, B1); PG8_BAR; PG8_SCHED;
            } else {
            PG8_LDB(B0, 0, 0); PG8_SCHED; PG8_LDA(At, 0, 0); PG8_STAGE(PG8_SA(1, 1), a1 + hstep, voffA);
            PG8_WAIT_L(8); PG8_BAR; PG8_WAIT_L(0); PG8_MMA(0, 0, At, B0); PG8_BAR; PG8_SCHED;
            PG8_LDB(B1, 0, 1); PG8_STAGE(PG8_SB(0, 0), b2, voffB);
            PG8_BAR; PG8_WAIT_L(0); PG8_MMA(0, 1, At, B1); PG8_BAR;
            PG8_LDA(At, 0, 1); PG8_STAGE(PG8_SA(0, 0), a2, voffA);
            PG8_BAR; PG8_WAIT_L(0); PG8_MMA(1, 0, At, B0); PG8_BAR; PG8_SCHED;
            PG8_STAGE(PG8_SB(0, 1), b2 + hstep, voffB);
            PG8_WAIT_V(6); PG8_BAR; PG8_MMA(1, 1, At, B1); PG8_BAR;
            PG8_LDB(B0, 1, 0); PG8_SCHED; PG8_LDA(At, 1, 0); PG8_STAGE(PG8_SA(0, 1), a2 + hstep, voffA);
            PG8_WAIT_L(8); PG8_BAR; PG8_WAIT_L(0); PG8_MMA(0, 0, At, B0); PG8_BAR; PG8_SCHED;
            PG8_LDB(B1, 1, 1); PG8_STAGE(PG8_SB(1, 0), b3, voffB);
            PG8_BAR; PG8_WAIT_L(0); PG8_MMA(0, 1, At, B1); PG8_BAR;
            PG8_LDA(At, 1, 1); PG8_STAGE(PG8_SA(1, 0), a3, voffA);
            PG8_BAR; PG8_WAIT_L(0); PG8_MMA(1, 0, At, B0); PG8_BAR; PG8_SCHED;
            PG8_STAGE(PG8_SB(1, 1), b3 + hstep, voffB);
            PG8_WAIT_V(6); PG8_BAR; PG8_MMA(1, 1, At, B1); PG8_BAR;
            }
        }
        if constexpr (ALIGN_EPI) { if (wr == 0) PG8_BAR; }
        if constexpr (!Epi::AFTER_DRAIN) { E(acc, cur, wr, wc, fr, fq); S.done(cur); }
        if (!has_next) break;
#pragma unroll
        for (int a = 0; a < 2; ++a)
#pragma unroll
            for (int b = 0; b < 2; ++b)
#pragma unroll
                for (int m = 0; m < 4; ++m)
#pragma unroll
                    for (int n = 0; n < 2; ++n) acc[a][b][m][n] = (f32x4){0.f, 0.f, 0.f, 0.f};
        cur = nxt; cA = nA; cB = nB; ++ui;
        if constexpr (ALIGN_EPI) { if (wr == 1) PG8_BAR; }
    }
    PG8_WAIT_V(0);
    if constexpr (!ALIGN_EPI) { if (wr == 0) PG8_BAR; }
    PG8_BAR;
    if constexpr (Epi::AFTER_DRAIN) { E.fused(acc, cur, wr, wc, fr, fq, lds, wid, lane); S.done(cur); }
#undef PG8_SA
#undef PG8_SB
#undef PG8_STAGE
#undef PG8_LDA
#undef PG8_LDB
#undef PG8_MMA
#undef PG8_WAIT_V
#undef PG8_WAIT_L
#undef PG8_BAR
#undef PG8_SCHED
}
}
typedef unsigned short bf16_t;
typedef short bf16x8 __attribute__((ext_vector_type(8)));
typedef float f32x4 __attribute__((ext_vector_type(4)));
constexpr int NB = 4, T = 8192, TC = 256, D = 1024, DFF = 4096;
constexpr int ML = NB * T, MC = NB * TC, M = ML + MC;
constexpr int LDU = 3584;
constexpr int NPLAIN = 2960, WIN_N = 3216;
constexpr int C_GQ = 896, C_GK = 1408, C_GV = 1920, C_GZ = 2432, C_GS = 2944, C_FZ = 2960;
constexpr size_t MiB = 1u << 20;
constexpr size_t WS_MOD = MiB / 2;
constexpr size_t WS_BC = 3 * MiB / 4;
constexpr size_t WS_WIN = 2 * MiB;
constexpr size_t WS_WOUT = 16 * MiB;
constexpr size_t WS_W1 = 20 * MiB;
constexpr size_t WS_W2 = 36 * MiB;
constexpr size_t WS_XC = 52 * MiB;
constexpr size_t WS_HN = 56 * MiB;
constexpr size_t WS_MID = 56 * MiB;
constexpr size_t WS_OR = 88 * MiB;
constexpr size_t WS_U = 122 * MiB;
constexpr size_t WS_OG = 353 * MiB;
constexpr size_t WS_Y = 419 * MiB;
constexpr size_t WS_H = 122 * MiB;
constexpr size_t WS_END = 485 * MiB;
constexpr size_t WS_BARW = 0;
constexpr int LDS_XB = 159680;
constexpr size_t WS_SBR = 485 * MiB;
constexpr size_t WS_SBG = 487 * MiB;
constexpr size_t WS_END2 = 495 * MiB;
constexpr size_t WS_SS = 495 * MiB;
constexpr size_t WS_ZEND = 496 * MiB;
constexpr size_t WS_BIAS = 496 * MiB;
constexpr size_t WS_END3 = 497 * MiB;
constexpr int LDS_BYTES = 159744;
constexpr int NPH = 18;

struct Prm { const float* in[29]; float* out; unsigned char* ws; int ph_lo, ph_hi; };

__device__ __forceinline__ bf16_t f2bf(float f) { const __bf16 b = (__bf16)f; return __builtin_bit_cast(unsigned short, b); }
__device__ __forceinline__ float bf2f(bf16_t h) { return __uint_as_float(((unsigned)h) << 16); }
__device__ __forceinline__ unsigned pk2(float lo, float hi) { return pg8::cvt_pk_bf16(lo, hi); }
__device__ __forceinline__ float bfe(const uint4& q, int e) { const unsigned w = (e < 2) ? q.x : (e < 4) ? q.y : (e < 6) ? q.z : q.w; return (e & 1) ? __uint_as_float(w & 0xffff0000u) : __uint_as_float(w << 16); }
__device__ __forceinline__ uint4 pack8(const float* v) { uint4 o; o.x = pk2(v[0], v[1]); o.y = pk2(v[2], v[3]); o.z = pk2(v[4], v[5]); o.w = pk2(v[6], v[7]); return o; }
__device__ __forceinline__ float wave_sum(float v) {
#pragma unroll
    for (int o = 1; o < 64; o <<= 1) v += __shfl_xor(v, o);
    return v;
}
__device__ __forceinline__ float fexp(float x) { return __expf(x); }
__device__ __forceinline__ float frcp(float x) { return __builtin_amdgcn_rcpf(x); }
__device__ __forceinline__ float sigmoidf_(float x) { return frcp(1.f + fexp(-x)); }
__device__ __forceinline__ float softplusf_(float z) { const float e = fexp(z); return z > 20.f ? z : (e < 1e-3f ? e * (1.f - 0.5f * e) : __logf(1.f + e)); }
__device__ __forceinline__ float ftanh(float x) { return 1.f - 2.f * frcp(1.f + fexp(2.f * x)); }
__device__ __forceinline__ float siluf_(float x) { return x * frcp(1.f + fexp(-x)); }
__device__ __forceinline__ float shx1(float v) { return __int_as_float(__builtin_amdgcn_ds_swizzle(__float_as_int(v), 0x041F)); }
__device__ __forceinline__ float shx2(float v) { return __int_as_float(__builtin_amdgcn_ds_swizzle(__float_as_int(v), 0x081F)); }
__device__ __forceinline__ float shx4(float v) { return __int_as_float(__builtin_amdgcn_ds_swizzle(__float_as_int(v), 0x101F)); }
typedef unsigned long long u64_t;
__device__ __forceinline__ void st_gran(u64_t* g, unsigned epoch, float v) { __hip_atomic_store(g, ((u64_t)epoch << 32) | (u64_t)__float_as_uint(v), __ATOMIC_RELAXED, __HIP_MEMORY_SCOPE_AGENT); }
template <int N>
__device__ __forceinline__ void recv_gran(const u64_t* g, unsigned epoch, float (&out)[N]) {
    unsigned spins = 0;
    for (;;) { bool ok = true;
#pragma unroll
        for (int k = 0; k < N; ++k) { const u64_t x = __hip_atomic_load(g + k * 512, __ATOMIC_RELAXED, __HIP_MEMORY_SCOPE_AGENT); out[k] = __uint_as_float((unsigned)x); ok = ok && ((unsigned)(x >> 32) == epoch); }
        if (ok || ++spins > (1u << 20)) break; __builtin_amdgcn_s_sleep(2); }
}
#define LDS_WAIT() asm volatile("s_waitcnt lgkmcnt(0)" ::: "memory")

__device__ __forceinline__ void mma_seg(f32x4& acc, const bf16_t* A, int lda, const bf16_t* Bt, int ldb, int tm, int tn, int ksteps, int fr, int fq) {
    const bf16_t* ap = A + (tm * 16 + fr) * lda + fq * 8; const bf16_t* bp = Bt + (tn * 16 + fr) * ldb + fq * 8;
    for (int ks = 0; ks < ksteps; ++ks) {
        const bf16x8 a = *(const bf16x8*)(ap + ks * 32); const bf16x8 b = *(const bf16x8*)(bp + ks * 32);
        acc = __builtin_amdgcn_mfma_f32_16x16x32_bf16(a, b, acc, 0, 0, 0);
    }
}
#define ZERO4 ((f32x4){0.f, 0.f, 0.f, 0.f})
__device__ __forceinline__ void st4bf(bf16_t* dst, float a, float b, float c, float d) { uint2 w; w.x = pk2(a, b); w.y = pk2(c, d); *(uint2*)dst = w; }
__device__ __forceinline__ void mma_seg_bs(f32x4& acc, const bf16_t* A, int lda, const bf16_t* Bt, int ldb, int tm, int tn, int ksteps, int fr, int fq, int g) {
    const bf16_t* ap = A + (tm * 16 + fr) * lda + fq * 8; const bf16_t* bp = Bt + (tn * 16 + fr) * ldb;
    for (int ks = 0; ks < ksteps; ++ks) {
        const bf16x8 a = *(const bf16x8*)(ap + ks * 32); const bf16x8 b = *(const bf16x8*)(bp + ((ks * 32 + fq * 8) ^ (g << 3)));
        acc = __builtin_amdgcn_mfma_f32_16x16x32_bf16(a, b, acc, 0, 0, 0);
    }
}

#define LAS __attribute__((address_space(3)))
#define XB_TMO      128
#define XB_XCNT(j)  (256  + 64 * (j))
#define XB_XSUB(j)  (1280 + 64 * (j))
#define XB_XGEN(j)  (2304 + 64 * (j))
#define XB_TOP      3328
#define XB_TOPGEN   3392
#define XCD_BAR_WORDS 3456
#define XB_SPIN_CAP (1u << 18)

__device__ __forceinline__ unsigned xb_ld(unsigned* p)              { return __hip_atomic_load(p, __ATOMIC_RELAXED, __HIP_MEMORY_SCOPE_AGENT); }
__device__ __forceinline__ unsigned xb_add(unsigned* p, unsigned v) { return __hip_atomic_fetch_add(p, v, __ATOMIC_RELAXED, __HIP_MEMORY_SCOPE_AGENT); }
__device__ __forceinline__ unsigned xb_xcc_id() { return (unsigned)__builtin_amdgcn_s_getreg((3 << 11) | 20) & 0xFu; }
#define XB_SPIN(cond, bar) do { unsigned _sp = 0; while (cond) { __builtin_amdgcn_s_sleep(1); \
    if ((++_sp & 255u) == 0u) { if (xb_ld(&(bar)[XB_TMO])) break; if (_sp > XB_SPIN_CAP) { atomicAdd(&(bar)[XB_TMO], 1u); break; } } } } while (0)

struct XcdBarrier {
    unsigned* bar; unsigned x;
    volatile LAS unsigned* st;
};

__device__ __forceinline__ XcdBarrier xcd_barrier_post(unsigned* bar, volatile LAS unsigned* st) {
    XcdBarrier b; b.bar = bar; b.x = xb_xcc_id(); b.st = st;
    if (threadIdx.x == 0) (void)xb_add(&bar[XB_XCNT(b.x)], 1u);
    return b;
}
__device__ __forceinline__ void xcd_barrier_complete(unsigned* bar, unsigned x, unsigned& nloc, unsigned& nx) {
    const unsigned G = gridDim.x * gridDim.y * gridDim.z;
    unsigned sum, cnt, mine, sp = 0u;
    for (;;) {
        sum = 0u; cnt = 0u; mine = 0u;
#pragma unroll
        for (unsigned j = 0; j < 16; ++j) { const unsigned c = xb_ld(&bar[XB_XCNT(j)]); sum += c; cnt += (c > 0u) ? 1u : 0u; mine = (j == x) ? c : mine; }
        if (sum == G) break;
        __builtin_amdgcn_s_sleep(1);
        if ((++sp & 255u) == 0u) { if (xb_ld(&bar[XB_TMO])) break; if (sp > XB_SPIN_CAP) { atomicAdd(&bar[XB_TMO], 1u); break; } }
    }
    nloc = mine > 0u ? mine : 1u; nx = cnt > 0u ? cnt : 1u;
}

__device__ __forceinline__ void xcd_barrier(const XcdBarrier& b) {
    asm volatile("s_waitcnt vmcnt(0)" ::: "memory");
    __syncthreads();
    if (threadIdx.x == 0) {
        unsigned* bar = b.bar;
        __builtin_amdgcn_s_waitcnt(0);
        unsigned nloc = b.st[0], nx = b.st[1];
        if (nloc == 0u) { xcd_barrier_complete(bar, b.x, nloc, nx); b.st[0] = nloc; b.st[1] = nx; }
        const unsigned old = xb_add(&bar[XB_XSUB(b.x)], 1u);
        const unsigned gen = old / nloc;
        if (old + 1u == (gen + 1u) * nloc) {
            __builtin_amdgcn_fence(__ATOMIC_RELEASE, "agent");
            asm volatile("s_waitcnt vmcnt(0)" ::: "memory");
            const unsigned og = xb_add(&bar[XB_TOP], 1u);
            const unsigned tg = og / nx;
            if (og + 1u == (tg + 1u) * nx) xb_add(&bar[XB_TOPGEN], 1u);
            else XB_SPIN(xb_ld(&bar[XB_TOPGEN]) == tg, bar);
            __builtin_amdgcn_fence(__ATOMIC_ACQUIRE, "agent");
            xb_add(&bar[XB_XGEN(b.x)], 1u);
            asm volatile("s_waitcnt vmcnt(0)" ::: "memory");
        } else {
            XB_SPIN(xb_ld(&bar[XB_XGEN(b.x)]) == gen, bar);
            __builtin_amdgcn_fence(__ATOMIC_ACQUIRE, "agent");
            asm volatile("s_waitcnt vmcnt(0)" ::: "memory");
        }
    }
    __syncthreads();
}

__device__ __forceinline__ void transpose_item(const float* W, int K, int N, int nlimit, bf16_t* WT, float* scr, int item, int lane) {
    const int nblk = (nlimit + 31) / 32, kb = item / nblk, nb = item % nblk, k0 = 64 * kb, n0 = 32 * nb;
    const int nn = n0 + (lane & 31); const bool ok = nn < nlimit;
#pragma unroll 8
    for (int i = 0; i < 32; ++i) { const int kk = 2 * i + (lane >> 5); scr[kk * 33 + (lane & 31)] = ok ? W[(size_t)(k0 + kk) * N + nn] : 0.f; }
    LDS_WAIT();
    const int c = lane & 7;
#pragma unroll
    for (int j = 0; j < 4; ++j) { const int n = (lane >> 3) + 8 * j; const float* s = scr + (8 * c) * 33 + n;
        uint4 o; o.x = pk2(s[0 * 33], s[1 * 33]); o.y = pk2(s[2 * 33], s[3 * 33]); o.z = pk2(s[4 * 33], s[5 * 33]); o.w = pk2(s[6 * 33], s[7 * 33]);
        if (n0 + n < nlimit) *(uint4*)(WT + (size_t)(n0 + n) * K + k0 + 8 * c) = o; }
    LDS_WAIT();
}

__device__ __forceinline__ void prep_phase(const Prm& p, unsigned char* lds, int tid, int G) {
    const int wave = tid >> 6, lane = tid & 63, bid = blockIdx.x;
    unsigned char* ws = p.ws;
    for (int it = bid; it < 448; it += G) {
        if (it < 192) {
            const int l = it / 96, j0 = (it % 96) * 64;
            float* SIL = (float*)lds; float* RED = SIL + 5 * 1024;
            for (int e = tid; e < 5120; e += 512) { const float cv = e < 4096 ? p.in[1][e] : p.in[3][e - 4096]; SIL[e] = cv / (1.f + expf(-cv)); }
            __syncthreads();
            float a0 = 0.f, a1 = 0.f, a2 = 0.f, a3 = 0.f, a4 = 0.f;
            const float* wm = p.in[6] + ((size_t)l * 1024 + wave * 128) * 6144 + j0 + lane;
#pragma unroll 8
            for (int k = 0; k < 128; ++k) { const float w = wm[(size_t)k * 6144]; const int kk = wave * 128 + k;
                a0 += SIL[kk] * w; a1 += SIL[1024 + kk] * w; a2 += SIL[2048 + kk] * w; a3 += SIL[3072 + kk] * w; a4 += SIL[4096 + kk] * w; }
            RED[(wave * 5 + 0) * 64 + lane] = a0; RED[(wave * 5 + 1) * 64 + lane] = a1; RED[(wave * 5 + 2) * 64 + lane] = a2; RED[(wave * 5 + 3) * 64 + lane] = a3; RED[(wave * 5 + 4) * 64 + lane] = a4;
            __syncthreads();
            if (tid < 320) { const int bb = tid >> 6, ln = tid & 63; float s = p.in[7][l * 6144 + j0 + ln];
                for (int w = 0; w < 8; ++w) s += RED[(w * 5 + bb) * 64 + ln];
                ((float*)(ws + WS_MOD))[(l * 5 + bb) * 6144 + j0 + ln] = s; }
            __syncthreads();
        } else {
            const int f = it - 192; const int l = f >> 7, g = (f >> 5) & 3, part = (f >> 4) & 1, kc = f & 15;
            float* PP = (float*)lds; float* WCH = PP + 64 * 65; float* WF = WCH + 64 * 65; float* TB = WF + 64 * 65;
            for (int e = tid; e < 4096; e += 512) { const int r = e >> 6, c = e & 63;
                WF[r * 65 + c] = p.in[25][((size_t)(l * 4 + g) * 64 + r) * 64 + c];
                WCH[r * 65 + c] = p.in[8][((size_t)l * 1024 + kc * 64 + r) * WIN_N + NPLAIN + g * 64 + c]; }
            if (tid < 64) { float s, c; sincospif((float)tid / 32.f, &s, &c); TB[tid] = 0.125f * (part ? -s : c); }
            __syncthreads();
            { const int c = tid >> 3, d0 = (tid & 7) * 8; float acc[8];
#pragma unroll
              for (int e = 0; e < 8; ++e) acc[e] = 0.f;
              for (int c2 = 0; c2 < 64; ++c2) { const float tb = TB[(c * c2) & 63];
#pragma unroll
                  for (int e = 0; e < 8; ++e) acc[e] += tb * WF[c2 * 65 + d0 + e]; }
#pragma unroll
              for (int e = 0; e < 8; ++e) PP[c * 65 + d0 + e] = acc[e]; }
            __syncthreads();
            { const int d = tid >> 3, ko = tid & 7; float acc[8];
#pragma unroll
              for (int e = 0; e < 8; ++e) acc[e] = 0.f;
              for (int c = 0; c < 64; ++c) { const float pv = PP[c * 65 + d];
#pragma unroll
                  for (int e = 0; e < 8; ++e) acc[e] += WCH[(ko * 8 + e) * 65 + c] * pv; }
              bf16_t* wt = (bf16_t*)(ws + WS_WIN) + ((size_t)l * LDU + C_FZ + part * 256 + g * 64 + d) * 1024 + kc * 64 + ko * 8;
              *(uint4*)wt = pack8(acc); }
            __syncthreads();
        }
    }
    { const int gt = bid * 512 + tid, NG = G * 512; const uint4 z = {0u, 0u, 0u, 0u};
      for (int e = gt; e < 2 * 112 * 128; e += NG) { const int l = e / (112 * 128), r = e % (112 * 128);
          *(uint4*)((bf16_t*)(ws + WS_WIN) + ((size_t)l * LDU + 3472) * 1024 + (size_t)r * 8) = z; } }
    if (bid == 0) { const uint4 z = {0u, 0u, 0u, 0u}; for (int e = tid; e < 16384 / 16; e += 512) *(uint4*)(ws + WS_BARW + (size_t)e * 16) = z; }
    { const int gt = bid * 512 + tid, NG = G * 512; const uint4 z = {0u, 0u, 0u, 0u};
      for (int e = gt; e < (int)((WS_ZEND - WS_SBR) / 16); e += NG) *(uint4*)(ws + WS_SBR + (size_t)e * 16) = z; }
    float* scr = (float*)(lds + wave * 8448);
    const int gw = bid * 8 + wave, NGW = G * 8;
    for (int it = gw; it < 2 * 6096; it += NGW) {
        const int l = it / 6096; int r = it % 6096;
        if (r < 1488) { transpose_item(p.in[8] + (size_t)l * 1024 * WIN_N, 1024, WIN_N, NPLAIN, (bf16_t*)(ws + WS_WIN) + (size_t)l * LDU * 1024, scr, r, lane); continue; } r -= 1488;
        if (r < 512) { transpose_item(p.in[9] + (size_t)l * 1024 * 1024, 1024, 1024, 1024, (bf16_t*)(ws + WS_WOUT) + (size_t)l * 1024 * 1024, scr, r, lane); continue; } r -= 512;
        if (r < 2048) { transpose_item(p.in[26] + (size_t)l * 1024 * 4096, 1024, 4096, 4096, (bf16_t*)(ws + WS_W1) + (size_t)l * 4096 * 1024, scr, r, lane); continue; } r -= 2048;
        transpose_item(p.in[27] + (size_t)l * 4096 * 1024, 4096, 1024, 1024, (bf16_t*)(ws + WS_W2) + (size_t)l * 1024 * 4096, scr, r, lane);
    }
    __syncthreads();
}

__device__ __forceinline__ void bias_items(const Prm& p, int tid, int G) {
    const int wave = tid >> 6, lane = tid & 63; const int gw = blockIdx.x * 8 + wave, NGW = G * 8;
    float* BI = (float*)(p.ws + WS_BIAS);
    for (int it = gw; it < 3584 + 4096 + 4096; it += NGW) {
        int s, n; if (it < 3584) { s = 0; n = it; } else if (it < 3584 + 4096) { s = 1; n = it - 3584; } else { s = 2; n = it - 3584 - 4096; }
        const int l = (s == 1) ? 0 : 1; const int slot = (s == 0) ? 0 : 3; const int N = (s == 0) ? 3584 : 4096;
        const bf16_t* wt = (s == 0) ? (const bf16_t*)(p.ws + WS_WIN) + ((size_t)LDU + n) * 1024 : (const bf16_t*)(p.ws + WS_W1) + ((size_t)l * 4096 + n) * 1024;
        float* out = BI + (s == 0 ? 0 : (s == 1 ? 5 * 3584 : 5 * 3584 + 5 * 4096));
        const float* modl = (const float*)(p.ws + WS_MOD) + (size_t)l * 5 * 6144 + slot * 1024;
        const uint4 w0 = *(const uint4*)(wt + lane * 16), w1 = *(const uint4*)(wt + lane * 16 + 8);
        float wv[16];
#pragma unroll
        for (int e = 0; e < 8; ++e) { wv[e] = bfe(w0, e); wv[8 + e] = bfe(w1, e); }
#pragma unroll
        for (int bb = 0; bb < 5; ++bb) { const float* sh = modl + bb * 6144 + lane * 16; float a = 0.f;
#pragma unroll
            for (int e4 = 0; e4 < 4; ++e4) { const f32x4 sv = *(const f32x4*)(sh + e4 * 4); a += (sv[0] * wv[e4 * 4] + sv[1] * wv[e4 * 4 + 1]) + (sv[2] * wv[e4 * 4 + 2] + sv[3] * wv[e4 * 4 + 3]); }
            a = wave_sum(a); if (lane == 0) out[(size_t)bb * N + n] = a; }
    }
}

__device__ __forceinline__ void norm_phase(const Prm& p, int l, int mode, int tid, int G) {
    const int wave = tid >> 6, lane = tid & 63; const int gw = blockIdx.x * 8 + wave, NGW = G * 8;
    const int nrows = (mode == 2 || (mode == 1 && l == 1)) ? ML : M;
    const float* gvec = mode == 2 ? p.in[28] : (mode == 1 ? p.in[5] + l * 1024 : p.in[4] + l * 1024);
    const float* modb = (const float*)(p.ws + WS_MOD) + (size_t)l * 5 * 6144;
    bf16_t* HN = (bf16_t*)(p.ws + WS_HN);
    const bool first = (l == 0 && mode == 0);
    for (int row = gw; row < nrows; row += NGW) {
        const bool lat = row < ML; const int bb = lat ? (row >> 13) : 4;
        const float* src = lat ? ((first ? p.in[0] : p.out) + (size_t)row * 1024) : ((first ? p.in[2] : (const float*)(p.ws + WS_XC)) + (size_t)(row - ML) * 1024);
        f32x4 v[4]; float ss = 0.f;
#pragma unroll
        for (int j = 0; j < 4; ++j) { v[j] = *(const f32x4*)(src + j * 256 + lane * 4); ss += (v[j][0] * v[j][0] + v[j][1] * v[j][1]) + (v[j][2] * v[j][2] + v[j][3] * v[j][3]); }
        const float rinv = rsqrtf(wave_sum(ss) * (1.f / 1024.f) + 1e-6f);
        if (mode == 2) {
#pragma unroll
            for (int j = 0; j < 4; ++j) { const f32x4 g = *(const f32x4*)(gvec + j * 256 + lane * 4); *(f32x4*)(p.out + (size_t)row * 1024 + j * 256 + lane * 4) = v[j] * rinv * g; }
        } else {
            const float* sh = modb + bb * 6144 + (mode ? 3 : 0) * 1024; const float* sc = modb + bb * 6144 + (mode ? 4 : 1) * 1024;
#pragma unroll
            for (int j = 0; j < 4; ++j) { const int c = j * 256 + lane * 4; const f32x4 g = *(const f32x4*)(gvec + c), s1 = *(const f32x4*)(sh + c), s2 = *(const f32x4*)(sc + c);
                const f32x4 y = (v[j] * rinv * g) * (s2 + 1.f) + s1;
                uint2 o; o.x = pk2(y[0], y[1]); o.y = pk2(y[2], y[3]); *(uint2*)(HN + (size_t)row * 1024 + c) = o; }
        }
    }
}

__device__ __forceinline__ void lerp8(const bf16_t* U, size_t row, int col, bool isctx, int t, const float* mu, float* out) {
    const bf16_t* bp = U + row * LDU + col;
    const uint4 own = *(const uint4*)bp; const uint4 z = {0u, 0u, 0u, 0u};
    uint4 n0, n1, n2, n3;
    if (isctx) { n0 = (t > 0) ? *(const uint4*)(bp - LDU) : z; n1 = (t < TC - 1) ? *(const uint4*)(bp + LDU) : z; n2 = n0; n3 = n1; }
    else { const int gx = t & 63, gy = t >> 6;
        n0 = (gx > 0) ? *(const uint4*)(bp - LDU) : z; n1 = (gx < 63) ? *(const uint4*)(bp + LDU) : z;
        n2 = (gy > 0) ? *(const uint4*)(bp - 64 * LDU) : z; n3 = (gy < 127) ? *(const uint4*)(bp + 64 * LDU) : z; }
#pragma unroll
    for (int e = 0; e < 8; ++e) { const float o = bfe(own, e); const float nb = (e & 3) == 0 ? bfe(n0, e) : (e & 3) == 1 ? bfe(n1, e) : (e & 3) == 2 ? bfe(n2, e) : bfe(n3, e);
        out[e] = o + mu[e] * (nb - o); }
}

__device__ __forceinline__ void lerp8_load(const bf16_t* U, size_t row, int col, bool isctx, int t, uint4 (&r)[5]) {
    const bf16_t* bp = U + row * LDU + col; const uint4 z = {0u, 0u, 0u, 0u};
    r[0] = *(const uint4*)bp;
    if (isctx) { r[1] = (t > 0) ? *(const uint4*)(bp - LDU) : z; r[2] = (t < TC - 1) ? *(const uint4*)(bp + LDU) : z; r[3] = r[1]; r[4] = r[2]; }
    else { const int gx = t & 63, gy = t >> 6;
        r[1] = (gx > 0) ? *(const uint4*)(bp - LDU) : z; r[2] = (gx < 63) ? *(const uint4*)(bp + LDU) : z;
        r[3] = (gy > 0) ? *(const uint4*)(bp - 64 * LDU) : z; r[4] = (gy < 127) ? *(const uint4*)(bp + 64 * LDU) : z; }
}
__device__ __forceinline__ void lerp8_apply(const uint4 (&r)[5], const float* mu, float* out) {
#pragma unroll
    for (int e = 0; e < 8; ++e) { const float o = bfe(r[0], e); const float nb = (e & 3) == 0 ? bfe(r[1], e) : (e & 3) == 1 ? bfe(r[2], e) : (e & 3) == 2 ? bfe(r[3], e) : bfe(r[4], e);
        out[e] = o + mu[e] * (nb - o); }
}
__device__ __forceinline__ void chunk_coords(int c, int b, int d, int n, bool& isctx, int& t0, size_t& rowbase) {
    isctx = c < 4; const int cc = isctx ? c : c - 4; const int nch = isctx ? 4 : 128;
    t0 = (d ? (nch - 1 - cc) : cc) * 64; rowbase = isctx ? (size_t)(ML + b * TC + t0) : (size_t)(b * T + t0); (void)n;
}
__device__ __forceinline__ void gdn_raw_load(const bf16_t* U, int b, int h, int d, int c, int tid, uint4 (&rv)[7]) {
    const bool isctx = c < 4; const int cc = isctx ? c : c - 4; const int nch = isctx ? 4 : 128; const int slen = isctx ? TC : T;
    const int t0 = (d ? (nch - 1 - cc) : cc) * 64; const size_t seqbase = isctx ? (size_t)(ML + b * TC) : (size_t)(b * T);
#pragma unroll
    for (int it = 0; it < 7; ++it) { const int pc = tid + it * 512; const int rr = pc / 48, pi = pc % 48; const int tt = t0 - 2 + rr;
        const int col = pi < 16 ? C_GQ + h * 128 + pi * 8 : pi < 32 ? C_GK + h * 128 + (pi - 16) * 8 : C_GV + h * 128 + (pi - 32) * 8;
        rv[it] = (uint4){0u, 0u, 0u, 0u}; if (pc < 68 * 48 && tt >= 0 && tt < slen) rv[it] = *(const uint4*)(U + (seqbase + tt) * LDU + col); }
}

template <int MODE>
__device__ __forceinline__ void trinv64(const bf16_t* LA, const float* LD, bf16_t* TA, int ldt, bf16_t* TT, bf16_t* WT, bf16_t* T1, bf16_t* T2, const float* s1, const float* s2, int tid, int wave, int fr, int fq) {
    if (wave == 0) { const int bi = (tid & 63) >> 4, cc = tid & 15; const float* A = LD + bi * 256; float dcol[16];
#pragma unroll
        for (int r = 0; r < 16; ++r) { float v = (r == cc) ? 1.f : 0.f;
#pragma unroll
            for (int j = 0; j < r; ++j) v -= A[r * 16 + j] * dcol[j];
            dcol[r] = v; }
#pragma unroll
        for (int r = 0; r < 16; ++r) { const int R = bi * 16 + r, Cc = bi * 16 + cc; const bf16_t bv = f2bf(dcol[r]); TA[R * ldt + Cc] = bv; TT[Cc * 72 + R] = bv;
            if (MODE == 1) T1[R * 72 + Cc] = f2bf(dcol[r] * s1[Cc]); }
    } else { for (int e = tid - 64; e < 4096; e += 448) { const int r = e >> 6, c = e & 63; if ((r >> 4) != (c >> 4)) TT[r * 72 + c] = 0; WT[r * 72 + c] = 0; } }
    __syncthreads();
    if (wave < 2) { const int tm = 2 * wave + 1, tn = 2 * wave, ko = 32 * wave, r0 = tm * 16 + fq * 4, c = tn * 16 + fr;
        f32x4 acc = ZERO4; mma_seg(acc, LA + ko, 72, TT + ko, 72, tm, tn, 1, fr, fq);
#pragma unroll
        for (int j = 0; j < 4; ++j) WT[c * 72 + r0 + j] = f2bf(acc[j]); }
    __syncthreads();
    if (wave < 2) { const int tm = 2 * wave + 1, tn = 2 * wave, ko = 32 * wave, r0 = tm * 16 + fq * 4, c = tn * 16 + fr;
        f32x4 acc = ZERO4; mma_seg(acc, TA + ko, ldt, WT + ko, 72, tm, tn, 1, fr, fq);
#pragma unroll
        for (int j = 0; j < 4; ++j) { const float v = -acc[j]; const bf16_t bv = f2bf(v); TA[(r0 + j) * ldt + c] = bv; TT[c * 72 + r0 + j] = bv;
            if (MODE == 1) T1[(r0 + j) * 72 + c] = f2bf(v * s1[c]); } }
    __syncthreads();
    if (wave < 4) { const int tm = 2 + (wave >> 1), tn = wave & 1, r0 = tm * 16 + fq * 4, c = tn * 16 + fr;
        f32x4 acc = ZERO4; mma_seg(acc, LA, 72, TT, 72, tm, tn, 1, fr, fq);
#pragma unroll
        for (int j = 0; j < 4; ++j) WT[c * 72 + r0 + j] = f2bf(acc[j]); }
    __syncthreads();
    if (wave < 4) { const int tm = 2 + (wave >> 1), tn = wave & 1, r0 = tm * 16 + fq * 4, c = tn * 16 + fr;
        f32x4 acc = ZERO4; mma_seg(acc, TA + 32, ldt, WT + 32, 72, tm, tn, 1, fr, fq);
#pragma unroll
        for (int j = 0; j < 4; ++j) { const float v = -acc[j]; TA[(r0 + j) * ldt + c] = f2bf(v);
            if (MODE == 1) T1[(r0 + j) * 72 + c] = f2bf(v * s1[c]); } }
    __syncthreads();
}
__device__ __forceinline__ void rwkv_scan(const Prm& p, int l, int sid, int kblk, int nblk, unsigned char* lds, int tid) {
    const int b = sid >> 3, h = (sid >> 1) & 3, d = sid & 1;
    const int wave = tid >> 6, lane = tid & 63, fr = lane & 15, fq = lane >> 4;
    bf16_t* TL = (bf16_t*)lds;
#define RTILE(i) (TL + (i) * 4608)
    bf16_t *S0bf = RTILE(0), *KT = RTILE(1), *BTl = RTILE(2), *KL = RTILE(3), *KTt = RTILE(4), *RT = RTILE(5), *VT = RTILE(6), *BS = RTILE(7),
           *LK = RTILE(9), *MB = RTILE(10), *MK = RTILE(11), *LA = RTILE(14), *TT = RTILE(1), *WT = RTILE(2),
           *TW = RTILE(12), *X1T = RTILE(1), *PT = RTILE(2);
    float* XW = (float*)RTILE(9); float* XAf = XW + 64 * 65; bf16_t* TWD = (bf16_t*)(XAf + 64 * 65); bf16_t* ADl = TWD + 64 * 40;
    unsigned char* cb = lds + 15 * 9216;
    bf16_t* WUPt = (bf16_t*)cb; bf16_t* AUPt = WUPt + 64 * 40; float* CV = (float*)(cb + 10240); float* GL = CV + 320; float* SEG = GL + 64; float* LD = SEG + 512;
#undef RTILE
    const bf16_t* U = (const bf16_t*)(p.ws + WS_U);
    bf16_t* ORp = (bf16_t*)(p.ws + WS_OR); float* BC = (float*)(p.ws + WS_BC);
    const int n = tid >> 3, jq = tid & 7, j0 = jq * 8; const int i = d ? 63 - n : n;
    for (int e = tid; e < 2048; e += 512) { const int q = e >> 6, j = e & 63;
        WUPt[j * 40 + q] = f2bf(p.in[12][((size_t)(l * 2 + d) * 32 + q) * 256 + h * 64 + j]);
        AUPt[j * 40 + q] = f2bf(p.in[14][((size_t)(l * 2 + d) * 32 + q) * 256 + h * 64 + j]); }
    if (tid < 64) { CV[tid] = p.in[11][(l * 2 + d) * 256 + h * 64 + tid]; CV[64 + tid] = p.in[13][(l * 2 + d) * 256 + h * 64 + tid];
        CV[128 + tid] = p.in[16][l * 256 + h * 64 + tid]; CV[192 + tid] = p.in[17][l * 256 + h * 64 + tid]; CV[256 + tid] = p.in[18][l * 256 + h * 64 + tid]; }
    f32x4 accS[2]; accS[0] = ZERO4; accS[1] = ZERO4;
    u64_t* SB = (u64_t*)(p.ws + WS_SBR) + (size_t)sid * 2 * 4096; const unsigned fbase = (unsigned)l * 132u;
    float r8[8], k8[8], v8[8], x8[8];
    { const int n0_ = tid >> 3, j00 = (tid & 7) * 8; bool ic; int t0_; size_t rb_; chunk_coords(kblk, b, d, n0_, ic, t0_, rb_);
      uint4 q0[5], q1[5], q2[5], q3[5];
      lerp8_load(U, rb_ + n0_, h * 64 + j00, ic, t0_ + n0_, q0); lerp8_load(U, rb_ + n0_, 256 + h * 64 + j00, ic, t0_ + n0_, q1);
      lerp8_load(U, rb_ + n0_, 512 + h * 64 + j00, ic, t0_ + n0_, q2); lerp8_load(U, rb_ + n0_, 768 + j00, ic, t0_ + n0_, q3);
      float m0[8], m1[8], m2[8], m3[8]; const float* mup = p.in[10] + l * 896 + j00;
#pragma unroll
      for (int e = 0; e < 8; ++e) { m0[e] = mup[h * 64 + e]; m1[e] = mup[256 + h * 64 + e]; m2[e] = mup[512 + h * 64 + e]; m3[e] = mup[768 + e]; }
      lerp8_apply(q0, m0, r8); lerp8_apply(q1, m1, k8); lerp8_apply(q2, m2, v8); lerp8_apply(q3, m3, x8); }
    __syncthreads();
    for (int c = kblk; c < 132; c += nblk) {
        int tid2 = threadIdx.x; asm volatile("" : "+v"(tid2)); const int tid = tid2;
        const int wave = tid2 >> 6, lane = tid2 & 63, fr = tid2 & 15, fq = (tid2 >> 4) & 3, n = tid2 >> 3, jq = tid2 & 7;
        const int j0 = jq * 8; const int i = d ? 63 - n : n;
        const bool isctx = c < 4; const int cc = isctx ? c : c - 4; const int nch = isctx ? 4 : 128;
        const int t0 = (d ? (nch - 1 - cc) : cc) * 64;
        const size_t rowbase = isctx ? (size_t)(ML + b * TC + t0) : (size_t)(b * T + t0);
        const int t = t0 + n; const size_t row = rowbase + n;
        if (jq < 4) {
#pragma unroll
            for (int e = 0; e < 8; ++e) TWD[i * 40 + j0 + e] = f2bf(ftanh(x8[e]));
        } else {
#pragma unroll
            for (int e = 0; e < 8; ++e) ADl[i * 40 + j0 - 32 + e] = f2bf(x8[e]);
        }
        __syncthreads();
#pragma unroll
        for (int q = 0; q < 2; ++q) { const int tile = wave + 8 * q, tm = tile >> 2, tn = tile & 3, r0 = tm * 16 + fq * 4, cc2 = tn * 16 + fr;
            f32x4 a1 = ZERO4, a2 = ZERO4; mma_seg(a1, TWD, 40, WUPt, 40, tm, tn, 1, fr, fq); mma_seg(a2, ADl, 40, AUPt, 40, tm, tn, 1, fr, fq);
#pragma unroll
            for (int j = 0; j < 4; ++j) { XW[(r0 + j) * 65 + cc2] = a1[j]; XAf[(r0 + j) * 65 + cc2] = a2[j]; } }
        __syncthreads();
        float a8[8], kd8[8], kk8[8]; float ss = 0.f, bcp = 0.f;
#pragma unroll
        for (int e = 0; e < 8; ++e) { const int j = j0 + e; const float xw = XW[i * 65 + j] + CV[j], xa = XAf[i * 65 + j] + CV[64 + j];
            const float a = sigmoidf_(xa); const float wl = -softplusf_(-xw) - 0.5f; const float lw = -fexp(wl);
            const float kd = k8[e] * (1.f + (a - 1.f) * CV[192 + j]); const float kkr = k8[e] * CV[128 + j];
            ss += kkr * kkr; bcp += r8[e] * kd * CV[256 + j]; a8[e] = a; kd8[e] = kd; kk8[e] = kkr; XW[i * 65 + j] = lw; }
        ss += shx1(ss); ss += shx2(ss); ss += shx4(ss);
        bcp += shx1(bcp); bcp += shx2(bcp); bcp += shx4(bcp);
        { const float rn = rsqrtf(ss + 1e-12f);
#pragma unroll
          for (int e = 0; e < 8; ++e) kk8[e] *= rn; }
        if (jq == 0) BC[((size_t)d * M + row) * 4 + h] = bcp;
        __syncthreads();
        { const int sg = tid >> 6, j = tid & 63; float s = 0.f;
#pragma unroll
          for (int ii = 0; ii < 8; ++ii) s += XW[(sg * 8 + ii) * 65 + j];
          SEG[sg * 64 + j] = s;
          __syncthreads();
          float pre = 0.f; for (int s2 = 0; s2 < sg; ++s2) pre += SEG[s2 * 64 + j];
#pragma unroll
          for (int ii = 0; ii < 8; ++ii) { pre += XW[(sg * 8 + ii) * 65 + j]; XW[(sg * 8 + ii) * 65 + j] = pre; } }
        __syncthreads();
        { float o_kt[8], o_bt[8], o_kl[8], o_rt[8];
#pragma unroll
          for (int e = 0; e < 8; ++e) { const int j = j0 + e; const float lwi = XW[i * 65 + j], lwm = i > 0 ? XW[(i - 1) * 65 + j] : 0.f, lwl = XW[63 * 65 + j];
              const float em = fexp(lwm), ei = fexp(lwi), eni = fexp(-lwi), el = fexp(lwl - lwi); const float b_ = kk8[e] * a8[e];
              o_kt[e] = kk8[e] * em; o_bt[e] = b_ * eni; o_kl[e] = kd8[e] * eni; o_rt[e] = r8[e] * ei;
              KTt[j * 72 + i] = f2bf(o_kt[e]); BS[j * 136 + i] = f2bf(b_ * el); BS[j * 136 + 64 + i] = f2bf(kd8[e] * el); VT[j * 72 + i] = f2bf(v8[e]);
              if (i == 63) GL[j] = ei; }
          *(uint4*)(KT + i * 72 + j0) = pack8(o_kt); *(uint4*)(BTl + i * 72 + j0) = pack8(o_bt); *(uint4*)(KL + i * 72 + j0) = pack8(o_kl); *(uint4*)(RT + i * 72 + j0) = pack8(o_rt); }
        __syncthreads();
        const int cn = c + nblk; const bool have_next = cn < 132;
        uint4 pq0[5], pq1[5], pq2[5], pq3[5];
        if (have_next) { bool ic; int t0n; size_t rbn; chunk_coords(cn, b, d, n, ic, t0n, rbn);
            lerp8_load(U, rbn + n, h * 64 + j0, ic, t0n + n, pq0); lerp8_load(U, rbn + n, 256 + h * 64 + j0, ic, t0n + n, pq1);
            lerp8_load(U, rbn + n, 512 + h * 64 + j0, ic, t0n + n, pq2); lerp8_load(U, rbn + n, 768 + j0, ic, t0n + n, pq3); }
        { const uint4 z4 = {0u, 0u, 0u, 0u}; *(uint4*)(TW + (tid >> 3) * 136 + (tid & 7) * 8) = z4; }
#pragma unroll
        for (int q = 0; q < 2; ++q) { const int tile = wave + 8 * q, tm = tile >> 2, tn = tile & 3, r0 = tm * 16 + fq * 4, cx = tn * 16 + fr;
            f32x4 a1 = ZERO4, a2 = ZERO4, a3 = ZERO4, a4 = ZERO4;
            { const int ao = (tm * 16 + fr) * 72 + fq * 8, bo = (tn * 16 + fr) * 72 + fq * 8;
#pragma unroll
              for (int ks = 0; ks < 2; ++ks) { const bf16x8 fk = *(const bf16x8*)(KT + ao + ks * 32), fr_ = *(const bf16x8*)(RT + ao + ks * 32), fb = *(const bf16x8*)(BTl + bo + ks * 32), fl = *(const bf16x8*)(KL + bo + ks * 32);
                  a1 = __builtin_amdgcn_mfma_f32_16x16x32_bf16(fk, fb, a1, 0, 0, 0); a2 = __builtin_amdgcn_mfma_f32_16x16x32_bf16(fk, fl, a2, 0, 0, 0);
                  a3 = __builtin_amdgcn_mfma_f32_16x16x32_bf16(fr_, fb, a3, 0, 0, 0); a4 = __builtin_amdgcn_mfma_f32_16x16x32_bf16(fr_, fl, a4, 0, 0, 0); } }
#pragma unroll
            for (int j = 0; j < 4; ++j) { const int r = r0 + j; const float x0 = (cx < r) ? a1[j] : 0.f;
                LA[r * 72 + cx] = f2bf(x0); if (tm == tn) LD[tm * 256 + (r & 15) * 16 + (cx & 15)] = x0;
                LK[r * 72 + cx] = f2bf(cx < r ? a2[j] : 0.f); MB[r * 72 + cx] = f2bf(cx <= r ? a3[j] : 0.f); MK[r * 72 + cx] = f2bf(cx <= r ? a4[j] : 0.f); } }
        __syncthreads();
        trinv64<0>(LA, LD, TW, 136, TT, WT, nullptr, nullptr, nullptr, nullptr, tid, wave, fr, fq);
        f32x4 accO[2];
#pragma unroll
        for (int q = 0; q < 2; ++q) { const int tile = wave + 8 * q, tm = tile >> 2, tn = tile & 3, r0 = tm * 16 + fq * 4, cx = tn * 16 + fr;
            f32x4 a1 = ZERO4, a2 = ZERO4; mma_seg(a1, TW, 136, KTt, 72, tm, tn, 2, fr, fq); mma_seg(a2, LK, 72, VT, 72, tm, tn, 2, fr, fq);
#pragma unroll
            for (int j = 0; j < 4; ++j) TW[(r0 + j) * 136 + 64 + cx] = f2bf(a1[j]);
            st4bf(X1T + cx * 72 + r0, a2[0], a2[1], a2[2], a2[3]);
            accO[q] = ZERO4; mma_seg(accO[q], MK, 72, VT, 72, tm, tn, 2, fr, fq); }
        if (have_next) { float m0[8], m1[8], m2[8], m3[8]; const float* mup = p.in[10] + l * 896 + j0;
#pragma unroll
            for (int e = 0; e < 8; ++e) { m0[e] = mup[h * 64 + e]; m1[e] = mup[256 + h * 64 + e]; m2[e] = mup[512 + h * 64 + e]; m3[e] = mup[768 + e]; }
            lerp8_apply(pq0, m0, r8); lerp8_apply(pq1, m1, k8); lerp8_apply(pq2, m2, v8); lerp8_apply(pq3, m3, x8); }
        if (c > 0) { float sv[8]; recv_gran<8>(SB + (c & 1) * 4096 + tid, fbase + (unsigned)c, sv);
#pragma unroll
            for (int q = 0; q < 2; ++q)
#pragma unroll
                for (int j = 0; j < 4; ++j) accS[q][j] = sv[q * 4 + j];
        } else { accS[0] = ZERO4; accS[1] = ZERO4; }
#pragma unroll
        for (int q = 0; q < 2; ++q) { const int tile = wave + 8 * q, tm = tile >> 2, tn = tile & 3;
#pragma unroll
            for (int j = 0; j < 4; ++j) S0bf[(tm * 16 + fq * 4 + j) * 72 + tn * 16 + fr] = f2bf(accS[q][j]); }
        __syncthreads();
#pragma unroll
        for (int q = 0; q < 2; ++q) { const int tile = wave + 8 * q, tm = tile >> 2, tn = tile & 3, r0 = tm * 16 + fq * 4, cx = tn * 16 + fr;
            f32x4 a1 = ZERO4; mma_seg(a1, TW, 136, X1T, 72, tm, tn, 2, fr, fq); mma_seg(a1, TW + 64, 136, S0bf, 72, tm, tn, 2, fr, fq);
            st4bf(PT + cx * 72 + r0, -a1[0], -a1[1], -a1[2], -a1[3]); }
        __syncthreads();
        { u64_t* sbn = SB + ((c + 1) & 1) * 4096; const unsigned ep = fbase + (unsigned)c + 1u;
#pragma unroll
          for (int q = 0; q < 2; ++q) { const int tile = wave + 8 * q, tm = tile >> 2, tn = tile & 3, cx = tn * 16 + fr;
              const float g = GL[cx]; accS[q] = accS[q] * g;
              mma_seg(accS[q], PT, 72, BS, 136, tm, tn, 2, fr, fq); mma_seg(accS[q], VT, 72, BS + 64, 136, tm, tn, 2, fr, fq);
#pragma unroll
              for (int j = 0; j < 4; ++j) st_gran(sbn + (q * 4 + j) * 512 + tid, ep, accS[q][j]); } }
#pragma unroll
        for (int q = 0; q < 2; ++q) { const int tile = wave + 8 * q, tm = tile >> 2, tn = tile & 3, r0 = tm * 16 + fq * 4, cx = tn * 16 + fr;
            mma_seg(accO[q], RT, 72, S0bf, 72, tm, tn, 2, fr, fq); mma_seg(accO[q], MB, 72, PT, 72, tm, tn, 2, fr, fq);
#pragma unroll
            for (int j = 0; j < 4; ++j) { const int tt = r0 + j; const int nn = d ? 63 - tt : tt;
                ORp[((size_t)d * M + rowbase + nn) * 256 + h * 64 + cx] = f2bf(accO[q][j]); } }
        __syncthreads();
    }
}

__device__ __forceinline__ void gdn_scan(const Prm& p, int l, int sid, int kblk, int nblk, unsigned char* lds, int tid) {
    const int b = sid >> 3, h = (sid >> 1) & 3, d = sid & 1;
    bf16_t* STbf = (bf16_t*)lds; bf16_t* Qn = (bf16_t*)(lds + 17408); bf16_t* KNt = (bf16_t*)(lds + 34816); bf16_t* VT = (bf16_t*)(lds + 53248); bf16_t* QKd = (bf16_t*)(lds + 71680);
    bf16_t* XP = (bf16_t*)(lds + 80896);
    bf16_t *LA = XP, *TT = XP + 4608, *WT = XP + 2 * 4608, *TA = XP + 3 * 4608, *T1 = XP + 4 * 4608;
    bf16_t *VNt = LA, *VNs = TT, *RAW = QKd;
    bf16_t* KN = (bf16_t*)(lds + 126976); bf16_t* Wm = KN;
    float* GLs = (float*)(lds + 144384); float* GC = GLs + 64; float* BETA = GC + 64; float* SC1 = BETA + 64; float* CW = SC1 + 64; float* LD = CW + 1920;
    const bf16_t* U = (const bf16_t*)(p.ws + WS_U); bf16_t* OGp = (bf16_t*)(p.ws + WS_OG);
    for (int e = tid; e < 1920; e += 512) { const int tap = e / 384, cc = e % 384;
        const int ch = cc < 128 ? h * 128 + cc : cc < 256 ? 512 + h * 128 + (cc - 128) : 1024 + h * 128 + (cc - 256);
        CW[e] = p.in[21][((size_t)l * 5 + tap) * 1536 + ch]; }
    const float a_exp = fexp(p.in[22][(l * 2 + d) * 4 + h]); const float dtb = p.in[23][(l * 2 + d) * 4 + h];
    f32x4 accS[8];
#pragma unroll
    for (int q = 0; q < 8; ++q) accS[q] = ZERO4;
    u64_t* SB = (u64_t*)(p.ws + WS_SBG) + (size_t)sid * 2 * 16384; const unsigned fbase = (unsigned)l * 132u;
    uint4 rv[7]; gdn_raw_load(U, b, h, d, kblk, tid, rv);
    __syncthreads();
    for (int c = kblk; c < 132; c += nblk) {
        int tid2 = threadIdx.x; asm volatile("" : "+v"(tid2)); const int tid = tid2;
        const int wave = tid2 >> 6, lane = tid2 & 63, fr = tid2 & 15, fq = (tid2 >> 4) & 3, n = tid2 >> 3, jq = tid2 & 7;
        const int i = d ? 63 - n : n;
        const bool isctx = c < 4; const int cc = isctx ? c : c - 4; const int nch = isctx ? 4 : 128; const int slen = isctx ? TC : T;
        const int t0 = (d ? (nch - 1 - cc) : cc) * 64;
        const size_t seqbase = isctx ? (size_t)(ML + b * TC) : (size_t)(b * T);
        const size_t rowbase = seqbase + t0;
#pragma unroll
        for (int it = 0; it < 7; ++it) { const int pc = tid + it * 512; const int rr = pc / 48, pi = pc % 48; if (pc < 68 * 48) *(uint4*)(RAW + rr * 392 + pi * 8) = rv[it]; }
        __syncthreads();
        { float qv[16];
          const bf16_t* up = U + (rowbase + n) * LDU + C_GS; const float beta_n = sigmoidf_(bf2f(up[d * 4 + h]));
#pragma unroll
          for (int e = 0; e < 16; ++e) qv[e] = 0.f;
#pragma unroll
          for (int tap = 0; tap < 5; ++tap) { const uint4 r0 = *(const uint4*)(RAW + (n + tap) * 392 + jq * 16), r1 = *(const uint4*)(RAW + (n + tap) * 392 + jq * 16 + 8);
              const float* cw = CW + tap * 384 + jq * 16;
#pragma unroll
              for (int e = 0; e < 8; ++e) { qv[e] += cw[e] * bfe(r0, e); qv[8 + e] += cw[8 + e] * bfe(r1, e); } }
          float sq = 0.f;
#pragma unroll
          for (int e = 0; e < 16; ++e) { const float a = siluf_(qv[e]); qv[e] = a; sq += a * a; }
          sq += shx1(sq); sq += shx2(sq); sq += shx4(sq);
          { const float rq = rsqrtf(sq + 1e-6f) * 0.08838834764831845f;
#pragma unroll
            for (int e = 0; e < 16; ++e) qv[e] *= rq; }
          *(uint4*)(Qn + i * 136 + jq * 16) = pack8(qv); *(uint4*)(Qn + i * 136 + jq * 16 + 8) = pack8(qv + 8);
          __builtin_amdgcn_sched_barrier(0);
#pragma unroll
          for (int e = 0; e < 16; ++e) qv[e] = 0.f;
#pragma unroll
          for (int tap = 0; tap < 5; ++tap) { const uint4 r0 = *(const uint4*)(RAW + (n + tap) * 392 + 128 + jq * 16), r1 = *(const uint4*)(RAW + (n + tap) * 392 + 128 + jq * 16 + 8);
              const float* cw = CW + tap * 384 + 128 + jq * 16;
#pragma unroll
              for (int e = 0; e < 8; ++e) { qv[e] += cw[e] * bfe(r0, e); qv[8 + e] += cw[8 + e] * bfe(r1, e); } }
          float sk = 0.f;
#pragma unroll
          for (int e = 0; e < 16; ++e) { const float a = siluf_(qv[e]); qv[e] = a; sk += a * a; }
          sk += shx1(sk); sk += shx2(sk); sk += shx4(sk);
          { const float rk = rsqrtf(sk + 1e-6f);
#pragma unroll
            for (int e = 0; e < 16; ++e) { qv[e] *= rk; KNt[(jq * 16 + e) * 72 + (i ^ (jq << 3))] = f2bf(qv[e]); } }
          *(uint4*)(KN + i * 136 + jq * 16) = pack8(qv); *(uint4*)(KN + i * 136 + jq * 16 + 8) = pack8(qv + 8);
          __builtin_amdgcn_sched_barrier(0);
#pragma unroll
          for (int e = 0; e < 16; ++e) qv[e] = 0.f;
#pragma unroll
          for (int tap = 0; tap < 5; ++tap) { const uint4 r0 = *(const uint4*)(RAW + (n + tap) * 392 + 256 + jq * 16), r1 = *(const uint4*)(RAW + (n + tap) * 392 + 256 + jq * 16 + 8);
              const float* cw = CW + tap * 384 + 256 + jq * 16;
#pragma unroll
              for (int e = 0; e < 8; ++e) { qv[e] += cw[e] * bfe(r0, e); qv[8 + e] += cw[8 + e] * bfe(r1, e); } }
#pragma unroll
          for (int e = 0; e < 16; ++e) VT[(jq * 16 + e) * 72 + (i ^ (jq << 3))] = f2bf(siluf_(qv[e]) * beta_n);
          if (jq == 0) { const float sa = bf2f(up[8 + d * 4 + h]); BETA[i] = beta_n; GLs[i] = -a_exp * softplusf_(sa + dtb); } }
        __syncthreads();
        if (wave == 0) { float x = GLs[lane];
#pragma unroll
            for (int o = 1; o < 64; o <<= 1) { const float y = __int_as_float(__builtin_amdgcn_ds_bpermute((lane - o) << 2, __float_as_int(x))); if (lane >= o) x += y; }
            GC[lane] = x; SC1[lane] = BETA[lane] * fexp(x); }
        __syncthreads();
        if (c + nblk < 132) gdn_raw_load(U, b, h, d, c + nblk, tid, rv);
        { const uint4 z4 = {0u, 0u, 0u, 0u}; *(uint4*)(TA + (tid >> 3) * 72 + (tid & 7) * 8) = z4; *(uint4*)(T1 + (tid >> 3) * 72 + (tid & 7) * 8) = z4; }
#pragma unroll
        for (int q = 0; q < 2; ++q) { const int tix = wave + 8 * q, tm = tix >> 2, tn = tix & 3, r0 = tm * 16 + fq * 4, cx = tn * 16 + fr;
            f32x4 a1 = ZERO4, a2 = ZERO4;
            const bf16_t* bp = KN + (tn * 16 + fr) * 136 + fq * 8; const bf16_t* ap1 = KN + (tm * 16 + fr) * 136 + fq * 8; const bf16_t* ap2 = Qn + (tm * 16 + fr) * 136 + fq * 8;
#pragma unroll
            for (int ks = 0; ks < 4; ++ks) { const bf16x8 bfr = *(const bf16x8*)(bp + ks * 32);
                a1 = __builtin_amdgcn_mfma_f32_16x16x32_bf16(*(const bf16x8*)(ap1 + ks * 32), bfr, a1, 0, 0, 0);
                a2 = __builtin_amdgcn_mfma_f32_16x16x32_bf16(*(const bf16x8*)(ap2 + ks * 32), bfr, a2, 0, 0, 0); }
#pragma unroll
            for (int j = 0; j < 4; ++j) { const int r = r0 + j; const float dec = fexp(GC[r] - GC[cx]); const float x0 = (cx < r) ? a1[j] * BETA[r] * dec : 0.f;
                LA[r * 72 + cx] = f2bf(x0); if (tm == tn) LD[tm * 256 + (r & 15) * 16 + (cx & 15)] = x0;
                QKd[r * 72 + cx] = f2bf((cx <= r) ? a2[j] * dec : 0.f); } }
        __syncthreads();
        trinv64<1>(LA, LD, TA, 72, TT, WT, T1, nullptr, SC1, nullptr, tid, wave, fr, fq);
        { const bf16_t* bp = KNt + (wave * 16 + fr) * 72;
          const bf16x8 b0 = *(const bf16x8*)(bp + ((fq * 8) ^ (wave << 3))), b1 = *(const bf16x8*)(bp + ((32 + fq * 8) ^ (wave << 3)));
#pragma unroll
          for (int q = 0; q < 4; ++q) { const bf16_t* ap = T1 + (q * 16 + fr) * 72 + fq * 8; f32x4 a1 = ZERO4;
              a1 = __builtin_amdgcn_mfma_f32_16x16x32_bf16(*(const bf16x8*)ap, b0, a1, 0, 0, 0); a1 = __builtin_amdgcn_mfma_f32_16x16x32_bf16(*(const bf16x8*)(ap + 32), b1, a1, 0, 0, 0);
#pragma unroll
              for (int j = 0; j < 4; ++j) Wm[(q * 16 + fq * 4 + j) * 136 + wave * 16 + fr] = f2bf(-a1[j]); } }
        const float gl63 = GC[63]; const float eg = fexp(gl63);
        u64_t* sbn = SB + ((c + 1) & 1) * 16384; const unsigned ep = fbase + (unsigned)c + 1u;
#pragma unroll
        for (int vh = 0; vh < 2; ++vh) {
            if (c > 0) { float sv[16]; recv_gran<16>(SB + (c & 1) * 16384 + (vh * 16) * 512 + tid, fbase + (unsigned)c, sv);
#pragma unroll
                for (int q = 0; q < 4; ++q)
#pragma unroll
                    for (int j = 0; j < 4; ++j) accS[vh * 4 + q][j] = sv[q * 4 + j];
            } else {
#pragma unroll
                for (int q = 0; q < 4; ++q) accS[vh * 4 + q] = ZERO4; }
#pragma unroll
            for (int q = 0; q < 4; ++q) { const int tile = wave + 8 * q, tm = tile >> 3, tn = tile & 7;
#pragma unroll
                for (int j = 0; j < 4; ++j) STbf[(tm * 16 + fq * 4 + j) * 136 + tn * 16 + fr] = f2bf(accS[vh * 4 + q][j]); }
            __syncthreads();
#pragma unroll
            for (int q2 = 0; q2 < 2; ++q2) { const int tile = wave + 8 * q2, tm = tile >> 2, tn = tile & 3, r0 = tm * 16 + fq * 4, cx = tn * 16 + fr;
                f32x4 au = ZERO4; mma_seg_bs(au, TA, 72, VT + (vh * 64) * 72, 72, tm, tn, 2, fr, fq, (vh * 4 + tn) & 7);
                mma_seg(au, Wm, 136, STbf, 136, tm, tn, 4, fr, fq);
                st4bf(VNt + cx * 72 + r0, au[0], au[1], au[2], au[3]);
                st4bf(VNs + cx * 72 + r0, au[0] * fexp(gl63 - GC[r0]), au[1] * fexp(gl63 - GC[r0 + 1]), au[2] * fexp(gl63 - GC[r0 + 2]), au[3] * fexp(gl63 - GC[r0 + 3])); }
            __syncthreads();
            { const bf16_t* bp = KNt + (wave * 16 + fr) * 72;
              const bf16x8 b0 = *(const bf16x8*)(bp + ((fq * 8) ^ (wave << 3))), b1 = *(const bf16x8*)(bp + ((32 + fq * 8) ^ (wave << 3)));
#pragma unroll
              for (int q = 0; q < 4; ++q) { const bf16_t* ap = VNs + (q * 16 + fr) * 72 + fq * 8; f32x4 a1 = accS[vh * 4 + q] * eg;
                  a1 = __builtin_amdgcn_mfma_f32_16x16x32_bf16(*(const bf16x8*)ap, b0, a1, 0, 0, 0); a1 = __builtin_amdgcn_mfma_f32_16x16x32_bf16(*(const bf16x8*)(ap + 32), b1, a1, 0, 0, 0);
                  accS[vh * 4 + q] = a1;
#pragma unroll
                  for (int j = 0; j < 4; ++j) st_gran(sbn + ((vh * 4 + q) * 4 + j) * 512 + tid, ep, a1[j]); } }
#pragma unroll
            for (int q2 = 0; q2 < 2; ++q2) { const int tile = wave + 8 * q2, tm = tile >> 2, tn = tile & 3, r0 = tm * 16 + fq * 4, cx = tn * 16 + fr;
                f32x4 a1 = ZERO4, a2 = ZERO4; mma_seg(a1, Qn, 136, STbf, 136, tm, tn, 4, fr, fq); mma_seg(a2, QKd, 72, VNt, 72, tm, tn, 2, fr, fq);
#pragma unroll
                for (int j = 0; j < 4; ++j) { const int tt = r0 + j; const int nn = d ? 63 - tt : tt; const float o = fexp(GC[tt]) * a1[j] + a2[j];
                    OGp[((size_t)d * M + rowbase + nn) * 512 + h * 128 + vh * 64 + cx] = f2bf(o); } }
            __syncthreads();
        }
    }
}
__device__ __forceinline__ void fft1_item(const Prm& p, int item, unsigned char* lds, int tid) {
    const int b = item >> 7, t2 = item & 127; const int wave = tid >> 6, lane = tid & 63, fr = lane & 15, fq = lane >> 4;
    bf16_t* A1 = (bf16_t*)lds; bf16_t* Bt = A1 + 128 * 136;
    const bf16_t* U = (const bf16_t*)(p.ws + WS_U); bf16_t* MID = (bf16_t*)(p.ws + WS_MID);
    for (int e = tid; e < 4096; e += 512) { const int f1 = e >> 6, t1 = e & 63; const int m = (f1 * (128 * t1 + t2)) & 8191; const float s = __builtin_amdgcn_sinf((float)m * (1.f / 8192.f)), c = __builtin_amdgcn_cosf((float)m * (1.f / 8192.f));
        A1[f1 * 136 + t1] = f2bf(c); A1[f1 * 136 + 64 + t1] = f2bf(s); A1[(64 + f1) * 136 + t1] = f2bf(-s); A1[(64 + f1) * 136 + 64 + t1] = f2bf(c); }
    { const int t1 = tid >> 3, pc = tid & 7; const bf16_t* up = U + ((size_t)b * T + 128 * t1 + t2) * LDU + C_FZ + pc * 64;
#pragma unroll
      for (int g8 = 0; g8 < 8; ++g8) { const uint4 v = *(const uint4*)(up + g8 * 8); const int col = pc * 64 + g8 * 8; const int part = col >> 8, ch = col & 255;
#pragma unroll
          for (int e = 0; e < 8; ++e) Bt[(ch + e) * 136 + part * 64 + t1] = f2bf(bfe(v, e)); } }
    __syncthreads();
    for (int tile = wave; tile < 128; tile += 8) { const int tm = tile >> 4, tn = tile & 15, r0 = tm * 16 + fq * 4, ch = tn * 16 + fr;
        f32x4 acc = ZERO4; mma_seg(acc, A1, 136, Bt, 136, tm, tn, 4, fr, fq);
#pragma unroll
        for (int j = 0; j < 4; ++j) { const int r = r0 + j, po = r >> 6, f1 = r & 63;
            MID[(((size_t)b * 64 + f1) * 128 + t2) * 512 + po * 256 + ch] = f2bf(acc[j]); } }
    __syncthreads();
}
__device__ __forceinline__ void fft2_item(const Prm& p, int item, unsigned char* lds, int tid) {
    const int b = item >> 7, f1 = (item >> 1) & 63, chh = item & 1; const int wave = tid >> 6, lane = tid & 63, fr = lane & 15, fq = lane >> 4;
    bf16_t* A2 = (bf16_t*)lds; bf16_t* Bt = A2 + 128 * 264;
    const bf16_t* MID = (const bf16_t*)(p.ws + WS_MID); bf16_t* Y = (bf16_t*)(p.ws + WS_Y);
    { const int t2 = tid >> 2, q = tid & 3, pi = q >> 1, hf = q & 1; const bf16_t* mp = MID + (((size_t)b * 64 + f1) * 128 + t2) * 512 + pi * 256 + chh * 128 + hf * 64;
#pragma unroll
      for (int g8 = 0; g8 < 8; ++g8) { const uint4 v = *(const uint4*)(mp + g8 * 8);
#pragma unroll
          for (int e = 0; e < 8; ++e) Bt[(hf * 64 + g8 * 8 + e) * 264 + pi * 128 + t2] = f2bf(bfe(v, e)); } }
    __syncthreads();
    for (int tile = wave; tile < 64; tile += 8) { const int tm = tile >> 3, tn = tile & 7, r0 = tm * 16 + fq * 4, ch = tn * 16 + fr;
        f32x4 acc = ZERO4; mma_seg(acc, A2, 264, Bt, 264, tm, tn, 8, fr, fq);
#pragma unroll
        for (int j = 0; j < 4; ++j) { const int f2 = r0 + j; Y[((size_t)b * T + f1 + 64 * f2) * 1024 + 768 + chh * 128 + ch] = f2bf(acc[j] * 0.011048543456039806f); } }
    __syncthreads();
}
__device__ __forceinline__ void fftc_item(const Prm& p, int item, unsigned char* lds, int tid) {
    const int b = item >> 4, ft = (item >> 2) & 3, cq = item & 3; const int wave = tid >> 6, lane = tid & 63, fr = lane & 15, fq = lane >> 4;
    bf16_t* A3 = (bf16_t*)lds; bf16_t* Bt = A3 + 64 * 520;
    const bf16_t* U = (const bf16_t*)(p.ws + WS_U); bf16_t* Y = (bf16_t*)(p.ws + WS_Y);
    for (int e = tid; e < 64 * 256; e += 512) { const int fl = e >> 8, t = e & 255; const int m = ((ft * 64 + fl) * t) & 255; const float s = __builtin_amdgcn_sinf((float)m * (1.f / 256.f)), c = __builtin_amdgcn_cosf((float)m * (1.f / 256.f));
        A3[fl * 520 + t] = f2bf(c); A3[fl * 520 + 256 + t] = f2bf(s); }
    { const int t = tid >> 1, pi = tid & 1; const bf16_t* up = U + ((size_t)ML + b * TC + t) * LDU + C_FZ + pi * 256 + cq * 64;
#pragma unroll
      for (int g8 = 0; g8 < 8; ++g8) { const uint4 v = *(const uint4*)(up + g8 * 8);
#pragma unroll
          for (int e = 0; e < 8; ++e) Bt[(g8 * 8 + e) * 520 + pi * 256 + t] = f2bf(bfe(v, e)); } }
    __syncthreads();
    for (int tile = wave; tile < 16; tile += 8) { const int tm = tile >> 2, tn = tile & 3, r0 = tm * 16 + fq * 4, ch = tn * 16 + fr;
        f32x4 acc = ZERO4; mma_seg(acc, A3, 520, Bt, 520, tm, tn, 16, fr, fq);
#pragma unroll
        for (int j = 0; j < 4; ++j) Y[((size_t)ML + b * TC + ft * 64 + r0 + j) * 1024 + 768 + cq * 64 + ch] = f2bf(acc[j] * 0.0625f); }
    __syncthreads();
}

__device__ __forceinline__ void rwkv_post_tile(const Prm& p, int l, int tile, unsigned char* lds, int tid_in) {
    int tid = threadIdx.x; asm volatile("" : "+v"(tid));
    const int wave = tid >> 6, lane = tid & 63, fr = lane & 15, fq = lane >> 4;
    bf16_t* GUPt = (bf16_t*)lds; bf16_t* SG = GUPt + 256 * 72; float* GATE = (float*)(SG + 64 * 72);
    const bf16_t* U = (const bf16_t*)(p.ws + WS_U); const bf16_t* ORp = (const bf16_t*)(p.ws + WS_OR); const float* BC = (const float*)(p.ws + WS_BC); bf16_t* Y = (bf16_t*)(p.ws + WS_Y);
    const int n = tid >> 3, jq = tid & 7; const size_t row = (size_t)tile * 64 + n; const bool isctx = row >= (size_t)ML; const int t = isctx ? (int)((row - ML) & (TC - 1)) : (int)(row & (T - 1));
    const float* mu = p.in[10] + l * 896;
    const int cb = jq * 32, hh = jq >> 1;
    uint4 oa[4], ob[4], vr0[5], vr1[5], vr2[5], vr3[5];
#pragma unroll
    for (int g8 = 0; g8 < 4; ++g8) { oa[g8] = *(const uint4*)(ORp + row * 256 + cb + g8 * 8); ob[g8] = *(const uint4*)(ORp + ((size_t)M + row) * 256 + cb + g8 * 8); }
    lerp8_load(U, row, 512 + cb, isctx, t, vr0); lerp8_load(U, row, 512 + cb + 8, isctx, t, vr1); lerp8_load(U, row, 512 + cb + 16, isctx, t, vr2); lerp8_load(U, row, 512 + cb + 24, isctx, t, vr3);
    const float bcs = BC[row * 4 + hh] + BC[((size_t)M + row) * 4 + hh];
    { float m8[8], g8[8];
      { const f32x4 ma = *(const f32x4*)(mu + 832 + jq * 8), mb = *(const f32x4*)(mu + 832 + jq * 8 + 4);
#pragma unroll
        for (int e = 0; e < 4; ++e) { m8[e] = ma[e]; m8[4 + e] = mb[e]; } }
      lerp8(U, row, 832 + jq * 8, isctx, t, m8, g8);
#pragma unroll
      for (int e = 0; e < 8; ++e) g8[e] = sigmoidf_(g8[e]);
      *(uint4*)(SG + n * 72 + jq * 8) = pack8(g8); }
    __syncthreads();
    for (int tl = wave; tl < 64; tl += 8) { const int tm = tl >> 4, tn = tl & 15, r0 = tm * 16 + fq * 4, cx = tn * 16 + fr;
        f32x4 acc = ZERO4; mma_seg(acc, SG, 72, GUPt, 72, tm, tn, 2, fr, fq);
#pragma unroll
        for (int j = 0; j < 4; ++j) GATE[(r0 + j) * 260 + cx] = acc[j]; }
    __syncthreads();
    { float o[32]; float s = 0.f;
#pragma unroll
      for (int g8 = 0; g8 < 4; ++g8)
#pragma unroll
          for (int e = 0; e < 8; ++e) { o[g8 * 8 + e] = bfe(oa[g8], e) + bfe(ob[g8], e); s += o[g8 * 8 + e]; }
      s += shx1(s); const float mean = s * (1.f / 64.f); float vs = 0.f;
#pragma unroll
      for (int e = 0; e < 32; ++e) { const float dd = o[e] - mean; vs += dd * dd; }
      vs += shx1(vs); const float rstd = rsqrtf(vs * (1.f / 64.f) + 64e-5f);
#pragma unroll
      for (int g8 = 0; g8 < 4; ++g8) { float m8[8], v8[8], y8[8], lg[8], lb[8];
          { const float* mp = mu + 512 + cb + g8 * 8; const float* gp = p.in[19] + l * 256 + cb + g8 * 8; const float* bp2 = p.in[20] + l * 256 + cb + g8 * 8;
            const f32x4 ma = *(const f32x4*)mp, mb = *(const f32x4*)(mp + 4), ga = *(const f32x4*)gp, gb = *(const f32x4*)(gp + 4), ba = *(const f32x4*)bp2, bb2 = *(const f32x4*)(bp2 + 4);
#pragma unroll
            for (int e = 0; e < 4; ++e) { m8[e] = ma[e]; m8[4 + e] = mb[e]; lg[e] = ga[e]; lg[4 + e] = gb[e]; lb[e] = ba[e]; lb[4 + e] = bb2[e]; } }
          if (g8 == 0) lerp8_apply(vr0, m8, v8); else if (g8 == 1) lerp8_apply(vr1, m8, v8); else if (g8 == 2) lerp8_apply(vr2, m8, v8); else lerp8_apply(vr3, m8, v8);
          const f32x4 ga0 = *(const f32x4*)(GATE + n * 260 + cb + g8 * 8), ga1 = *(const f32x4*)(GATE + n * 260 + cb + g8 * 8 + 4);
#pragma unroll
          for (int e = 0; e < 8; ++e) { const float yn = (o[g8 * 8 + e] - mean) * rstd * lg[e] + lb[e];
              y8[e] = (yn + bcs * v8[e]) * (e < 4 ? ga0[e] : ga1[e - 4]); }
          *(uint4*)(Y + row * 1024 + cb + g8 * 8) = pack8(y8); } }
    __syncthreads();
}
__device__ __forceinline__ void gdn_post_tile(const Prm& p, int l, int tile, int tid_in) {
    int tid = threadIdx.x; asm volatile("" : "+v"(tid));
    const bf16_t* U = (const bf16_t*)(p.ws + WS_U); const bf16_t* OGp = (const bf16_t*)(p.ws + WS_OG); bf16_t* Y = (bf16_t*)(p.ws + WS_Y);
    const int n = tid >> 3, jq = tid & 7; const size_t row = (size_t)tile * 64 + n; const int cb = jq * 64;
    uint4 oa[8], ob[8], zq[8];
#pragma unroll
    for (int g8 = 0; g8 < 8; ++g8) { oa[g8] = *(const uint4*)(OGp + row * 512 + cb + g8 * 8); ob[g8] = *(const uint4*)(OGp + ((size_t)M + row) * 512 + cb + g8 * 8);
        zq[g8] = *(const uint4*)(U + row * LDU + C_GZ + cb + g8 * 8); }
    float ss = 0.f;
#pragma unroll
    for (int g8 = 0; g8 < 8; ++g8)
#pragma unroll
        for (int e = 0; e < 8; ++e) { const float o = bfe(oa[g8], e) + bfe(ob[g8], e); ss += o * o; }
    ss += shx1(ss); const float rinv = rsqrtf(ss * (1.f / 128.f) + 1e-6f);
#pragma unroll
    for (int g8 = 0; g8 < 8; ++g8) { float y8[8], ng[8];
        { const float* np = p.in[24] + l * 128 + ((cb + g8 * 8) & 127); const f32x4 na = *(const f32x4*)np, nb2 = *(const f32x4*)(np + 4);
#pragma unroll
          for (int e = 0; e < 4; ++e) { ng[e] = na[e]; ng[4 + e] = nb2[e]; } }
#pragma unroll
        for (int e = 0; e < 8; ++e) { const float o = bfe(oa[g8], e) + bfe(ob[g8], e); const float z = bfe(zq[g8], e); y8[e] = o * rinv * ng[e] * siluf_(z); }
        *(uint4*)(Y + row * 1024 + 256 + cb + g8 * 8) = pack8(y8); }
}
__device__ __forceinline__ void post_phase(const Prm& p, int l, unsigned char* lds, int tid, int G) {
    const int bid = blockIdx.x; const int ntile = (l == 0) ? M / 64 : ML / 64;
    if (bid < ntile) { bf16_t* GUPt = (bf16_t*)lds;
        for (int e = tid; e < 64 * 256; e += 512) { const int q = e >> 8, c = e & 255; GUPt[c * 72 + q] = f2bf(p.in[15][((size_t)l * 64 + q) * 256 + c]); }
        __syncthreads();
#ifdef PROBE_RPOST
        for (int rp = 0; rp < PROBE_RPOST; ++rp)
#endif
        for (int tile = bid; tile < ntile; tile += G) rwkv_post_tile(p, l, tile, lds, tid); }
#ifdef PROBE_GPOST
    for (int rp = 0; rp < PROBE_GPOST; ++rp)
#endif
    for (int tile = bid; tile < ntile; tile += G) gdn_post_tile(p, l, tile, tid);
    __syncthreads();
    if (bid < 512) { bf16_t* A2 = (bf16_t*)lds;
        for (int e = tid; e < 128 * 128; e += 512) { const int f2 = e >> 7, t2 = e & 127; const int m = (f2 * t2) & 127; const float s = __builtin_amdgcn_sinf((float)m * (1.f / 128.f)), c = __builtin_amdgcn_cosf((float)m * (1.f / 128.f));
            A2[f2 * 264 + t2] = f2bf(c); A2[f2 * 264 + 128 + t2] = f2bf(s); }
        __syncthreads();
        for (int it = bid; it < 512; it += G) fft2_item(p, it, lds, tid); }
    if (l == 0 && bid >= G - 64) fftc_item(p, bid - (G - 64), lds, tid);
}

#ifndef PHMASK
#define PHMASK 0x3ffff
#endif
#define PH_IN(k) (((PHMASK >> (k)) & 1) && lo <= (k) && (k) < hi)
#ifndef DUPMASK
#define DUPMASK 0
#endif
#define PH_REP(k) for (int rep_ = 0; rep_ <= ((DUPMASK >> (k)) & 1); ++rep_)
#define PH_SYNC(k) do { if (PH_IN(k) && PH_IN((k) + 1)) { if ((k) == 0) grid.sync(); else xcd_barrier(xbar); } } while (0)
constexpr int LDS_TAB = 131072;
__device__ __forceinline__ const PG8_LAS float* fill_rs_table(unsigned char* lds, const pg8::StaticOrder& S, const float* SS, const float* bias, int ldb) {
    float* tab = (float*)(lds + LDS_TAB); const int tid = threadIdx.x; pg8::Unit u;
    for (int i = 0; i < 10 && S.next(i, u); ++i) {
        if (tid < 256) tab[i * 512 + tid] = __builtin_amdgcn_rsqf(SS[u.pm * 256 + tid] * (1.f / 1024.f) + 1e-6f);
        else { const int bb = u.pm < 128 ? (u.pm >> 5) : 4; tab[i * 512 + tid] = bias[(size_t)bb * ldb + u.pn * 256 + (tid - 256)]; } }
    __syncthreads();
    return (const PG8_LAS float*)((PG8_LAS unsigned char*)lds + LDS_TAB);
}
template <int L>
__device__ __forceinline__ void layer_phases(const Prm& p, cg::grid_group& grid, const XcdBarrier& xbar, unsigned char* lds, int lo, int hi) {
    constexpr int l = L; constexpr int base = 1 + 8 * L;
    if (L == 0) { if (PH_IN(base + 0)) PH_REP(base + 0) { int tid = threadIdx.x; asm volatile("" : "+v"(tid)); norm_phase(p, l, 0, tid, gridDim.x); bias_items(p, tid, gridDim.x); }
        PH_SYNC(base + 0); }
    if (PH_IN(base + 1)) PH_REP(base + 1) { unsigned char* ws = p.ws; const int G = gridDim.x, bid = blockIdx.x;
        pg8::Gemm g{(const bf16_t*)(ws + WS_HN), (const bf16_t*)(ws + WS_WIN) + (size_t)l * LDU * 1024, M, LDU, 1024}; pg8::StaticOrder S; S.init(M, LDU, G, bid);
        if (L == 0) { pg8::EpiBf16<0> E{(bf16_t*)(ws + WS_U), LDU};
            pg8::gemm_phase<pg8::EpiBf16<0>, pg8::StaticOrder, true, true>((PG8_LAS unsigned char*)lds, g, S, E); }
        else { const PG8_LAS float* tab = fill_rs_table(lds, S, (const float*)(ws + WS_SS) + 2 * M, (const float*)(ws + WS_BIAS), 3584);
            pg8::EpiBf16RS<0> E{(bf16_t*)(ws + WS_U), LDU, tab};
            pg8::gemm_phase<pg8::EpiBf16RS<0>, pg8::StaticOrder, true, true>((PG8_LAS unsigned char*)lds, g, S, E); } }
    PH_SYNC(base + 1);
    if (PH_IN(base + 2)) PH_REP(base + 2) { int tid = threadIdx.x; asm volatile("" : "+v"(tid)); const int G = gridDim.x, bid = blockIdx.x;
        if (G >= 256) { if (bid < 128) rwkv_scan(p, l, bid >> 2, bid & 3, 4, lds, tid); else if (bid < 256) gdn_scan(p, l, (bid - 128) >> 2, bid & 3, 4, lds, tid);
            if (bid < 128) for (int it = bid; it < 512; it += 128) fft1_item(p, it, lds, tid); }
        else { if (bid < 32) rwkv_scan(p, l, bid, 0, 1, lds, tid); else if (bid < 64) gdn_scan(p, l, bid - 32, 0, 1, lds, tid);
            else for (int it = bid - 64; it < 512; it += G - 64) fft1_item(p, it, lds, tid); } }
    PH_SYNC(base + 2);
    if (PH_IN(base + 3)) PH_REP(base + 3) { int tid = threadIdx.x; asm volatile("" : "+v"(tid)); post_phase(p, l, lds, tid, gridDim.x); }
    PH_SYNC(base + 3);
    if (PH_IN(base + 4)) PH_REP(base + 4) { unsigned char* ws = p.ws; const int G = gridDim.x, bid = blockIdx.x; const float* modl = (const float*)(ws + WS_MOD) + (size_t)l * 5 * 6144;
        constexpr int Mg = (l == 0) ? M : ML;
        pg8::Gemm g{(const bf16_t*)(ws + WS_Y), (const bf16_t*)(ws + WS_WOUT) + (size_t)l * 1024 * 1024, Mg, 1024, 1024}; pg8::StaticOrder S; S.init(Mg, 1024, G, bid);
        pg8::EpiResidN E{l == 0 ? p.in[0] : p.out, l == 0 ? p.in[2] : (const float*)(ws + WS_XC), p.out, (float*)(ws + WS_XC), modl + 2 * 1024,
                         (bf16_t*)(ws + WS_HN), (float*)(ws + WS_SS) + l * M, p.in[5] + l * 1024, modl + 4 * 1024};
        pg8::gemm_phase<pg8::EpiResidN, pg8::StaticOrder, true, true>((PG8_LAS unsigned char*)lds, g, S, E); }
    PH_SYNC(base + 4);
    if (PH_IN(base + 6)) PH_REP(base + 6) { unsigned char* ws = p.ws; const int G = gridDim.x, bid = blockIdx.x; constexpr int Mg = (l == 0) ? M : ML;
        pg8::Gemm g{(const bf16_t*)(ws + WS_HN), (const bf16_t*)(ws + WS_W1) + (size_t)l * 4096 * 1024, Mg, DFF, 1024}; pg8::StaticOrder S; S.init(Mg, DFF, G, bid);
        const PG8_LAS float* tab = fill_rs_table(lds, S, (const float*)(ws + WS_SS) + l * M, (const float*)(ws + WS_BIAS) + 5 * 3584 + l * 5 * 4096, 4096);
        pg8::EpiBf16RS<1> E{(bf16_t*)(ws + WS_H), DFF, tab};
        pg8::gemm_phase<pg8::EpiBf16RS<1>, pg8::StaticOrder, true, true>((PG8_LAS unsigned char*)lds, g, S, E); }
    PH_SYNC(base + 6);
    if (PH_IN(base + 7)) PH_REP(base + 7) { unsigned char* ws = p.ws; const int G = gridDim.x, bid = blockIdx.x; const float* modl = (const float*)(ws + WS_MOD) + (size_t)l * 5 * 6144; constexpr int Mg = (l == 0) ? M : ML;
        pg8::Gemm g{(const bf16_t*)(ws + WS_H), (const bf16_t*)(ws + WS_W2) + (size_t)l * 1024 * 4096, Mg, 1024, DFF}; pg8::StaticOrder S; S.init(Mg, 1024, G, bid);
        if (L == 0) { const float* modn = (const float*)(ws + WS_MOD) + (size_t)5 * 6144;
            pg8::EpiResidN E{p.out, (const float*)(ws + WS_XC), p.out, (float*)(ws + WS_XC), modl + 5 * 1024, (bf16_t*)(ws + WS_HN), (float*)(ws + WS_SS) + 2 * M, p.in[4] + 1024, modn + 1 * 1024};
            pg8::gemm_phase<pg8::EpiResidN, pg8::StaticOrder, true, true>((PG8_LAS unsigned char*)lds, g, S, E); }
        else { pg8::EpiResid E{p.out, (const float*)(ws + WS_XC), p.out, (float*)(ws + WS_XC), modl + 5 * 1024};
            pg8::gemm_phase<pg8::EpiResid, pg8::StaticOrder, true, true>((PG8_LAS unsigned char*)lds, g, S, E); } }
    PH_SYNC(base + 7);
}
__global__ void __launch_bounds__(512, 2) mega_fwd(Prm p) {
    extern __shared__ __attribute__((aligned(16))) unsigned char lds[];
    cg::grid_group grid = cg::this_grid();
    const int lo = p.ph_lo, hi = p.ph_hi;
    if (threadIdx.x < 2) ((volatile LAS unsigned*)((LAS unsigned char*)lds + LDS_XB))[threadIdx.x] = 0u;
    __syncthreads();
#ifdef EXTRA_SYNCS
    for (int es = 0; es < EXTRA_SYNCS; ++es) grid.sync();
#endif
    if (PH_IN(0)) PH_REP(0) { int tid = threadIdx.x; asm volatile("" : "+v"(tid)); prep_phase(p, lds, tid, gridDim.x); }
    if (PH_IN(0) && PH_IN(1)) grid.sync();
    const XcdBarrier xbar = xcd_barrier_post((unsigned*)(p.ws + WS_BARW), (volatile LAS unsigned*)((LAS unsigned char*)lds + LDS_XB));
    layer_phases<0>(p, grid, xbar, lds, lo, hi);
    layer_phases<1>(p, grid, xbar, lds, lo, hi);
    if (PH_IN(NPH - 1)) { int tid = threadIdx.x; asm volatile("" : "+v"(tid)); norm_phase(p, 1, 2, tid, gridDim.x); }
}

#ifndef MK_SPLIT
#define MK_SPLIT 0
#endif
extern "C" void kernel_launch(void* const* d_in, const int* in_sizes, int n_in, void* d_out, int out_size, void* d_ws, size_t ws_size, hipStream_t stream) {
    static int grid = 0;
    if (grid == 0) {
        int dev = 0, cus = 0, per_cu = 0;
        if (n_in != 29 || out_size != ML * D || ws_size < WS_END3) { fprintf(stderr, "kernel_launch: unexpected problem shape (n_in %d out %d ws %zu)\n", n_in, out_size, ws_size); grid = -1; return; }
        hipGetDevice(&dev); hipDeviceGetAttribute(&cus, hipDeviceAttributeMultiprocessorCount, dev);
        if (hipFuncSetAttribute((const void*)mega_fwd, hipFuncAttributeMaxDynamicSharedMemorySize, LDS_BYTES) != hipSuccess) { fprintf(stderr, "kernel_launch: hipFuncSetAttribute failed\n"); grid = -1; return; }
        if (hipOccupancyMaxActiveBlocksPerMultiprocessor(&per_cu, (const void*)mega_fwd, 512, LDS_BYTES) != hipSuccess || per_cu < 1) { fprintf(stderr, "kernel_launch: occupancy query says %d blocks per CU\n", per_cu); grid = -1; return; }
        grid = cus * 1;
        if (grid > 256) grid = 256;
        if (grid < 128) { fprintf(stderr, "kernel_launch: needs >= 128 CUs\n"); grid = -1; return; }
    }
    if (grid < 0) return;
    Prm prm{};
    for (int i = 0; i < 29; ++i) prm.in[i] = (const float*)d_in[i];
    prm.out = (float*)d_out; prm.ws = (unsigned char*)d_ws;
#if MK_SPLIT
    for (int ph = 0; ph < NPH; ++ph) { prm.ph_lo = ph; prm.ph_hi = ph + 1; void* args[] = {&prm};
        hipError_t e = hipLaunchCooperativeKernel((const void*)mega_fwd, dim3(grid), dim3(512), args, LDS_BYTES, stream);
        if (e != hipSuccess) { fprintf(stderr, "kernel_launch: launch failed: %s\n", hipGetErrorString(e)); break; } }
#else
    prm.ph_lo = 0; prm.ph_hi = NPH; void* args[] = {&prm};
    hipError_t e = hipLaunchCooperativeKernel((const void*)mega_fwd, dim3(grid), dim3(512), args, LDS_BYTES, stream);
    if (e != hipSuccess) fprintf(stderr, "kernel_launch: cooperative launch failed: %s (grid %d)\n", hipGetErrorString(e), grid);
#endif
}
```

```cpp
#include <hip/hip_runtime.h>
#include <hip/hip_cooperative_groups.h>
#include <cstdio>
#include <cstdint>
namespace cg = cooperative_groups;
namespace pg8 {
#define PG8_LAS __attribute__((address_space(3)))
typedef unsigned short bf16_t;
typedef short bf16x8 __attribute__((ext_vector_type(8)));
typedef float f32x4 __attribute__((ext_vector_type(4)));
typedef unsigned u32x4 __attribute__((ext_vector_type(4)));
constexpr int BM = 256, BK = 64, HALF = 128, HTB = HALF * BK * 2  , STAGE_BYTES = 8 * HTB, NXCD = 8, WGM = 8;

__host__ __device__ __forceinline__ int lds_byte(int r, int c) { const int st = (r >> 4) * 2 + (c >> 5), rr = r & 15, cc = c & 31, ob = rr * 64 + cc * 2; return st * 1024 + (ob ^ (((ob >> 9) & 1) << 5)); }
__host__ __device__ __forceinline__ void stage_rc(int b, int& R, int& C) { const int st = b / 1024, sb = b % 1024, swz = sb ^ (((sb >> 9) & 1) << 5); R = (st >> 1) * 16 + swz / 64; C = (st & 1) * 32 + (swz % 64) / 2; }
__host__ __device__ __forceinline__ int perm32(int rho) { const int n = rho >> 4, i = rho & 15; return 8 * (i >> 2) + 4 * n + (i & 3); }

struct Unit { int pm, pn, ord; };
struct Gemm { const bf16_t* A; const bf16_t* Bt; int M, N, K; };

struct StaticOrder {
    int nM, nN, nwg, G, c;
    __host__ __device__ void init(int M, int N, int G_, int c_) { nM = M / BM; nN = N / BM; nwg = nM * nN; G = G_; c = c_; }
    __host__ __device__ bool next(int i, Unit& u) const {
        const long L = (long)i * G + c; if (L >= nwg) return false;
        int wgid = (int)L; { const int q = nwg / NXCD, r = nwg % NXCD, xcd = wgid % NXCD, off = wgid / NXCD; wgid = (xcd < r ? xcd * (q + 1) : r * (q + 1) + (xcd - r) * q) + off; }
        const int nig = WGM * nN, gid = wgid / nig, fm = gid * WGM, gsz = (nM - fm) < WGM ? (nM - fm) : WGM;
        u.pm = fm + ((wgid % nig) % gsz); u.pn = (wgid % nig) / gsz; u.ord = i; return true;
    }
    __device__ __forceinline__ void a_ready(const Unit&) const {}
    __device__ __forceinline__ void done(const Unit&) const {}
};

typedef __bf16 bf16x2_t __attribute__((ext_vector_type(2)));
typedef float f32x2_t __attribute__((ext_vector_type(2)));
__device__ __forceinline__ unsigned cvt_pk_bf16(float lo, float hi) { const f32x2_t v = {lo, hi}; const bf16x2_t b = __builtin_convertvector(v, bf16x2_t); return __builtin_bit_cast(unsigned, b); }
template <int ACT  > struct EpiBf16 {
    static constexpr bool PERM = true, AFTER_DRAIN = false;
    bf16_t* O; int ldc;
    __device__ __forceinline__ void operator()(const f32x4 (&acc)[2][2][4][2], const Unit& u, int wr, int wc, int fr, int fq) const {
        const int row0 = u.pm * BM + wr * 64 + fr; const int col0 = u.pn * BM + wc * 32 + 8 * fq;
#pragma unroll
        for (int ai = 0; ai < 2; ++ai)
#pragma unroll
            for (int m = 0; m < 4; ++m) { bf16_t* rowp = O + (size_t)(row0 + ai * HALF + m * 16) * ldc + col0;
#pragma unroll
                for (int bj = 0; bj < 2; ++bj) { f32x4 v0 = acc[ai][bj][m][0], v1 = acc[ai][bj][m][1];
                    if (ACT == 1) {
#pragma unroll
                        for (int e = 0; e < 4; ++e) { float a = v0[e] > 0.f ? v0[e] : 0.f; v0[e] = a * a; float b = v1[e] > 0.f ? v1[e] : 0.f; v1[e] = b * b; } }
                    u32x4 w; w.x = cvt_pk_bf16(v0[0], v0[1]); w.y = cvt_pk_bf16(v0[2], v0[3]); w.z = cvt_pk_bf16(v1[0], v1[1]); w.w = cvt_pk_bf16(v1[2], v1[3]);
                    *(u32x4*)(rowp + bj * HALF) = w; } }
    }
};
struct EpiResid {
    static constexpr bool PERM = true, AFTER_DRAIN = false;
    const float* rin_lat; const float* rin_ctx; float* rout_lat; float* rout_ctx; const float* gate;
    __device__ __forceinline__ void operator()(const f32x4 (&acc)[2][2][4][2], const Unit& u, int wr, int wc, int fr, int fq) const {
        const bool lat = u.pm < 128; const int bb = lat ? (u.pm >> 5) : 4;
        const int rbase = (lat ? u.pm * 256 : (u.pm - 128) * 256) + wr * 64 + fr;
        const float* rin = lat ? rin_lat : rin_ctx; float* rout = lat ? rout_lat : rout_ctx;
        const int col0 = u.pn * BM + wc * 32 + 8 * fq;
        const float* gv = gate + bb * 6144 + col0;
        f32x4 g[2][2];
#pragma unroll
        for (int bj = 0; bj < 2; ++bj)
#pragma unroll
            for (int n = 0; n < 2; ++n) g[bj][n] = *(const f32x4*)(gv + bj * HALF + 4 * n);
#pragma unroll
        for (int ai = 0; ai < 2; ++ai)
#pragma unroll
            for (int m = 0; m < 4; ++m) { const size_t ro = (size_t)(rbase + ai * HALF + m * 16) * 1024 + col0;
#pragma unroll
                for (int bj = 0; bj < 2; ++bj) {
                    const f32x4 x0 = *(const f32x4*)(rin + ro + bj * HALF), x1 = *(const f32x4*)(rin + ro + bj * HALF + 4);
                    *(f32x4*)(rout + ro + bj * HALF) = x0 + g[bj][0] * acc[ai][bj][m][0];
                    *(f32x4*)(rout + ro + bj * HALF + 4) = x1 + g[bj][1] * acc[ai][bj][m][1]; } }
    }
};
struct EpiResidN {
    static constexpr bool PERM = true, AFTER_DRAIN = false;
    const float* rin_lat; const float* rin_ctx; float* rout_lat; float* rout_ctx; const float* gate;
    bf16_t* XB; float* SS; const float* gvec; const float* scn;
    __device__ __forceinline__ void operator()(const f32x4 (&acc)[2][2][4][2], const Unit& u, int wr, int wc, int fr, int fq) const {
        const bool lat = u.pm < 128; const int bb = lat ? (u.pm >> 5) : 4;
        const int rbase = (lat ? u.pm * 256 : (u.pm - 128) * 256) + wr * 64 + fr; const int grow = u.pm * 256 + wr * 64 + fr;
        const float* rin = lat ? rin_lat : rin_ctx; float* rout = lat ? rout_lat : rout_ctx;
        const int col0 = u.pn * BM + wc * 32 + 8 * fq;
        const float* gv = gate + bb * 6144 + col0;
        f32x4 g[2][2], gs[2][2];
#pragma unroll
        for (int bj = 0; bj < 2; ++bj)
#pragma unroll
            for (int n = 0; n < 2; ++n) { g[bj][n] = *(const f32x4*)(gv + bj * HALF + 4 * n);
                gs[bj][n] = *(const f32x4*)(gvec + col0 + bj * HALF + 4 * n) * (*(const f32x4*)(scn + bb * 6144 + col0 + bj * HALF + 4 * n) + 1.f); }
#pragma unroll
        for (int ai = 0; ai < 2; ++ai)
#pragma unroll
            for (int m = 0; m < 4; ++m) { const size_t ro = (size_t)(rbase + ai * HALF + m * 16) * 1024 + col0; bf16_t* xb = XB + (size_t)(grow + ai * HALF + m * 16) * 1024 + col0; float ssq = 0.f;
#pragma unroll
                for (int bj = 0; bj < 2; ++bj) {
                    const f32x4 x0 = *(const f32x4*)(rin + ro + bj * HALF), x1 = *(const f32x4*)(rin + ro + bj * HALF + 4);
                    const f32x4 o0 = x0 + g[bj][0] * acc[ai][bj][m][0], o1 = x1 + g[bj][1] * acc[ai][bj][m][1];
                    *(f32x4*)(rout + ro + bj * HALF) = o0; *(f32x4*)(rout + ro + bj * HALF + 4) = o1;
                    ssq += (o0[0] * o0[0] + o0[1] * o0[1]) + (o0[2] * o0[2] + o0[3] * o0[3]) + (o1[0] * o1[0] + o1[1] * o1[1]) + (o1[2] * o1[2] + o1[3] * o1[3]);
                    const f32x4 y0 = o0 * gs[bj][0], y1 = o1 * gs[bj][1];
                    u32x4 w; w.x = cvt_pk_bf16(y0[0], y0[1]); w.y = cvt_pk_bf16(y0[2], y0[3]); w.z = cvt_pk_bf16(y1[0], y1[1]); w.w = cvt_pk_bf16(y1[2], y1[3]);
                    *(u32x4*)(xb + bj * HALF) = w; }
                ssq += __shfl_xor(ssq, 16); ssq += __shfl_xor(ssq, 32);
                if (fq == 0) __hip_atomic_fetch_add(SS + grow + ai * HALF + m * 16, ssq, __ATOMIC_RELAXED, __HIP_MEMORY_SCOPE_AGENT); }
    }
};
template <int ACT  > struct EpiBf16RS {
    static constexpr bool PERM = true, AFTER_DRAIN = false;
    bf16_t* O; int ldc; const PG8_LAS float* tab;
    __device__ __forceinline__ void operator()(const f32x4 (&acc)[2][2][4][2], const Unit& u, int wr, int wc, int fr, int fq) const {
        const int row0 = u.pm * BM + wr * 64 + fr; const int col0 = u.pn * BM + wc * 32 + 8 * fq;
        const PG8_LAS float* tr = tab + u.ord * 512 + wr * 64 + fr; const PG8_LAS float* tb = tab + u.ord * 512 + 256 + wc * 32 + 8 * fq;
        f32x4 bv[2][2];
#pragma unroll
        for (int bj = 0; bj < 2; ++bj)
#pragma unroll
            for (int n = 0; n < 2; ++n) bv[bj][n] = *(const PG8_LAS f32x4*)(tb + bj * HALF + 4 * n);
#pragma unroll
        for (int ai = 0; ai < 2; ++ai)
#pragma unroll
            for (int m = 0; m < 4; ++m) { const int r = row0 + ai * HALF + m * 16; const float rinv = tr[ai * HALF + m * 16];
                bf16_t* rowp = O + (size_t)r * ldc + col0;
#pragma unroll
                for (int bj = 0; bj < 2; ++bj) { f32x4 v0 = acc[ai][bj][m][0] * rinv + bv[bj][0], v1 = acc[ai][bj][m][1] * rinv + bv[bj][1];
                    if (ACT == 1) {
#pragma unroll
                        for (int e = 0; e < 4; ++e) { float a = v0[e] > 0.f ? v0[e] : 0.f; v0[e] = a * a; float b = v1[e] > 0.f ? v1[e] : 0.f; v1[e] = b * b; } }
                    u32x4 w; w.x = cvt_pk_bf16(v0[0], v0[1]); w.y = cvt_pk_bf16(v0[2], v0[3]); w.z = cvt_pk_bf16(v1[0], v1[1]); w.w = cvt_pk_bf16(v1[2], v1[3]);
                    *(u32x4*)(rowp + bj * HALF) = w; } }
    }
};
template <class Epi, class Sched, bool ALIGN_EPI = false, bool SP2 = false>
__device__ __forceinline__ void gemm_phase(PG8_LAS unsigned char* lds, const Gemm g, const Sched& S, const Epi& E) {
    int tid_l = threadIdx.x; asm volatile("" : "+v"(tid_l));
    const int tid = tid_l, wid = __builtin_amdgcn_readfirstlane(tid >> 6), lane = tid & 63, wr = wid >> 2, wc = wid & 3, fr = lane & 15, fq = lane >> 4;
    const int K = g.K, nt = K / BK;
    unsigned voffA[2], voffB[2];
#pragma unroll
    for (int i = 0; i < 2; ++i) { int R, C; stage_rc(tid * 16 + i * 8192, R, C); const int Rb = Epi::PERM ? ((R & ~31) + perm32(R & 31)) : R;
        voffA[i] = (unsigned)(R * K + C) * 2u; voffB[i] = (unsigned)(Rb * K + C) * 2u; }
    const size_t kstep = (size_t)(BK * 2);
    const size_t hstep = (size_t)HALF * K * 2;
    const size_t tstep = 2 * hstep;
    const unsigned ldsw = (unsigned)wid * 1024u;
    const int aoff = lds_byte(wr * 64 + fr, fq * 8), boff = lds_byte(wc * 32 + fr, fq * 8);
#define PG8_SA(b, h) (((b) * 2 + (h)) * HTB)
#define PG8_SB(b, h) ((4 + (b) * 2 + (h)) * HTB)
#define PG8_STAGE(bufoff, gbase, voff) do { _Pragma("unroll") for (int _i = 0; _i < 2; ++_i) \
        __builtin_amdgcn_global_load_lds((const unsigned*)((const char*)(gbase) + (voff)[_i]), (PG8_LAS unsigned*)(lds + (bufoff) + ldsw + _i * 8192), 16, 0, 0); } while (0)
#define PG8_LDA(dst, b, h) do { _Pragma("unroll") for (int m = 0; m < 4; ++m) _Pragma("unroll") for (int k = 0; k < 2; ++k) dst[m][k] = *(const PG8_LAS bf16x8*)(lds + PG8_SA(b, h) + aoff + m * 2048 + k * 1024); } while (0)
#define PG8_LDB(dst, b, h) do { _Pragma("unroll") for (int n = 0; n < 2; ++n) _Pragma("unroll") for (int k = 0; k < 2; ++k) dst[n][k] = *(const PG8_LAS bf16x8*)(lds + PG8_SB(b, h) + boff + n * 2048 + k * 1024); } while (0)
#define PG8_MMA(ai, bj, At, Bt) do { __builtin_amdgcn_s_setprio(1); _Pragma("unroll") for (int m = 0; m < 4; ++m) _Pragma("unroll") for (int n = 0; n < 2; ++n) _Pragma("unroll") for (int k = 0; k < 2; ++k) \
        acc[ai][bj][m][n] = __builtin_amdgcn_mfma_f32_16x16x32_bf16(Bt[n][k], At[m][k], acc[ai][bj][m][n], 0, 0, 0); __builtin_amdgcn_s_setprio(0); } while (0)
#define PG8_WAIT_V(n) asm volatile("s_waitcnt vmcnt(" #n ")" ::: "memory")
#define PG8_WAIT_L(n) asm volatile("s_waitcnt lgkmcnt(" #n ")" ::: "memory")
#define PG8_BAR __builtin_amdgcn_s_barrier()
#define PG8_SCHED __builtin_amdgcn_sched_barrier(0)
    Unit cur, nxt; int ui = 0;
    if (!S.next(0, cur)) return;
    f32x4 acc[2][2][4][2];
#pragma unroll
    for (int a = 0; a < 2; ++a)
#pragma unroll
        for (int b = 0; b < 2; ++b)
#pragma unroll
            for (int m = 0; m < 4; ++m)
#pragma unroll
                for (int n = 0; n < 2; ++n) acc[a][b][m][n] = (f32x4){0.f, 0.f, 0.f, 0.f};
    bf16x8 At[4][2], B0[2][2], B1[2][2];
    const char* cA = (const char*)g.A + (size_t)cur.pm * tstep; const char* cB = (const char*)g.Bt + (size_t)cur.pn * tstep;
    S.a_ready(cur);
    if constexpr (SP2) {
        PG8_STAGE(PG8_SB(0, 0), cB, voffB); PG8_STAGE(PG8_SB(0, 1), cB + hstep, voffB); PG8_STAGE(PG8_SA(0, 0), cA, voffA); PG8_STAGE(PG8_SA(0, 1), cA + hstep, voffA);
        if (wr == 1) PG8_BAR;
        PG8_WAIT_V(2); PG8_BAR;
        PG8_STAGE(PG8_SB(1, 0), cB + kstep, voffB); PG8_STAGE(PG8_SA(1, 0), cA + kstep, voffA); PG8_STAGE(PG8_SB(1, 1), cB + hstep + kstep, voffB);
        PG8_WAIT_V(6); PG8_BAR;
    } else {
        PG8_STAGE(PG8_SB(0, 0), cB, voffB); PG8_STAGE(PG8_SA(0, 0), cA, voffA); PG8_STAGE(PG8_SB(0, 1), cB + hstep, voffB); PG8_STAGE(PG8_SA(0, 1), cA + hstep, voffA);
        if (wr == 1) PG8_BAR;
        PG8_WAIT_V(4); PG8_BAR;
        PG8_STAGE(PG8_SB(1, 0), cB + kstep, voffB); PG8_STAGE(PG8_SA(1, 0), cA + kstep, voffA); PG8_STAGE(PG8_SB(1, 1), cB + hstep + kstep, voffB);
        PG8_WAIT_V(6); PG8_BAR;
    }
    for (;;) {
        const bool has_next = S.next(ui + 1, nxt);
        const char* nA = has_next ? (const char*)g.A + (size_t)nxt.pm * tstep : cA; const char* nB = has_next ? (const char*)g.Bt + (size_t)nxt.pn * tstep : cB;
        for (int t = 0; t < nt; t += 2) {
            const bool last = (t == nt - 2);
            const char* a1 = cA + (size_t)(t + 1) * kstep;
            const char* a2 = last ? nA : cA + (size_t)(t + 2) * kstep; const char* b2 = last ? nB : cB + (size_t)(t + 2) * kstep;
            const char* a3 = a2 + kstep; const char* b3 = b2 + kstep;
            if (last && has_next) S.a_ready(nxt);
            if constexpr (SP2) {
            PG8_LDB(B0, 0, 0); PG8_LDB(B1, 0, 1); PG8_SCHED; PG8_LDA(At, 0, 0); PG8_STAGE(PG8_SA(1, 1), a1 + hstep, voffA);
            PG8_WAIT_V(8); PG8_WAIT_L(0); PG8_BAR; PG8_MMA(0, 0, At, B0); PG8_MMA(0, 1, At, B1); PG8_BAR; PG8_SCHED;
            PG8_LDA(At, 0, 1); PG8_STAGE(PG8_SB(0, 0), b2, voffB); PG8_STAGE(PG8_SB(0, 1), b2 + hstep, voffB); PG8_STAGE(PG8_SA(0, 0), a2, voffA);
            PG8_WAIT_V(8); PG8_WAIT_L(0); PG8_BAR; PG8_MMA(1, 0, At, B0); PG8_MMA(1, 1, At, B1); PG8_BAR; PG8_SCHED;
            PG8_LDB(B0, 1, 0); PG8_LDB(B1, 1, 1); PG8_SCHED; PG8_LDA(At, 1, 0); PG8_STAGE(PG8_SA(0, 1), a2 + hstep, voffA);
            PG8_WAIT_V(8); PG8_WAIT_L(0); PG8_BAR; PG8_MMA(0, 0, At, B0); PG8_MMA(0, 1, At, B1); PG8_BAR; PG8_SCHED;
            PG8_LDA(At, 1, 1); PG8_STAGE(PG8_SB(1, 0), b3, voffB); PG8_STAGE(PG8_SB(1, 1), b3 + hstep, voffB); PG8_STAGE(PG8_SA(1, 0), a3, voffA);
            PG8_WAIT_V(8); PG8_WAIT_L(0); PG8_BAR; PG8_MMA(1, 0, At, B0); PG8_MMA(1, 1, At, B1); PG8_BAR; PG8_SCHED;
            } else {
            PG8_LDB(B0, 0, 0); PG8_SCHED; PG8_LDA(At, 0, 0); PG8_STAGE(PG8_SA(1, 1), a1 + hstep, voffA);
            PG8_WAIT_L(8); PG8_BAR; PG8_WAIT_L(0); PG8_MMA(0, 0, At, B0); PG8_BAR; PG8_SCHED;
            PG8_LDB(B1, 0, 1); PG8_STAGE(PG8_SB(0, 0), b2, voffB);
            PG8_BAR; PG8_WAIT_L(0); PG8_MMA(0, 1, At, B1); PG8_BAR;
            PG8_LDA(At, 0, 1); PG8_STAGE(PG8_SA(0, 0), a2, voffA);
            PG8_BAR; PG8_WAIT_L(0); PG8_MMA(1, 0, At, B0); PG8_BAR; PG8_SCHED;
            PG8_STAGE(PG8_SB(0, 1), b2 + hstep, voffB);
            PG8_WAIT_V(6); PG8_BAR; PG8_MMA(1, 1, At, B1); PG8_BAR;
            PG8_LDB(B0, 1, 0); PG8_SCHED; PG8_LDA(At, 1, 0); PG8_STAGE(PG8_SA(0, 1), a2 + hstep, voffA);
            PG8_WAIT_L(8); PG8_BAR; PG8_WAIT_L(0); PG8_MMA(0, 0, At, B0); PG8_BAR; PG8_SCHED;
            PG8_LDB(B1, 1, 1); PG8_STAGE(PG8_SB(1, 0), b3, voffB);
            PG8_BAR; PG8_WAIT_L(0); PG8_MMA(0, 1, At, B1); PG8_BAR;
            PG8_LDA(At, 1, 1); PG8_STAGE(PG8_SA(1, 0), a3, voffA);
            PG8_BAR; PG8_WAIT_L(0); PG8_MMA(1, 0, At, B0); PG8_BAR; PG8_SCHED;
            PG8_STAGE(PG8_SB(1, 1), b3 + hstep, voffB);
            PG8_WAIT_V(6); PG8_BAR; PG8_MMA(1, 1, At, B1); PG8_BAR;
            }
        }
        if constexpr (ALIGN_EPI) { if (wr == 0) PG8_BAR; }
        if constexpr (!Epi::AFTER_DRAIN) { E(acc, cur, wr, wc, fr, fq); S.done(cur); }
        if (!has_next) break;
#pragma unroll
        for (int a = 0; a < 2; ++a)
#pragma unroll
            for (int b = 0; b < 2; ++b)
#pragma unroll
                for (int m = 0; m < 4; ++m)
#pragma unroll
                    for (int n = 0; n < 2; ++n) acc[a][b][m][n] = (f32x4){0.f, 0.f, 0.f, 0.f};
        cur = nxt; cA = nA; cB = nB; ++ui;
        if constexpr (ALIGN_EPI) { if (wr == 1) PG8_BAR; }
    }
    PG8_WAIT_V(0);
    if constexpr (!ALIGN_EPI) { if (wr == 0) PG8_BAR; }
    PG8_BAR;
    if constexpr (Epi::AFTER_DRAIN) { E.fused(acc, cur, wr, wc, fr, fq, lds, wid, lane); S.done(cur); }
#undef PG8_SA
#undef PG8_SB
#undef PG8_STAGE
#undef PG8_LDA
#undef PG8_LDB
#undef PG8_MMA
#undef PG8_WAIT_V
#undef PG8_WAIT_L
#undef PG8_BAR
#undef PG8_SCHED
}
}
typedef unsigned short bf16_t;
typedef short bf16x8 __attribute__((ext_vector_type(8)));
typedef float f32x4 __attribute__((ext_vector_type(4)));
constexpr int NB = 4, T = 8192, TC = 256, D = 1024, DFF = 4096;
constexpr int ML = NB * T, MC = NB * TC, M = ML + MC;
constexpr int LDU = 3584;
constexpr int NPLAIN = 2960, WIN_N = 3216;
constexpr int C_GQ = 896, C_GK = 1408, C_GV = 1920, C_GZ = 2432, C_GS = 2944, C_FZ = 2960;
constexpr size_t MiB = 1u << 20;
constexpr size_t WS_MOD = MiB / 2;
constexpr size_t WS_BC = 3 * MiB / 4;
constexpr size_t WS_WIN = 2 * MiB;
constexpr size_t WS_WOUT = 16 * MiB;
constexpr size_t WS_W1 = 20 * MiB;
constexpr size_t WS_W2 = 36 * MiB;
constexpr size_t WS_XC = 52 * MiB;
constexpr size_t WS_HN = 56 * MiB;
constexpr size_t WS_MID = 56 * MiB;
constexpr size_t WS_OR = 88 * MiB;
constexpr size_t WS_U = 122 * MiB;
constexpr size_t WS_OG = 353 * MiB;
constexpr size_t WS_Y = 419 * MiB;
constexpr size_t WS_H = 122 * MiB;
constexpr size_t WS_END = 485 * MiB;
constexpr size_t WS_BARW = 0;
constexpr int LDS_XB = 159680;
constexpr size_t WS_SBR = 485 * MiB;
constexpr size_t WS_SBG = 487 * MiB;
constexpr size_t WS_END2 = 495 * MiB;
constexpr size_t WS_SS = 495 * MiB;
constexpr size_t WS_ZEND = 496 * MiB;
constexpr size_t WS_BIAS = 496 * MiB;
constexpr size_t WS_END3 = 497 * MiB;
constexpr int LDS_BYTES = 159744;
constexpr int NPH = 18;

struct Prm { const float* in[29]; float* out; unsigned char* ws; int ph_lo, ph_hi; };

__device__ __forceinline__ bf16_t f2bf(float f) { const __bf16 b = (__bf16)f; return __builtin_bit_cast(unsigned short, b); }
__device__ __forceinline__ float bf2f(bf16_t h) { return __uint_as_float(((unsigned)h) << 16); }
__device__ __forceinline__ unsigned pk2(float lo, float hi) { return pg8::cvt_pk_bf16(lo, hi); }
__device__ __forceinline__ float bfe(const uint4& q, int e) { const unsigned w = (e < 2) ? q.x : (e < 4) ? q.y : (e < 6) ? q.z : q.w; return (e & 1) ? __uint_as_float(w & 0xffff0000u) : __uint_as_float(w << 16); }
__device__ __forceinline__ uint4 pack8(const float* v) { uint4 o; o.x = pk2(v[0], v[1]); o.y = pk2(v[2], v[3]); o.z = pk2(v[4], v[5]); o.w = pk2(v[6], v[7]); return o; }
__device__ __forceinline__ float wave_sum(float v) {
#pragma unroll
    for (int o = 1; o < 64; o <<= 1) v += __shfl_xor(v, o);
    return v;
}
__device__ __forceinline__ float fexp(float x) { return __expf(x); }
__device__ __forceinline__ float frcp(float x) { return __builtin_amdgcn_rcpf(x); }
__device__ __forceinline__ float sigmoidf_(float x) { return frcp(1.f + fexp(-x)); }
__device__ __forceinline__ float softplusf_(float z) { const float e = fexp(z); return z > 20.f ? z : (e < 1e-3f ? e * (1.f - 0.5f * e) : __logf(1.f + e)); }
__device__ __forceinline__ float ftanh(float x) { return 1.f - 2.f * frcp(1.f + fexp(2.f * x)); }
__device__ __forceinline__ float siluf_(float x) { return x * frcp(1.f + fexp(-x)); }
__device__ __forceinline__ float shx1(float v) { return __int_as_float(__builtin_amdgcn_ds_swizzle(__float_as_int(v), 0x041F)); }
__device__ __forceinline__ float shx2(float v) { return __int_as_float(__builtin_amdgcn_ds_swizzle(__float_as_int(v), 0x081F)); }
__device__ __forceinline__ float shx4(float v) { return __int_as_float(__builtin_amdgcn_ds_swizzle(__float_as_int(v), 0x101F)); }
typedef unsigned long long u64_t;
__device__ __forceinline__ void st_gran(u64_t* g, unsigned epoch, float v) { __hip_atomic_store(g, ((u64_t)epoch << 32) | (u64_t)__float_as_uint(v), __ATOMIC_RELAXED, __HIP_MEMORY_SCOPE_AGENT); }
template <int N>
__device__ __forceinline__ void recv_gran(const u64_t* g, unsigned epoch, float (&out)[N]) {
    unsigned spins = 0;
    for (;;) { bool ok = true;
#pragma unroll
        for (int k = 0; k < N; ++k) { const u64_t x = __hip_atomic_load(g + k * 512, __ATOMIC_RELAXED, __HIP_MEMORY_SCOPE_AGENT); out[k] = __uint_as_float((unsigned)x); ok = ok && ((unsigned)(x >> 32) == epoch); }
        if (ok || ++spins > (1u << 20)) break; __builtin_amdgcn_s_sleep(2); }
}
#define LDS_WAIT() asm volatile("s_waitcnt lgkmcnt(0)" ::: "memory")

__device__ __forceinline__ void mma_seg(f32x4& acc, const bf16_t* A, int lda, const bf16_t* Bt, int ldb, int tm, int tn, int ksteps, int fr, int fq) {
    const bf16_t* ap = A + (tm * 16 + fr) * lda + fq * 8; const bf16_t* bp = Bt + (tn * 16 + fr) * ldb + fq * 8;
    for (int ks = 0; ks < ksteps; ++ks) {
        const bf16x8 a = *(const bf16x8*)(ap + ks * 32); const bf16x8 b = *(const bf16x8*)(bp + ks * 32);
        acc = __builtin_amdgcn_mfma_f32_16x16x32_bf16(a, b, acc, 0, 0, 0);
    }
}
#define ZERO4 ((f32x4){0.f, 0.f, 0.f, 0.f})
__device__ __forceinline__ void st4bf(bf16_t* dst, float a, float b, float c, float d) { uint2 w; w.x = pk2(a, b); w.y = pk2(c, d); *(uint2*)dst = w; }
__device__ __forceinline__ void mma_seg_bs(f32x4& acc, const bf16_t* A, int lda, const bf16_t* Bt, int ldb, int tm, int tn, int ksteps, int fr, int fq, int g) {
    const bf16_t* ap = A + (tm * 16 + fr) * lda + fq * 8; const bf16_t* bp = Bt + (tn * 16 + fr) * ldb;
    for (int ks = 0; ks < ksteps; ++ks) {
        const bf16x8 a = *(const bf16x8*)(ap + ks * 32); const bf16x8 b = *(const bf16x8*)(bp + ((ks * 32 + fq * 8) ^ (g << 3)));
        acc = __builtin_amdgcn_mfma_f32_16x16x32_bf16(a, b, acc, 0, 0, 0);
    }
}

#define LAS __attribute__((address_space(3)))
#define XB_TMO      128
#define XB_XCNT(j)  (256  + 64 * (j))
#define XB_XSUB(j)  (1280 + 64 * (j))
#define XB_XGEN(j)  (2304 + 64 * (j))
#define XB_TOP      3328
#define XB_TOPGEN   3392
#define XCD_BAR_WORDS 3456
#define XB_SPIN_CAP (1u << 18)

__device__ __forceinline__ unsigned xb_ld(unsigned* p)              { return __hip_atomic_load(p, __ATOMIC_RELAXED, __HIP_MEMORY_SCOPE_AGENT); }
__device__ __forceinline__ unsigned xb_add(unsigned* p, unsigned v) { return __hip_atomic_fetch_add(p, v, __ATOMIC_RELAXED, __HIP_MEMORY_SCOPE_AGENT); }
__device__ __forceinline__ unsigned xb_xcc_id() { return (unsigned)__builtin_amdgcn_s_getreg((3 << 11) | 20) & 0xFu; }
#define XB_SPIN(cond, bar) do { unsigned _sp = 0; while (cond) { __builtin_amdgcn_s_sleep(1); \
    if ((++_sp & 255u) == 0u) { if (xb_ld(&(bar)[XB_TMO])) break; if (_sp > XB_SPIN_CAP) { atomicAdd(&(bar)[XB_TMO], 1u); break; } } } } while (0)

struct XcdBarrier {
    unsigned* bar; unsigned x;
    volatile LAS unsigned* st;
};

__device__ __forceinline__ XcdBarrier xcd_barrier_post(unsigned* bar, volatile LAS unsigned* st) {
    XcdBarrier b; b.bar = bar; b.x = xb_xcc_id(); b.st = st;
    if (threadIdx.x == 0) (void)xb_add(&bar[XB_XCNT(b.x)], 1u);
    return b;
}
__device__ __forceinline__ void xcd_barrier_complete(unsigned* bar, unsigned x, unsigned& nloc, unsigned& nx) {
    const unsigned G = gridDim.x * gridDim.y * gridDim.z;
    unsigned sum, cnt, mine, sp = 0u;
    for (;;) {
        sum = 0u; cnt = 0u; mine = 0u;
#pragma unroll
        for (unsigned j = 0; j < 16; ++j) { const unsigned c = xb_ld(&bar[XB_XCNT(j)]); sum += c; cnt += (c > 0u) ? 1u : 0u; mine = (j == x) ? c : mine; }
        if (sum == G) break;
        __builtin_amdgcn_s_sleep(1);
        if ((++sp & 255u) == 0u) { if (xb_ld(&bar[XB_TMO])) break; if (sp > XB_SPIN_CAP) { atomicAdd(&bar[XB_TMO], 1u); break; } }
    }
    nloc = mine > 0u ? mine : 1u; nx = cnt > 0u ? cnt : 1u;
}

__device__ __forceinline__ void xcd_barrier(const XcdBarrier& b) {
    asm volatile("s_waitcnt vmcnt(0)" ::: "memory");
    __syncthreads();
    if (threadIdx.x == 0) {
        unsigned* bar = b.bar;
        __builtin_amdgcn_s_waitcnt(0);
        unsigned nloc = b.st[0], nx = b.st[1];
        if (nloc == 0u) { xcd_barrier_complete(bar, b.x, nloc, nx); b.st[0] = nloc; b.st[1] = nx; }
        const unsigned old = xb_add(&bar[XB_XSUB(b.x)], 1u);
        const unsigned gen = old / nloc;
        if (old + 1u == (gen + 1u) * nloc) {
            __builtin_amdgcn_fence(__ATOMIC_RELEASE, "agent");
            asm volatile("s_waitcnt vmcnt(0)" ::: "memory");
            const unsigned og = xb_add(&bar[XB_TOP], 1u);
            const unsigned tg = og / nx;
            if (og + 1u == (tg + 1u) * nx) xb_add(&bar[XB_TOPGEN], 1u);
            else XB_SPIN(xb_ld(&bar[XB_TOPGEN]) == tg, bar);
            __builtin_amdgcn_fence(__ATOMIC_ACQUIRE, "agent");
            xb_add(&bar[XB_XGEN(b.x)], 1u);
            asm volatile("s_waitcnt vmcnt(0)" ::: "memory");
        } else {
            XB_SPIN(xb_ld(&bar[XB_XGEN(b.x)]) == gen, bar);
            __builtin_amdgcn_fence(__ATOMIC_ACQUIRE, "agent");
            asm volatile("s_waitcnt vmcnt(0)" ::: "memory");
        }
    }
    __syncthreads();
}

__device__ __forceinline__ void transpose_item(const float* W, int K, int N, int nlimit, bf16_t* WT, float* scr, int item, int lane) {
    const int nblk = (nlimit + 31) / 32, kb = item / nblk, nb = item % nblk, k0 = 64 * kb, n0 = 32 * nb;
    const int nn = n0 + (lane & 31); const bool ok = nn < nlimit;
    { float tv[32];
#pragma unroll
      for (int i = 0; i < 32; ++i) { const int kk = 2 * i + (lane >> 5); tv[i] = ok ? W[(size_t)(k0 + kk) * N + nn] : 0.f; }
#pragma unroll
      for (int i = 0; i < 32; ++i) { const int kk = 2 * i + (lane >> 5); scr[kk * 33 + (lane & 31)] = tv[i]; } }
    LDS_WAIT();
    const int c = lane & 7;
#pragma unroll
    for (int j = 0; j < 4; ++j) { const int n = (lane >> 3) + 8 * j; const float* s = scr + (8 * c) * 33 + n;
        uint4 o; o.x = pk2(s[0 * 33], s[1 * 33]); o.y = pk2(s[2 * 33], s[3 * 33]); o.z = pk2(s[4 * 33], s[5 * 33]); o.w = pk2(s[6 * 33], s[7 * 33]);
        if (n0 + n < nlimit) *(uint4*)(WT + (size_t)(n0 + n) * K + k0 + 8 * c) = o; }
    LDS_WAIT();
}

__device__ __forceinline__ void prep_phase(const Prm& p, unsigned char* lds, int tid, int G) {
    const int wave = tid >> 6, lane = tid & 63, bid = blockIdx.x;
    unsigned char* ws = p.ws;
    for (int it = bid; it < 448; it += G) {
        if (it < 192) {
            const int l = it / 96, j0 = (it % 96) * 64;
            float* SIL = (float*)lds; float* RED = SIL + 5 * 1024;
            for (int e = tid; e < 5120; e += 512) { const float cv = e < 4096 ? p.in[1][e] : p.in[3][e - 4096]; SIL[e] = cv / (1.f + expf(-cv)); }
            __syncthreads();
            float a0 = 0.f, a1 = 0.f, a2 = 0.f, a3 = 0.f, a4 = 0.f;
            const float* wm = p.in[6] + ((size_t)l * 1024 + wave * 128) * 6144 + j0 + lane;
            for (int k0 = 0; k0 < 128; k0 += 32) { float wv[32];
#pragma unroll
                for (int k = 0; k < 32; ++k) wv[k] = wm[(size_t)(k0 + k) * 6144];
#pragma unroll
                for (int k = 0; k < 32; ++k) { const float w = wv[k]; const int kk = wave * 128 + k0 + k;
                    a0 += SIL[kk] * w; a1 += SIL[1024 + kk] * w; a2 += SIL[2048 + kk] * w; a3 += SIL[3072 + kk] * w; a4 += SIL[4096 + kk] * w; } }
            RED[(wave * 5 + 0) * 64 + lane] = a0; RED[(wave * 5 + 1) * 64 + lane] = a1; RED[(wave * 5 + 2) * 64 + lane] = a2; RED[(wave * 5 + 3) * 64 + lane] = a3; RED[(wave * 5 + 4) * 64 + lane] = a4;
            __syncthreads();
            if (tid < 320) { const int bb = tid >> 6, ln = tid & 63; float s = p.in[7][l * 6144 + j0 + ln];
                for (int w = 0; w < 8; ++w) s += RED[(w * 5 + bb) * 64 + ln];
                ((float*)(ws + WS_MOD))[(l * 5 + bb) * 6144 + j0 + ln] = s; }
            __syncthreads();
        } else {
            const int f = it - 192; const int l = f >> 7, g = (f >> 5) & 3, part = (f >> 4) & 1, kc = f & 15;
            float* PP = (float*)lds; float* WCH = PP + 64 * 65; float* WF = WCH + 64 * 65; float* TB = WF + 64 * 65;
            for (int e = tid; e < 4096; e += 512) { const int r = e >> 6, c = e & 63;
                WF[r * 65 + c] = p.in[25][((size_t)(l * 4 + g) * 64 + r) * 64 + c];
                WCH[r * 65 + c] = p.in[8][((size_t)l * 1024 + kc * 64 + r) * WIN_N + NPLAIN + g * 64 + c]; }
            if (tid < 64) { float s, c; sincospif((float)tid / 32.f, &s, &c); TB[tid] = 0.125f * (part ? -s : c); }
            __syncthreads();
            { const int c = tid >> 3, d0 = (tid & 7) * 8; float acc[8];
#pragma unroll
              for (int e = 0; e < 8; ++e) acc[e] = 0.f;
              for (int c2 = 0; c2 < 64; ++c2) { const float tb = TB[(c * c2) & 63];
#pragma unroll
                  for (int e = 0; e < 8; ++e) acc[e] += tb * WF[c2 * 65 + d0 + e]; }
#pragma unroll
              for (int e = 0; e < 8; ++e) PP[c * 65 + d0 + e] = acc[e]; }
            __syncthreads();
            { const int d = tid >> 3, ko = tid & 7; float acc[8];
#pragma unroll
              for (int e = 0; e < 8; ++e) acc[e] = 0.f;
              for (int c = 0; c < 64; ++c) { const float pv = PP[c * 65 + d];
#pragma unroll
                  for (int e = 0; e < 8; ++e) acc[e] += WCH[(ko * 8 + e) * 65 + c] * pv; }
              bf16_t* wt = (bf16_t*)(ws + WS_WIN) + ((size_t)l * LDU + C_FZ + part * 256 + g * 64 + d) * 1024 + kc * 64 + ko * 8;
              *(uint4*)wt = pack8(acc); }
            __syncthreads();
        }
    }
    { const int gt = bid * 512 + tid, NG = G * 512; const uint4 z = {0u, 0u, 0u, 0u};
      for (int e = gt; e < 2 * 112 * 128; e += NG) { const int l = e / (112 * 128), r = e % (112 * 128);
          *(uint4*)((bf16_t*)(ws + WS_WIN) + ((size_t)l * LDU + 3472) * 1024 + (size_t)r * 8) = z; } }
    if (bid == 0) { const uint4 z = {0u, 0u, 0u, 0u}; for (int e = tid; e < 16384 / 16; e += 512) *(uint4*)(ws + WS_BARW + (size_t)e * 16) = z; }
    { const int gt = bid * 512 + tid, NG = G * 512; const uint4 z = {0u, 0u, 0u, 0u};
      for (int e = gt; e < (int)((WS_ZEND - WS_SBR) / 16); e += NG) *(uint4*)(ws + WS_SBR + (size_t)e * 16) = z; }
    float* scr = (float*)(lds + wave * 8448);
    const int gw = bid * 8 + wave, NGW = G * 8;
    for (int it = gw; it < 2 * 6096; it += NGW) {
        const int l = it / 6096; int r = it % 6096;
        if (r < 1488) { transpose_item(p.in[8] + (size_t)l * 1024 * WIN_N, 1024, WIN_N, NPLAIN, (bf16_t*)(ws + WS_WIN) + (size_t)l * LDU * 1024, scr, r, lane); continue; } r -= 1488;
        if (r < 512) { transpose_item(p.in[9] + (size_t)l * 1024 * 1024, 1024, 1024, 1024, (bf16_t*)(ws + WS_WOUT) + (size_t)l * 1024 * 1024, scr, r, lane); continue; } r -= 512;
        if (r < 2048) { transpose_item(p.in[26] + (size_t)l * 1024 * 4096, 1024, 4096, 4096, (bf16_t*)(ws + WS_W1) + (size_t)l * 4096 * 1024, scr, r, lane); continue; } r -= 2048;
        transpose_item(p.in[27] + (size_t)l * 4096 * 1024, 4096, 1024, 1024, (bf16_t*)(ws + WS_W2) + (size_t)l * 1024 * 4096, scr, r, lane);
    }
    __syncthreads();
}

__device__ __forceinline__ void bias_items(const Prm& p, int tid, int G) {
    const int wave = tid >> 6, lane = tid & 63; const int gw = blockIdx.x * 8 + wave, NGW = G * 8;
    float* BI = (float*)(p.ws + WS_BIAS);
    for (int it = gw; it < 3584 + 4096 + 4096; it += NGW) {
        int s, n; if (it < 3584) { s = 0; n = it; } else if (it < 3584 + 4096) { s = 1; n = it - 3584; } else { s = 2; n = it - 3584 - 4096; }
        const int l = (s == 1) ? 0 : 1; const int slot = (s == 0) ? 0 : 3; const int N = (s == 0) ? 3584 : 4096;
        const bf16_t* wt = (s == 0) ? (const bf16_t*)(p.ws + WS_WIN) + ((size_t)LDU + n) * 1024 : (const bf16_t*)(p.ws + WS_W1) + ((size_t)l * 4096 + n) * 1024;
        float* out = BI + (s == 0 ? 0 : (s == 1 ? 5 * 3584 : 5 * 3584 + 5 * 4096));
        const float* modl = (const float*)(p.ws + WS_MOD) + (size_t)l * 5 * 6144 + slot * 1024;
        const uint4 w0 = *(const uint4*)(wt + lane * 16), w1 = *(const uint4*)(wt + lane * 16 + 8);
        float wv[16];
#pragma unroll
        for (int e = 0; e < 8; ++e) { wv[e] = bfe(w0, e); wv[8 + e] = bfe(w1, e); }
#pragma unroll
        for (int bb = 0; bb < 5; ++bb) { const float* sh = modl + bb * 6144 + lane * 16; float a = 0.f;
#pragma unroll
            for (int e4 = 0; e4 < 4; ++e4) { const f32x4 sv = *(const f32x4*)(sh + e4 * 4); a += (sv[0] * wv[e4 * 4] + sv[1] * wv[e4 * 4 + 1]) + (sv[2] * wv[e4 * 4 + 2] + sv[3] * wv[e4 * 4 + 3]); }
            a = wave_sum(a); if (lane == 0) out[(size_t)bb * N + n] = a; }
    }
}

__device__ __forceinline__ void norm_phase(const Prm& p, int l, int mode, int tid, int G) {
    const int wave = tid >> 6, lane = tid & 63; const int gw = blockIdx.x * 8 + wave, NGW = G * 8;
    const int nrows = (mode == 2 || (mode == 1 && l == 1)) ? ML : M;
    const float* gvec = mode == 2 ? p.in[28] : (mode == 1 ? p.in[5] + l * 1024 : p.in[4] + l * 1024);
    const float* modb = (const float*)(p.ws + WS_MOD) + (size_t)l * 5 * 6144;
    bf16_t* HN = (bf16_t*)(p.ws + WS_HN);
    const bool first = (l == 0 && mode == 0);
    for (int row = gw; row < nrows; row += NGW) {
        const bool lat = row < ML; const int bb = lat ? (row >> 13) : 4;
        const float* src = lat ? ((first ? p.in[0] : p.out) + (size_t)row * 1024) : ((first ? p.in[2] : (const float*)(p.ws + WS_XC)) + (size_t)(row - ML) * 1024);
        f32x4 v[4]; float ss = 0.f;
#pragma unroll
        for (int j = 0; j < 4; ++j) { v[j] = *(const f32x4*)(src + j * 256 + lane * 4); ss += (v[j][0] * v[j][0] + v[j][1] * v[j][1]) + (v[j][2] * v[j][2] + v[j][3] * v[j][3]); }
        const float rinv = rsqrtf(wave_sum(ss) * (1.f / 1024.f) + 1e-6f);
        if (mode == 2) {
#pragma unroll
            for (int j = 0; j < 4; ++j) { const f32x4 g = *(const f32x4*)(gvec + j * 256 + lane * 4); *(f32x4*)(p.out + (size_t)row * 1024 + j * 256 + lane * 4) = v[j] * rinv * g; }
        } else {
            const float* sh = modb + bb * 6144 + (mode ? 3 : 0) * 1024; const float* sc = modb + bb * 6144 + (mode ? 4 : 1) * 1024;
#pragma unroll
            for (int j = 0; j < 4; ++j) { const int c = j * 256 + lane * 4; const f32x4 g = *(const f32x4*)(gvec + c), s1 = *(const f32x4*)(sh + c), s2 = *(const f32x4*)(sc + c);
                const f32x4 y = (v[j] * rinv * g) * (s2 + 1.f) + s1;
                uint2 o; o.x = pk2(y[0], y[1]); o.y = pk2(y[2], y[3]); *(uint2*)(HN + (size_t)row * 1024 + c) = o; }
        }
    }
}

__device__ __forceinline__ void lerp8(const bf16_t* U, size_t row, int col, bool isctx, int t, const float* mu, float* out) {
    const bf16_t* bp = U + row * LDU + col;
    const uint4 own = *(const uint4*)bp; const uint4 z = {0u, 0u, 0u, 0u};
    uint4 n0, n1, n2, n3;
    if (isctx) { n0 = (t > 0) ? *(const uint4*)(bp - LDU) : z; n1 = (t < TC - 1) ? *(const uint4*)(bp + LDU) : z; n2 = n0; n3 = n1; }
    else { const int gx = t & 63, gy = t >> 6;
        n0 = (gx > 0) ? *(const uint4*)(bp - LDU) : z; n1 = (gx < 63) ? *(const uint4*)(bp + LDU) : z;
        n2 = (gy > 0) ? *(const uint4*)(bp - 64 * LDU) : z; n3 = (gy < 127) ? *(const uint4*)(bp + 64 * LDU) : z; }
#pragma unroll
    for (int e = 0; e < 8; ++e) { const float o = bfe(own, e); const float nb = (e & 3) == 0 ? bfe(n0, e) : (e & 3) == 1 ? bfe(n1, e) : (e & 3) == 2 ? bfe(n2, e) : bfe(n3, e);
        out[e] = o + mu[e] * (nb - o); }
}

__device__ __forceinline__ void lerp8_load(const bf16_t* U, size_t row, int col, bool isctx, int t, uint4 (&r)[5]) {
    const bf16_t* bp = U + row * LDU + col; const uint4 z = {0u, 0u, 0u, 0u};
    r[0] = *(const uint4*)bp;
    if (isctx) { r[1] = (t > 0) ? *(const uint4*)(bp - LDU) : z; r[2] = (t < TC - 1) ? *(const uint4*)(bp + LDU) : z; r[3] = r[1]; r[4] = r[2]; }
    else { const int gx = t & 63, gy = t >> 6;
        r[1] = (gx > 0) ? *(const uint4*)(bp - LDU) : z; r[2] = (gx < 63) ? *(const uint4*)(bp + LDU) : z;
        r[3] = (gy > 0) ? *(const uint4*)(bp - 64 * LDU) : z; r[4] = (gy < 127) ? *(const uint4*)(bp + 64 * LDU) : z; }
}
__device__ __forceinline__ void lerp8_apply(const uint4 (&r)[5], const float* mu, float* out) {
#pragma unroll
    for (int e = 0; e < 8; ++e) { const float o = bfe(r[0], e); const float nb = (e & 3) == 0 ? bfe(r[1], e) : (e & 3) == 1 ? bfe(r[2], e) : (e & 3) == 2 ? bfe(r[3], e) : bfe(r[4], e);
        out[e] = o + mu[e] * (nb - o); }
}
__device__ __forceinline__ void chunk_coords(int c, int b, int d, int n, bool& isctx, int& t0, size_t& rowbase) {
    isctx = c < 4; const int cc = isctx ? c : c - 4; const int nch = isctx ? 4 : 128;
    t0 = (d ? (nch - 1 - cc) : cc) * 64; rowbase = isctx ? (size_t)(ML + b * TC + t0) : (size_t)(b * T + t0); (void)n;
}
__device__ __forceinline__ void gdn_raw_load(const bf16_t* U, int b, int h, int d, int c, int tid, uint4 (&rv)[7]) {
    const bool isctx = c < 4; const int cc = isctx ? c : c - 4; const int nch = isctx ? 4 : 128; const int slen = isctx ? TC : T;
    const int t0 = (d ? (nch - 1 - cc) : cc) * 64; const size_t seqbase = isctx ? (size_t)(ML + b * TC) : (size_t)(b * T);
#pragma unroll
    for (int it = 0; it < 7; ++it) { const int pc = tid + it * 512; const int rr = pc / 48, pi = pc % 48; const int tt = t0 - 2 + rr;
        const int col = pi < 16 ? C_GQ + h * 128 + pi * 8 : pi < 32 ? C_GK + h * 128 + (pi - 16) * 8 : C_GV + h * 128 + (pi - 32) * 8;
        rv[it] = (uint4){0u, 0u, 0u, 0u}; if (pc < 68 * 48 && tt >= 0 && tt < slen) rv[it] = *(const uint4*)(U + (seqbase + tt) * LDU + col); }
}

template <int MODE>
__device__ __forceinline__ void trinv64(const bf16_t* LA, const float* LD, bf16_t* TA, int ldt, bf16_t* TT, bf16_t* WT, bf16_t* T1, bf16_t* T2, const float* s1, const float* s2, int tid, int wave, int fr, int fq) {
    if (wave == 0) { const int bi = (tid & 63) >> 4, cc = tid & 15; const float* A = LD + bi * 256; float dcol[16];
#pragma unroll
        for (int r = 0; r < 16; ++r) { float v = (r == cc) ? 1.f : 0.f;
#pragma unroll
            for (int j = 0; j < r; ++j) v -= A[r * 16 + j] * dcol[j];
            dcol[r] = v; }
#pragma unroll
        for (int r = 0; r < 16; ++r) { const int R = bi * 16 + r, Cc = bi * 16 + cc; const bf16_t bv = f2bf(dcol[r]); TA[R * ldt + Cc] = bv; TT[Cc * 72 + R] = bv;
            if (MODE == 1) T1[R * 72 + Cc] = f2bf(dcol[r] * s1[Cc]); }
    } else { for (int e = tid - 64; e < 4096; e += 448) { const int r = e >> 6, c = e & 63; if ((r >> 4) != (c >> 4)) TT[r * 72 + c] = 0; WT[r * 72 + c] = 0; } }
    __syncthreads();
    if (wave < 2) { const int tm = 2 * wave + 1, tn = 2 * wave, ko = 32 * wave, r0 = tm * 16 + fq * 4, c = tn * 16 + fr;
        f32x4 acc = ZERO4; mma_seg(acc, LA + ko, 72, TT + ko, 72, tm, tn, 1, fr, fq);
#pragma unroll
        for (int j = 0; j < 4; ++j) WT[c * 72 + r0 + j] = f2bf(acc[j]); }
    __syncthreads();
    if (wave < 2) { const int tm = 2 * wave + 1, tn = 2 * wave, ko = 32 * wave, r0 = tm * 16 + fq * 4, c = tn * 16 + fr;
        f32x4 acc = ZERO4; mma_seg(acc, TA + ko, ldt, WT + ko, 72, tm, tn, 1, fr, fq);
#pragma unroll
        for (int j = 0; j < 4; ++j) { const float v = -acc[j]; const bf16_t bv = f2bf(v); TA[(r0 + j) * ldt + c] = bv; TT[c * 72 + r0 + j] = bv;
            if (MODE == 1) T1[(r0 + j) * 72 + c] = f2bf(v * s1[c]); } }
    __syncthreads();
    if (wave < 4) { const int tm = 2 + (wave >> 1), tn = wave & 1, r0 = tm * 16 + fq * 4, c = tn * 16 + fr;
        f32x4 acc = ZERO4; mma_seg(acc, LA, 72, TT, 72, tm, tn, 1, fr, fq);
#pragma unroll
        for (int j = 0; j < 4; ++j) WT[c * 72 + r0 + j] = f2bf(acc[j]); }
    __syncthreads();
    if (wave < 4) { const int tm = 2 + (wave >> 1), tn = wave & 1, r0 = tm * 16 + fq * 4, c = tn * 16 + fr;
        f32x4 acc = ZERO4; mma_seg(acc, TA + 32, ldt, WT + 32, 72, tm, tn, 1, fr, fq);
#pragma unroll
        for (int j = 0; j < 4; ++j) { const float v = -acc[j]; TA[(r0 + j) * ldt + c] = f2bf(v);
            if (MODE == 1) T1[(r0 + j) * 72 + c] = f2bf(v * s1[c]); } }
    __syncthreads();
}
__device__ __forceinline__ void rwkv_scan(const Prm& p, int l, int sid, int kblk, int nblk, unsigned char* lds, int tid) {
    const int b = sid >> 3, h = (sid >> 1) & 3, d = sid & 1;
    const int wave = tid >> 6, lane = tid & 63, fr = lane & 15, fq = lane >> 4;
    bf16_t* TL = (bf16_t*)lds;
#define RTILE(i) (TL + (i) * 4608)
    bf16_t *S0bf = RTILE(0), *KT = RTILE(1), *BTl = RTILE(2), *KL = RTILE(3), *KTt = RTILE(4), *RT = RTILE(5), *VT = RTILE(6), *BS = RTILE(7),
           *LK = RTILE(9), *MB = RTILE(10), *MK = RTILE(11), *LA = RTILE(14), *TT = RTILE(1), *WT = RTILE(2),
           *TW = RTILE(12), *X1T = RTILE(1), *PT = RTILE(2);
    float* XW = (float*)RTILE(9); float* XAf = XW + 64 * 65; bf16_t* TWD = (bf16_t*)(XAf + 64 * 65); bf16_t* ADl = TWD + 64 * 40;
    unsigned char* cb = lds + 15 * 9216;
    bf16_t* WUPt = (bf16_t*)cb; bf16_t* AUPt = WUPt + 64 * 40; float* CV = (float*)(cb + 10240); float* GL = CV + 320; float* SEG = GL + 64; float* LD = SEG + 512;
#undef RTILE
    const bf16_t* U = (const bf16_t*)(p.ws + WS_U);
    bf16_t* ORp = (bf16_t*)(p.ws + WS_OR); float* BC = (float*)(p.ws + WS_BC);
    const int n = tid >> 3, jq = tid & 7, j0 = jq * 8; const int i = d ? 63 - n : n;
    for (int e = tid; e < 2048; e += 512) { const int q = e >> 6, j = e & 63;
        WUPt[j * 40 + q] = f2bf(p.in[12][((size_t)(l * 2 + d) * 32 + q) * 256 + h * 64 + j]);
        AUPt[j * 40 + q] = f2bf(p.in[14][((size_t)(l * 2 + d) * 32 + q) * 256 + h * 64 + j]); }
    if (tid < 64) { CV[tid] = p.in[11][(l * 2 + d) * 256 + h * 64 + tid]; CV[64 + tid] = p.in[13][(l * 2 + d) * 256 + h * 64 + tid];
        CV[128 + tid] = p.in[16][l * 256 + h * 64 + tid]; CV[192 + tid] = p.in[17][l * 256 + h * 64 + tid]; CV[256 + tid] = p.in[18][l * 256 + h * 64 + tid]; }
    f32x4 accS[2]; accS[0] = ZERO4; accS[1] = ZERO4;
    u64_t* SB = (u64_t*)(p.ws + WS_SBR) + (size_t)sid * 2 * 4096; const unsigned fbase = (unsigned)l * 132u;
    float r8[8], k8[8], v8[8], x8[8];
    { const int n0_ = tid >> 3, j00 = (tid & 7) * 8; bool ic; int t0_; size_t rb_; chunk_coords(kblk, b, d, n0_, ic, t0_, rb_);
      uint4 q0[5], q1[5], q2[5], q3[5];
      lerp8_load(U, rb_ + n0_, h * 64 + j00, ic, t0_ + n0_, q0); lerp8_load(U, rb_ + n0_, 256 + h * 64 + j00, ic, t0_ + n0_, q1);
      lerp8_load(U, rb_ + n0_, 512 + h * 64 + j00, ic, t0_ + n0_, q2); lerp8_load(U, rb_ + n0_, 768 + j00, ic, t0_ + n0_, q3);
      float m0[8], m1[8], m2[8], m3[8]; const float* mup = p.in[10] + l * 896 + j00;
#pragma unroll
      for (int e = 0; e < 8; ++e) { m0[e] = mup[h * 64 + e]; m1[e] = mup[256 + h * 64 + e]; m2[e] = mup[512 + h * 64 + e]; m3[e] = mup[768 + e]; }
      lerp8_apply(q0, m0, r8); lerp8_apply(q1, m1, k8); lerp8_apply(q2, m2, v8); lerp8_apply(q3, m3, x8); }
    __syncthreads();
    for (int c = kblk; c < 132; c += nblk) {
        int tid2 = threadIdx.x; asm volatile("" : "+v"(tid2)); const int tid = tid2;
        const int wave = tid2 >> 6, lane = tid2 & 63, fr = tid2 & 15, fq = (tid2 >> 4) & 3, n = tid2 >> 3, jq = tid2 & 7;
        const int j0 = jq * 8; const int i = d ? 63 - n : n;
        const bool isctx = c < 4; const int cc = isctx ? c : c - 4; const int nch = isctx ? 4 : 128;
        const int t0 = (d ? (nch - 1 - cc) : cc) * 64;
        const size_t rowbase = isctx ? (size_t)(ML + b * TC + t0) : (size_t)(b * T + t0);
        const int t = t0 + n; const size_t row = rowbase + n;
        if (jq < 4) {
#pragma unroll
            for (int e = 0; e < 8; ++e) TWD[i * 40 + j0 + e] = f2bf(ftanh(x8[e]));
        } else {
#pragma unroll
            for (int e = 0; e < 8; ++e) ADl[i * 40 + j0 - 32 + e] = f2bf(x8[e]);
        }
        __syncthreads();
#pragma unroll
        for (int q = 0; q < 2; ++q) { const int tile = wave + 8 * q, tm = tile >> 2, tn = tile & 3, r0 = tm * 16 + fq * 4, cc2 = tn * 16 + fr;
            f32x4 a1 = ZERO4, a2 = ZERO4; mma_seg(a1, TWD, 40, WUPt, 40, tm, tn, 1, fr, fq); mma_seg(a2, ADl, 40, AUPt, 40, tm, tn, 1, fr, fq);
#pragma unroll
            for (int j = 0; j < 4; ++j) { XW[(r0 + j) * 65 + cc2] = a1[j]; XAf[(r0 + j) * 65 + cc2] = a2[j]; } }
        __syncthreads();
        float a8[8], kd8[8], kk8[8]; float ss = 0.f, bcp = 0.f;
#pragma unroll
        for (int e = 0; e < 8; ++e) { const int j = j0 + e; const float xw = XW[i * 65 + j] + CV[j], xa = XAf[i * 65 + j] + CV[64 + j];
            const float a = sigmoidf_(xa); const float wl = -softplusf_(-xw) - 0.5f; const float lw = -fexp(wl);
            const float kd = k8[e] * (1.f + (a - 1.f) * CV[192 + j]); const float kkr = k8[e] * CV[128 + j];
            ss += kkr * kkr; bcp += r8[e] * kd * CV[256 + j]; a8[e] = a; kd8[e] = kd; kk8[e] = kkr; XW[i * 65 + j] = lw; }
        ss += shx1(ss); ss += shx2(ss); ss += shx4(ss);
        bcp += shx1(bcp); bcp += shx2(bcp); bcp += shx4(bcp);
        { const float rn = rsqrtf(ss + 1e-12f);
#pragma unroll
          for (int e = 0; e < 8; ++e) kk8[e] *= rn; }
        if (jq == 0) BC[((size_t)d * M + row) * 4 + h] = bcp;
        __syncthreads();
        { const int sg = tid >> 6, j = tid & 63; float s = 0.f;
#pragma unroll
          for (int ii = 0; ii < 8; ++ii) s += XW[(sg * 8 + ii) * 65 + j];
          SEG[sg * 64 + j] = s;
          __syncthreads();
          float pre = 0.f; for (int s2 = 0; s2 < sg; ++s2) pre += SEG[s2 * 64 + j];
#pragma unroll
          for (int ii = 0; ii < 8; ++ii) { pre += XW[(sg * 8 + ii) * 65 + j]; XW[(sg * 8 + ii) * 65 + j] = pre; } }
        __syncthreads();
        { float o_kt[8], o_bt[8], o_kl[8], o_rt[8];
#pragma unroll
          for (int e = 0; e < 8; ++e) { const int j = j0 + e; const float lwi = XW[i * 65 + j], lwm = i > 0 ? XW[(i - 1) * 65 + j] : 0.f, lwl = XW[63 * 65 + j];
              const float em = fexp(lwm), ei = fexp(lwi), eni = fexp(-lwi), el = fexp(lwl - lwi); const float b_ = kk8[e] * a8[e];
              o_kt[e] = kk8[e] * em; o_bt[e] = b_ * eni; o_kl[e] = kd8[e] * eni; o_rt[e] = r8[e] * ei;
              KTt[j * 72 + i] = f2bf(o_kt[e]); BS[j * 136 + i] = f2bf(b_ * el); BS[j * 136 + 64 + i] = f2bf(kd8[e] * el); VT[j * 72 + i] = f2bf(v8[e]);
              if (i == 63) GL[j] = ei; }
          *(uint4*)(KT + i * 72 + j0) = pack8(o_kt); *(uint4*)(BTl + i * 72 + j0) = pack8(o_bt); *(uint4*)(KL + i * 72 + j0) = pack8(o_kl); *(uint4*)(RT + i * 72 + j0) = pack8(o_rt); }
        __syncthreads();
        const int cn = c + nblk; const bool have_next = cn < 132;
        uint4 pq0[5], pq1[5], pq2[5], pq3[5];
        if (have_next) { bool ic; int t0n; size_t rbn; chunk_coords(cn, b, d, n, ic, t0n, rbn);
            lerp8_load(U, rbn + n, h * 64 + j0, ic, t0n + n, pq0); lerp8_load(U, rbn + n, 256 + h * 64 + j0, ic, t0n + n, pq1);
            lerp8_load(U, rbn + n, 512 + h * 64 + j0, ic, t0n + n, pq2); lerp8_load(U, rbn + n, 768 + j0, ic, t0n + n, pq3); }
        { const uint4 z4 = {0u, 0u, 0u, 0u}; *(uint4*)(TW + (tid >> 3) * 136 + (tid & 7) * 8) = z4; }
#pragma unroll
        for (int q = 0; q < 2; ++q) { const int tile = wave + 8 * q, tm = tile >> 2, tn = tile & 3, r0 = tm * 16 + fq * 4, cx = tn * 16 + fr;
            f32x4 a1 = ZERO4, a2 = ZERO4, a3 = ZERO4, a4 = ZERO4;
            { const int ao = (tm * 16 + fr) * 72 + fq * 8, bo = (tn * 16 + fr) * 72 + fq * 8;
#pragma unroll
              for (int ks = 0; ks < 2; ++ks) { const bf16x8 fk = *(const bf16x8*)(KT + ao + ks * 32), fr_ = *(const bf16x8*)(RT + ao + ks * 32), fb = *(const bf16x8*)(BTl + bo + ks * 32), fl = *(const bf16x8*)(KL + bo + ks * 32);
                  a1 = __builtin_amdgcn_mfma_f32_16x16x32_bf16(fk, fb, a1, 0, 0, 0); a2 = __builtin_amdgcn_mfma_f32_16x16x32_bf16(fk, fl, a2, 0, 0, 0);
                  a3 = __builtin_amdgcn_mfma_f32_16x16x32_bf16(fr_, fb, a3, 0, 0, 0); a4 = __builtin_amdgcn_mfma_f32_16x16x32_bf16(fr_, fl, a4, 0, 0, 0); } }
#pragma unroll
            for (int j = 0; j < 4; ++j) { const int r = r0 + j; const float x0 = (cx < r) ? a1[j] : 0.f;
                LA[r * 72 + cx] = f2bf(x0); if (tm == tn) LD[tm * 256 + (r & 15) * 16 + (cx & 15)] = x0;
                LK[r * 72 + cx] = f2bf(cx < r ? a2[j] : 0.f); MB[r * 72 + cx] = f2bf(cx <= r ? a3[j] : 0.f); MK[r * 72 + cx] = f2bf(cx <= r ? a4[j] : 0.f); } }
        __syncthreads();
        trinv64<0>(LA, LD, TW, 136, TT, WT, nullptr, nullptr, nullptr, nullptr, tid, wave, fr, fq);
        f32x4 accO[2];
#pragma unroll
        for (int q = 0; q < 2; ++q) { const int tile = wave + 8 * q, tm = tile >> 2, tn = tile & 3, r0 = tm * 16 + fq * 4, cx = tn * 16 + fr;
            f32x4 a1 = ZERO4, a2 = ZERO4; mma_seg(a1, TW, 136, KTt, 72, tm, tn, 2, fr, fq); mma_seg(a2, LK, 72, VT, 72, tm, tn, 2, fr, fq);
#pragma unroll
            for (int j = 0; j < 4; ++j) TW[(r0 + j) * 136 + 64 + cx] = f2bf(a1[j]);
            st4bf(X1T + cx * 72 + r0, a2[0], a2[1], a2[2], a2[3]);
            accO[q] = ZERO4; mma_seg(accO[q], MK, 72, VT, 72, tm, tn, 2, fr, fq); }
        if (have_next) { float m0[8], m1[8], m2[8], m3[8]; const float* mup = p.in[10] + l * 896 + j0;
#pragma unroll
            for (int e = 0; e < 8; ++e) { m0[e] = mup[h * 64 + e]; m1[e] = mup[256 + h * 64 + e]; m2[e] = mup[512 + h * 64 + e]; m3[e] = mup[768 + e]; }
            lerp8_apply(pq0, m0, r8); lerp8_apply(pq1, m1, k8); lerp8_apply(pq2, m2, v8); lerp8_apply(pq3, m3, x8); }
        if (c > 0) { float sv[8]; recv_gran<8>(SB + (c & 1) * 4096 + tid, fbase + (unsigned)c, sv);
#pragma unroll
            for (int q = 0; q < 2; ++q)
#pragma unroll
                for (int j = 0; j < 4; ++j) accS[q][j] = sv[q * 4 + j];
        } else { accS[0] = ZERO4; accS[1] = ZERO4; }
#pragma unroll
        for (int q = 0; q < 2; ++q) { const int tile = wave + 8 * q, tm = tile >> 2, tn = tile & 3;
#pragma unroll
            for (int j = 0; j < 4; ++j) S0bf[(tm * 16 + fq * 4 + j) * 72 + tn * 16 + fr] = f2bf(accS[q][j]); }
        __syncthreads();
#pragma unroll
        for (int q = 0; q < 2; ++q) { const int tile = wave + 8 * q, tm = tile >> 2, tn = tile & 3, r0 = tm * 16 + fq * 4, cx = tn * 16 + fr;
            f32x4 a1 = ZERO4; mma_seg(a1, TW, 136, X1T, 72, tm, tn, 2, fr, fq); mma_seg(a1, TW + 64, 136, S0bf, 72, tm, tn, 2, fr, fq);
            st4bf(PT + cx * 72 + r0, -a1[0], -a1[1], -a1[2], -a1[3]); }
        __syncthreads();
        { u64_t* sbn = SB + ((c + 1) & 1) * 4096; const unsigned ep = fbase + (unsigned)c + 1u;
#pragma unroll
          for (int q = 0; q < 2; ++q) { const int tile = wave + 8 * q, tm = tile >> 2, tn = tile & 3, cx = tn * 16 + fr;
              const float g = GL[cx]; accS[q] = accS[q] * g;
              mma_seg(accS[q], PT, 72, BS, 136, tm, tn, 2, fr, fq); mma_seg(accS[q], VT, 72, BS + 64, 136, tm, tn, 2, fr, fq);
#pragma unroll
              for (int j = 0; j < 4; ++j) st_gran(sbn + (q * 4 + j) * 512 + tid, ep, accS[q][j]); } }
#pragma unroll
        for (int q = 0; q < 2; ++q) { const int tile = wave + 8 * q, tm = tile >> 2, tn = tile & 3, r0 = tm * 16 + fq * 4, cx = tn * 16 + fr;
            mma_seg(accO[q], RT, 72, S0bf, 72, tm, tn, 2, fr, fq); mma_seg(accO[q], MB, 72, PT, 72, tm, tn, 2, fr, fq);
#pragma unroll
            for (int j = 0; j < 4; ++j) { const int tt = r0 + j; const int nn = d ? 63 - tt : tt;
                ORp[((size_t)d * M + rowbase + nn) * 256 + h * 64 + cx] = f2bf(accO[q][j]); } }
        __syncthreads();
    }
}

__device__ __forceinline__ void gdn_scan(const Prm& p, int l, int sid, int kblk, int nblk, unsigned char* lds, int tid) {
    const int b = sid >> 3, h = (sid >> 1) & 3, d = sid & 1;
    bf16_t* STbf = (bf16_t*)lds; bf16_t* Qn = (bf16_t*)(lds + 17408); bf16_t* KNt = (bf16_t*)(lds + 34816); bf16_t* VT = (bf16_t*)(lds + 53248); bf16_t* QKd = (bf16_t*)(lds + 71680);
    bf16_t* XP = (bf16_t*)(lds + 80896);
    bf16_t *LA = XP, *TT = XP + 4608, *WT = XP + 2 * 4608, *TA = XP + 3 * 4608, *T1 = XP + 4 * 4608;
    bf16_t *VNt = LA, *VNs = TT, *RAW = QKd;
    bf16_t* KN = (bf16_t*)(lds + 126976); bf16_t* Wm = KN;
    float* GLs = (float*)(lds + 144384); float* GC = GLs + 64; float* BETA = GC + 64; float* SC1 = BETA + 64; float* CW = SC1 + 64; float* LD = CW + 1920;
    const bf16_t* U = (const bf16_t*)(p.ws + WS_U); bf16_t* OGp = (bf16_t*)(p.ws + WS_OG);
    for (int e = tid; e < 1920; e += 512) { const int tap = e / 384, cc = e % 384;
        const int ch = cc < 128 ? h * 128 + cc : cc < 256 ? 512 + h * 128 + (cc - 128) : 1024 + h * 128 + (cc - 256);
        CW[e] = p.in[21][((size_t)l * 5 + tap) * 1536 + ch]; }
    const float a_exp = fexp(p.in[22][(l * 2 + d) * 4 + h]); const float dtb = p.in[23][(l * 2 + d) * 4 + h];
    f32x4 accS[8];
#pragma unroll
    for (int q = 0; q < 8; ++q) accS[q] = ZERO4;
    u64_t* SB = (u64_t*)(p.ws + WS_SBG) + (size_t)sid * 2 * 16384; const unsigned fbase = (unsigned)l * 132u;
    uint4 rv[7]; gdn_raw_load(U, b, h, d, kblk, tid, rv);
    __syncthreads();
    for (int c = kblk; c < 132; c += nblk) {
        int tid2 = threadIdx.x; asm volatile("" : "+v"(tid2)); const int tid = tid2;
        const int wave = tid2 >> 6, lane = tid2 & 63, fr = tid2 & 15, fq = (tid2 >> 4) & 3, n = tid2 >> 3, jq = tid2 & 7;
        const int i = d ? 63 - n : n;
        const bool isctx = c < 4; const int cc = isctx ? c : c - 4; const int nch = isctx ? 4 : 128; const int slen = isctx ? TC : T;
        const int t0 = (d ? (nch - 1 - cc) : cc) * 64;
        const size_t seqbase = isctx ? (size_t)(ML + b * TC) : (size_t)(b * T);
        const size_t rowbase = seqbase + t0;
#pragma unroll
        for (int it = 0; it < 7; ++it) { const int pc = tid + it * 512; const int rr = pc / 48, pi = pc % 48; if (pc < 68 * 48) *(uint4*)(RAW + rr * 392 + pi * 8) = rv[it]; }
        __syncthreads();
        { float qv[16];
          const bf16_t* up = U + (rowbase + n) * LDU + C_GS; const float beta_n = sigmoidf_(bf2f(up[d * 4 + h]));
#pragma unroll
          for (int e = 0; e < 16; ++e) qv[e] = 0.f;
#pragma unroll
          for (int tap = 0; tap < 5; ++tap) { const uint4 r0 = *(const uint4*)(RAW + (n + tap) * 392 + jq * 16), r1 = *(const uint4*)(RAW + (n + tap) * 392 + jq * 16 + 8);
              const float* cw = CW + tap * 384 + jq * 16;
#pragma unroll
              for (int e = 0; e < 8; ++e) { qv[e] += cw[e] * bfe(r0, e); qv[8 + e] += cw[8 + e] * bfe(r1, e); } }
          float sq = 0.f;
#pragma unroll
          for (int e = 0; e < 16; ++e) { const float a = siluf_(qv[e]); qv[e] = a; sq += a * a; }
          sq += shx1(sq); sq += shx2(sq); sq += shx4(sq);
          { const float rq = rsqrtf(sq + 1e-6f) * 0.08838834764831845f;
#pragma unroll
            for (int e = 0; e < 16; ++e) qv[e] *= rq; }
          *(uint4*)(Qn + i * 136 + jq * 16) = pack8(qv); *(uint4*)(Qn + i * 136 + jq * 16 + 8) = pack8(qv + 8);
          __builtin_amdgcn_sched_barrier(0);
#pragma unroll
          for (int e = 0; e < 16; ++e) qv[e] = 0.f;
#pragma unroll
          for (int tap = 0; tap < 5; ++tap) { const uint4 r0 = *(const uint4*)(RAW + (n + tap) * 392 + 128 + jq * 16), r1 = *(const uint4*)(RAW + (n + tap) * 392 + 128 + jq * 16 + 8);
              const float* cw = CW + tap * 384 + 128 + jq * 16;
#pragma unroll
              for (int e = 0; e < 8; ++e) { qv[e] += cw[e] * bfe(r0, e); qv[8 + e] += cw[8 + e] * bfe(r1, e); } }
          float sk = 0.f;
#pragma unroll
          for (int e = 0; e < 16; ++e) { const float a = siluf_(qv[e]); qv[e] = a; sk += a * a; }
          sk += shx1(sk); sk += shx2(sk); sk += shx4(sk);
          { const float rk = rsqrtf(sk + 1e-6f);
#pragma unroll
            for (int e = 0; e < 16; ++e) { qv[e] *= rk; KNt[(jq * 16 + e) * 72 + (i ^ (jq << 3))] = f2bf(qv[e]); } }
          *(uint4*)(KN + i * 136 + jq * 16) = pack8(qv); *(uint4*)(KN + i * 136 + jq * 16 + 8) = pack8(qv + 8);
          __builtin_amdgcn_sched_barrier(0);
#pragma unroll
          for (int e = 0; e < 16; ++e) qv[e] = 0.f;
#pragma unroll
          for (int tap = 0; tap < 5; ++tap) { const uint4 r0 = *(const uint4*)(RAW + (n + tap) * 392 + 256 + jq * 16), r1 = *(const uint4*)(RAW + (n + tap) * 392 + 256 + jq * 16 + 8);
              const float* cw = CW + tap * 384 + 256 + jq * 16;
#pragma unroll
              for (int e = 0; e < 8; ++e) { qv[e] += cw[e] * bfe(r0, e); qv[8 + e] += cw[8 + e] * bfe(r1, e); } }
#pragma unroll
          for (int e = 0; e < 16; ++e) VT[(jq * 16 + e) * 72 + (i ^ (jq << 3))] = f2bf(siluf_(qv[e]) * beta_n);
          if (jq == 0) { const float sa = bf2f(up[8 + d * 4 + h]); BETA[i] = beta_n; GLs[i] = -a_exp * softplusf_(sa + dtb); } }
        __syncthreads();
        if (wave == 0) { float x = GLs[lane];
#pragma unroll
            for (int o = 1; o < 64; o <<= 1) { const float y = __int_as_float(__builtin_amdgcn_ds_bpermute((lane - o) << 2, __float_as_int(x))); if (lane >= o) x += y; }
            GC[lane] = x; SC1[lane] = BETA[lane] * fexp(x); }
        __syncthreads();
        if (c + nblk < 132) gdn_raw_load(U, b, h, d, c + nblk, tid, rv);
        { const uint4 z4 = {0u, 0u, 0u, 0u}; *(uint4*)(TA + (tid >> 3) * 72 + (tid & 7) * 8) = z4; *(uint4*)(T1 + (tid >> 3) * 72 + (tid & 7) * 8) = z4; }
#pragma unroll
        for (int q = 0; q < 2; ++q) { const int tix = wave + 8 * q, tm = tix >> 2, tn = tix & 3, r0 = tm * 16 + fq * 4, cx = tn * 16 + fr;
            f32x4 a1 = ZERO4, a2 = ZERO4;
            const bf16_t* bp = KN + (tn * 16 + fr) * 136 + fq * 8; const bf16_t* ap1 = KN + (tm * 16 + fr) * 136 + fq * 8; const bf16_t* ap2 = Qn + (tm * 16 + fr) * 136 + fq * 8;
#pragma unroll
            for (int ks = 0; ks < 4; ++ks) { const bf16x8 bfr = *(const bf16x8*)(bp + ks * 32);
                a1 = __builtin_amdgcn_mfma_f32_16x16x32_bf16(*(const bf16x8*)(ap1 + ks * 32), bfr, a1, 0, 0, 0);
                a2 = __builtin_amdgcn_mfma_f32_16x16x32_bf16(*(const bf16x8*)(ap2 + ks * 32), bfr, a2, 0, 0, 0); }
#pragma unroll
            for (int j = 0; j < 4; ++j) { const int r = r0 + j; const float dec = fexp(GC[r] - GC[cx]); const float x0 = (cx < r) ? a1[j] * BETA[r] * dec : 0.f;
                LA[r * 72 + cx] = f2bf(x0); if (tm == tn) LD[tm * 256 + (r & 15) * 16 + (cx & 15)] = x0;
                QKd[r * 72 + cx] = f2bf((cx <= r) ? a2[j] * dec : 0.f); } }
        __syncthreads();
        trinv64<1>(LA, LD, TA, 72, TT, WT, T1, nullptr, SC1, nullptr, tid, wave, fr, fq);
        { const bf16_t* bp = KNt + (wave * 16 + fr) * 72;
          const bf16x8 b0 = *(const bf16x8*)(bp + ((fq * 8) ^ (wave << 3))), b1 = *(const bf16x8*)(bp + ((32 + fq * 8) ^ (wave << 3)));
#pragma unroll
          for (int q = 0; q < 4; ++q) { const bf16_t* ap = T1 + (q * 16 + fr) * 72 + fq * 8; f32x4 a1 = ZERO4;
              a1 = __builtin_amdgcn_mfma_f32_16x16x32_bf16(*(const bf16x8*)ap, b0, a1, 0, 0, 0); a1 = __builtin_amdgcn_mfma_f32_16x16x32_bf16(*(const bf16x8*)(ap + 32), b1, a1, 0, 0, 0);
#pragma unroll
              for (int j = 0; j < 4; ++j) Wm[(q * 16 + fq * 4 + j) * 136 + wave * 16 + fr] = f2bf(-a1[j]); } }
        const float gl63 = GC[63]; const float eg = fexp(gl63);
        u64_t* sbn = SB + ((c + 1) & 1) * 16384; const unsigned ep = fbase + (unsigned)c + 1u;
#pragma unroll
        for (int vh = 0; vh < 2; ++vh) {
            if (c > 0) { float sv[16]; recv_gran<16>(SB + (c & 1) * 16384 + (vh * 16) * 512 + tid, fbase + (unsigned)c, sv);
#pragma unroll
                for (int q = 0; q < 4; ++q)
#pragma unroll
                    for (int j = 0; j < 4; ++j) accS[vh * 4 + q][j] = sv[q * 4 + j];
            } else {
#pragma unroll
                for (int q = 0; q < 4; ++q) accS[vh * 4 + q] = ZERO4; }
#pragma unroll
            for (int q = 0; q < 4; ++q) { const int tile = wave + 8 * q, tm = tile >> 3, tn = tile & 7;
#pragma unroll
                for (int j = 0; j < 4; ++j) STbf[(tm * 16 + fq * 4 + j) * 136 + tn * 16 + fr] = f2bf(accS[vh * 4 + q][j]); }
            __syncthreads();
#pragma unroll
            for (int q2 = 0; q2 < 2; ++q2) { const int tile = wave + 8 * q2, tm = tile >> 2, tn = tile & 3, r0 = tm * 16 + fq * 4, cx = tn * 16 + fr;
                f32x4 au = ZERO4; mma_seg_bs(au, TA, 72, VT + (vh * 64) * 72, 72, tm, tn, 2, fr, fq, (vh * 4 + tn) & 7);
                mma_seg(au, Wm, 136, STbf, 136, tm, tn, 4, fr, fq);
                st4bf(VNt + cx * 72 + r0, au[0], au[1], au[2], au[3]);
                st4bf(VNs + cx * 72 + r0, au[0] * fexp(gl63 - GC[r0]), au[1] * fexp(gl63 - GC[r0 + 1]), au[2] * fexp(gl63 - GC[r0 + 2]), au[3] * fexp(gl63 - GC[r0 + 3])); }
            __syncthreads();
            { const bf16_t* bp = KNt + (wave * 16 + fr) * 72;
              const bf16x8 b0 = *(const bf16x8*)(bp + ((fq * 8) ^ (wave << 3))), b1 = *(const bf16x8*)(bp + ((32 + fq * 8) ^ (wave << 3)));
#pragma unroll
              for (int q = 0; q < 4; ++q) { const bf16_t* ap = VNs + (q * 16 + fr) * 72 + fq * 8; f32x4 a1 = accS[vh * 4 + q] * eg;
                  a1 = __builtin_amdgcn_mfma_f32_16x16x32_bf16(*(const bf16x8*)ap, b0, a1, 0, 0, 0); a1 = __builtin_amdgcn_mfma_f32_16x16x32_bf16(*(const bf16x8*)(ap + 32), b1, a1, 0, 0, 0);
                  accS[vh * 4 + q] = a1;
#pragma unroll
                  for (int j = 0; j < 4; ++j) st_gran(sbn + ((vh * 4 + q) * 4 + j) * 512 + tid, ep, a1[j]); } }
#pragma unroll
            for (int q2 = 0; q2 < 2; ++q2) { const int tile = wave + 8 * q2, tm = tile >> 2, tn = tile & 3, r0 = tm * 16 + fq * 4, cx = tn * 16 + fr;
                f32x4 a1 = ZERO4, a2 = ZERO4; mma_seg(a1, Qn, 136, STbf, 136, tm, tn, 4, fr, fq); mma_seg(a2, QKd, 72, VNt, 72, tm, tn, 2, fr, fq);
#pragma unroll
                for (int j = 0; j < 4; ++j) { const int tt = r0 + j; const int nn = d ? 63 - tt : tt; const float o = fexp(GC[tt]) * a1[j] + a2[j];
                    OGp[((size_t)d * M + rowbase + nn) * 512 + h * 128 + vh * 64 + cx] = f2bf(o); } }
            __syncthreads();
        }
    }
}
__device__ __forceinline__ void fft1_item(const Prm& p, int item, unsigned char* lds, int tid) {
    const int b = item >> 7, t2 = item & 127; const int wave = tid >> 6, lane = tid & 63, fr = lane & 15, fq = lane >> 4;
    bf16_t* A1 = (bf16_t*)lds; bf16_t* Bt = A1 + 128 * 136;
    const bf16_t* U = (const bf16_t*)(p.ws + WS_U); bf16_t* MID = (bf16_t*)(p.ws + WS_MID);
    for (int e = tid; e < 4096; e += 512) { const int f1 = e >> 6, t1 = e & 63; const int m = (f1 * (128 * t1 + t2)) & 8191; const float s = __builtin_amdgcn_sinf((float)m * (1.f / 8192.f)), c = __builtin_amdgcn_cosf((float)m * (1.f / 8192.f));
        A1[f1 * 136 + t1] = f2bf(c); A1[f1 * 136 + 64 + t1] = f2bf(s); A1[(64 + f1) * 136 + t1] = f2bf(-s); A1[(64 + f1) * 136 + 64 + t1] = f2bf(c); }
    { const int t1 = tid >> 3, pc = tid & 7; const bf16_t* up = U + ((size_t)b * T + 128 * t1 + t2) * LDU + C_FZ + pc * 64;
#pragma unroll
      for (int g8 = 0; g8 < 8; ++g8) { const uint4 v = *(const uint4*)(up + g8 * 8); const int col = pc * 64 + g8 * 8; const int part = col >> 8, ch = col & 255;
#pragma unroll
          for (int e = 0; e < 8; ++e) Bt[(ch + e) * 136 + part * 64 + t1] = f2bf(bfe(v, e)); } }
    __syncthreads();
    for (int tile = wave; tile < 128; tile += 8) { const int tm = tile >> 4, tn = tile & 15, r0 = tm * 16 + fq * 4, ch = tn * 16 + fr;
        f32x4 acc = ZERO4; mma_seg(acc, A1, 136, Bt, 136, tm, tn, 4, fr, fq);
#pragma unroll
        for (int j = 0; j < 4; ++j) { const int r = r0 + j, po = r >> 6, f1 = r & 63;
            MID[(((size_t)b * 64 + f1) * 128 + t2) * 512 + po * 256 + ch] = f2bf(acc[j]); } }
    __syncthreads();
}
__device__ __forceinline__ void fft2_item(const Prm& p, int item, unsigned char* lds, int tid) {
    const int b = item >> 7, f1 = (item >> 1) & 63, chh = item & 1; const int wave = tid >> 6, lane = tid & 63, fr = lane & 15, fq = lane >> 4;
    bf16_t* A2 = (bf16_t*)lds; bf16_t* Bt = A2 + 128 * 264;
    const bf16_t* MID = (const bf16_t*)(p.ws + WS_MID); bf16_t* Y = (bf16_t*)(p.ws + WS_Y);
    { const int t2 = tid >> 2, q = tid & 3, pi = q >> 1, hf = q & 1; const bf16_t* mp = MID + (((size_t)b * 64 + f1) * 128 + t2) * 512 + pi * 256 + chh * 128 + hf * 64;
#pragma unroll
      for (int g8 = 0; g8 < 8; ++g8) { const uint4 v = *(const uint4*)(mp + g8 * 8);
#pragma unroll
          for (int e = 0; e < 8; ++e) Bt[(hf * 64 + g8 * 8 + e) * 264 + pi * 128 + t2] = f2bf(bfe(v, e)); } }
    __syncthreads();
    for (int tile = wave; tile < 64; tile += 8) { const int tm = tile >> 3, tn = tile & 7, r0 = tm * 16 + fq * 4, ch = tn * 16 + fr;
        f32x4 acc = ZERO4; mma_seg(acc, A2, 264, Bt, 264, tm, tn, 8, fr, fq);
#pragma unroll
        for (int j = 0; j < 4; ++j) { const int f2 = r0 + j; Y[((size_t)b * T + f1 + 64 * f2) * 1024 + 768 + chh * 128 + ch] = f2bf(acc[j] * 0.011048543456039806f); } }
    __syncthreads();
}
__device__ __forceinline__ void fftc_item(const Prm& p, int item, unsigned char* lds, int tid) {
    const int b = item >> 4, ft = (item >> 2) & 3, cq = item & 3; const int wave = tid >> 6, lane = tid & 63, fr = lane & 15, fq = lane >> 4;
    bf16_t* A3 = (bf16_t*)lds; bf16_t* Bt = A3 + 64 * 520;
    const bf16_t* U = (const bf16_t*)(p.ws + WS_U); bf16_t* Y = (bf16_t*)(p.ws + WS_Y);
    for (int e = tid; e < 64 * 256; e += 512) { const int fl = e >> 8, t = e & 255; const int m = ((ft * 64 + fl) * t) & 255; const float s = __builtin_amdgcn_sinf((float)m * (1.f / 256.f)), c = __builtin_amdgcn_cosf((float)m * (1.f / 256.f));
        A3[fl * 520 + t] = f2bf(c); A3[fl * 520 + 256 + t] = f2bf(s); }
    { const int t = tid >> 1, pi = tid & 1; const bf16_t* up = U + ((size_t)ML + b * TC + t) * LDU + C_FZ + pi * 256 + cq * 64;
#pragma unroll
      for (int g8 = 0; g8 < 8; ++g8) { const uint4 v = *(const uint4*)(up + g8 * 8);
#pragma unroll
          for (int e = 0; e < 8; ++e) Bt[(g8 * 8 + e) * 520 + pi * 256 + t] = f2bf(bfe(v, e)); } }
    __syncthreads();
    for (int tile = wave; tile < 16; tile += 8) { const int tm = tile >> 2, tn = tile & 3, r0 = tm * 16 + fq * 4, ch = tn * 16 + fr;
        f32x4 acc = ZERO4; mma_seg(acc, A3, 520, Bt, 520, tm, tn, 16, fr, fq);
#pragma unroll
        for (int j = 0; j < 4; ++j) Y[((size_t)ML + b * TC + ft * 64 + r0 + j) * 1024 + 768 + cq * 64 + ch] = f2bf(acc[j] * 0.0625f); }
    __syncthreads();
}

__device__ __forceinline__ void rwkv_post_tile(const Prm& p, int l, int tile, unsigned char* lds, int tid_in) {
    int tid = threadIdx.x; asm volatile("" : "+v"(tid));
    const int wave = tid >> 6, lane = tid & 63, fr = lane & 15, fq = lane >> 4;
    bf16_t* GUPt = (bf16_t*)lds; bf16_t* SG = GUPt + 256 * 72; float* GATE = (float*)(SG + 64 * 72);
    const bf16_t* U = (const bf16_t*)(p.ws + WS_U); const bf16_t* ORp = (const bf16_t*)(p.ws + WS_OR); const float* BC = (const float*)(p.ws + WS_BC); bf16_t* Y = (bf16_t*)(p.ws + WS_Y);
    const int n = tid >> 3, jq = tid & 7; const size_t row = (size_t)tile * 64 + n; const bool isctx = row >= (size_t)ML; const int t = isctx ? (int)((row - ML) & (TC - 1)) : (int)(row & (T - 1));
    const float* mu = p.in[10] + l * 896;
    const int cb = jq * 32, hh = jq >> 1;
    uint4 oa[4], ob[4], vr0[5], vr1[5], vr2[5], vr3[5];
#pragma unroll
    for (int g8 = 0; g8 < 4; ++g8) { oa[g8] = *(const uint4*)(ORp + row * 256 + cb + g8 * 8); ob[g8] = *(const uint4*)(ORp + ((size_t)M + row) * 256 + cb + g8 * 8); }
    lerp8_load(U, row, 512 + cb, isctx, t, vr0); lerp8_load(U, row, 512 + cb + 8, isctx, t, vr1); lerp8_load(U, row, 512 + cb + 16, isctx, t, vr2); lerp8_load(U, row, 512 + cb + 24, isctx, t, vr3);
    const float bcs = BC[row * 4 + hh] + BC[((size_t)M + row) * 4 + hh];
    { float m8[8], g8[8];
      { const f32x4 ma = *(const f32x4*)(mu + 832 + jq * 8), mb = *(const f32x4*)(mu + 832 + jq * 8 + 4);
#pragma unroll
        for (int e = 0; e < 4; ++e) { m8[e] = ma[e]; m8[4 + e] = mb[e]; } }
      lerp8(U, row, 832 + jq * 8, isctx, t, m8, g8);
#pragma unroll
      for (int e = 0; e < 8; ++e) g8[e] = sigmoidf_(g8[e]);
      *(uint4*)(SG + n * 72 + jq * 8) = pack8(g8); }
    __syncthreads();
    for (int tl = wave; tl < 64; tl += 8) { const int tm = tl >> 4, tn = tl & 15, r0 = tm * 16 + fq * 4, cx = tn * 16 + fr;
        f32x4 acc = ZERO4; mma_seg(acc, SG, 72, GUPt, 72, tm, tn, 2, fr, fq);
#pragma unroll
        for (int j = 0; j < 4; ++j) GATE[(r0 + j) * 260 + cx] = acc[j]; }
    __syncthreads();
    { float o[32]; float s = 0.f;
#pragma unroll
      for (int g8 = 0; g8 < 4; ++g8)
#pragma unroll
          for (int e = 0; e < 8; ++e) { o[g8 * 8 + e] = bfe(oa[g8], e) + bfe(ob[g8], e); s += o[g8 * 8 + e]; }
      s += shx1(s); const float mean = s * (1.f / 64.f); float vs = 0.f;
#pragma unroll
      for (int e = 0; e < 32; ++e) { const float dd = o[e] - mean; vs += dd * dd; }
      vs += shx1(vs); const float rstd = rsqrtf(vs * (1.f / 64.f) + 64e-5f);
#pragma unroll
      for (int g8 = 0; g8 < 4; ++g8) { float m8[8], v8[8], y8[8], lg[8], lb[8];
          { const float* mp = mu + 512 + cb + g8 * 8; const float* gp = p.in[19] + l * 256 + cb + g8 * 8; const float* bp2 = p.in[20] + l * 256 + cb + g8 * 8;
            const f32x4 ma = *(const f32x4*)mp, mb = *(const f32x4*)(mp + 4), ga = *(const f32x4*)gp, gb = *(const f32x4*)(gp + 4), ba = *(const f32x4*)bp2, bb2 = *(const f32x4*)(bp2 + 4);
#pragma unroll
            for (int e = 0; e < 4; ++e) { m8[e] = ma[e]; m8[4 + e] = mb[e]; lg[e] = ga[e]; lg[4 + e] = gb[e]; lb[e] = ba[e]; lb[4 + e] = bb2[e]; } }
          if (g8 == 0) lerp8_apply(vr0, m8, v8); else if (g8 == 1) lerp8_apply(vr1, m8, v8); else if (g8 == 2) lerp8_apply(vr2, m8, v8); else lerp8_apply(vr3, m8, v8);
          const f32x4 ga0 = *(const f32x4*)(GATE + n * 260 + cb + g8 * 8), ga1 = *(const f32x4*)(GATE + n * 260 + cb + g8 * 8 + 4);
#pragma unroll
          for (int e = 0; e < 8; ++e) { const float yn = (o[g8 * 8 + e] - mean) * rstd * lg[e] + lb[e];
              y8[e] = (yn + bcs * v8[e]) * (e < 4 ? ga0[e] : ga1[e - 4]); }
          *(uint4*)(Y + row * 1024 + cb + g8 * 8) = pack8(y8); } }
    __syncthreads();
}
__device__ __forceinline__ void gdn_post_tile(const Prm& p, int l, int tile, int tid_in) {
    int tid = threadIdx.x; asm volatile("" : "+v"(tid));
    const bf16_t* U = (const bf16_t*)(p.ws + WS_U); const bf16_t* OGp = (const bf16_t*)(p.ws + WS_OG); bf16_t* Y = (bf16_t*)(p.ws + WS_Y);
    const int n = tid >> 3, jq = tid & 7; const size_t row = (size_t)tile * 64 + n; const int cb = jq * 64;
    uint4 oa[8], ob[8], zq[8];
#pragma unroll
    for (int g8 = 0; g8 < 8; ++g8) { oa[g8] = *(const uint4*)(OGp + row * 512 + cb + g8 * 8); ob[g8] = *(const uint4*)(OGp + ((size_t)M + row) * 512 + cb + g8 * 8);
        zq[g8] = *(const uint4*)(U + row * LDU + C_GZ + cb + g8 * 8); }
    float ss = 0.f;
#pragma unroll
    for (int g8 = 0; g8 < 8; ++g8)
#pragma unroll
        for (int e = 0; e < 8; ++e) { const float o = bfe(oa[g8], e) + bfe(ob[g8], e); ss += o * o; }
    ss += shx1(ss); const float rinv = rsqrtf(ss * (1.f / 128.f) + 1e-6f);
#pragma unroll
    for (int g8 = 0; g8 < 8; ++g8) { float y8[8], ng[8];
        { const float* np = p.in[24] + l * 128 + ((cb + g8 * 8) & 127); const f32x4 na = *(const f32x4*)np, nb2 = *(const f32x4*)(np + 4);
#pragma unroll
          for (int e = 0; e < 4; ++e) { ng[e] = na[e]; ng[4 + e] = nb2[e]; } }
#pragma unroll
        for (int e = 0; e < 8; ++e) { const float o = bfe(oa[g8], e) + bfe(ob[g8], e); const float z = bfe(zq[g8], e); y8[e] = o * rinv * ng[e] * siluf_(z); }
        *(uint4*)(Y + row * 1024 + 256 + cb + g8 * 8) = pack8(y8); }
}
__device__ __forceinline__ void post_phase(const Prm& p, int l, unsigned char* lds, int tid, int G) {
    const int bid = blockIdx.x; const int ntile = (l == 0) ? M / 64 : ML / 64;
    if (bid < ntile) { bf16_t* GUPt = (bf16_t*)lds;
        for (int e = tid; e < 64 * 256; e += 512) { const int q = e >> 8, c = e & 255; GUPt[c * 72 + q] = f2bf(p.in[15][((size_t)l * 64 + q) * 256 + c]); }
        __syncthreads();
#ifdef PROBE_RPOST
        for (int rp = 0; rp < PROBE_RPOST; ++rp)
#endif
        for (int tile = bid; tile < ntile; tile += G) rwkv_post_tile(p, l, tile, lds, tid); }
#ifdef PROBE_GPOST
    for (int rp = 0; rp < PROBE_GPOST; ++rp)
#endif
    for (int tile = bid; tile < ntile; tile += G) gdn_post_tile(p, l, tile, tid);
    __syncthreads();
    if (bid < 512) { bf16_t* A2 = (bf16_t*)lds;
        for (int e = tid; e < 128 * 128; e += 512) { const int f2 = e >> 7, t2 = e & 127; const int m = (f2 * t2) & 127; const float s = __builtin_amdgcn_sinf((float)m * (1.f / 128.f)), c = __builtin_amdgcn_cosf((float)m * (1.f / 128.f));
            A2[f2 * 264 + t2] = f2bf(c); A2[f2 * 264 + 128 + t2] = f2bf(s); }
        __syncthreads();
        for (int it = bid; it < 512; it += G) fft2_item(p, it, lds, tid); }
    if (l == 0 && bid >= G - 64) fftc_item(p, bid - (G - 64), lds, tid);
}

#ifndef PHMASK
#define PHMASK 0x3ffff
#endif
#define PH_IN(k) (((PHMASK >> (k)) & 1) && lo <= (k) && (k) < hi)
#ifndef DUPMASK
#define DUPMASK 0
#endif
#define PH_REP(k) for (int rep_ = 0; rep_ <= ((DUPMASK >> (k)) & 1); ++rep_)
#define PH_SYNC(k) do { if (PH_IN(k) && PH_IN((k) + 1)) { if ((k) == 0) grid.sync(); else xcd_barrier(xbar); } } while (0)
constexpr int LDS_TAB = 131072;
__device__ __forceinline__ const PG8_LAS float* fill_rs_table(unsigned char* lds, const pg8::StaticOrder& S, const float* SS, const float* bias, int ldb) {
    float* tab = (float*)(lds + LDS_TAB); const int tid = threadIdx.x; pg8::Unit u;
    for (int i = 0; i < 10 && S.next(i, u); ++i) {
        if (tid < 256) tab[i * 512 + tid] = __builtin_amdgcn_rsqf(SS[u.pm * 256 + tid] * (1.f / 1024.f) + 1e-6f);
        else { const int bb = u.pm < 128 ? (u.pm >> 5) : 4; tab[i * 512 + tid] = bias[(size_t)bb * ldb + u.pn * 256 + (tid - 256)]; } }
    __syncthreads();
    return (const PG8_LAS float*)((PG8_LAS unsigned char*)lds + LDS_TAB);
}
template <int L>
__device__ __forceinline__ void layer_phases(const Prm& p, cg::grid_group& grid, const XcdBarrier& xbar, unsigned char* lds, int lo, int hi) {
    constexpr int l = L; constexpr int base = 1 + 8 * L;
    if (L == 0) { if (PH_IN(base + 0)) PH_REP(base + 0) { int tid = threadIdx.x; asm volatile("" : "+v"(tid)); norm_phase(p, l, 0, tid, gridDim.x); bias_items(p, tid, gridDim.x); }
        PH_SYNC(base + 0); }
    if (PH_IN(base + 1)) PH_REP(base + 1) { unsigned char* ws = p.ws; const int G = gridDim.x, bid = blockIdx.x;
        pg8::Gemm g{(const bf16_t*)(ws + WS_HN), (const bf16_t*)(ws + WS_WIN) + (size_t)l * LDU * 1024, M, LDU, 1024}; pg8::StaticOrder S; S.init(M, LDU, G, bid);
        if (L == 0) { pg8::EpiBf16<0> E{(bf16_t*)(ws + WS_U), LDU};
            pg8::gemm_phase<pg8::EpiBf16<0>, pg8::StaticOrder, true, true>((PG8_LAS unsigned char*)lds, g, S, E); }
        else { const PG8_LAS float* tab = fill_rs_table(lds, S, (const float*)(ws + WS_SS) + 2 * M, (const float*)(ws + WS_BIAS), 3584);
            pg8::EpiBf16RS<0> E{(bf16_t*)(ws + WS_U), LDU, tab};
            pg8::gemm_phase<pg8::EpiBf16RS<0>, pg8::StaticOrder, true, true>((PG8_LAS unsigned char*)lds, g, S, E); } }
    PH_SYNC(base + 1);
    if (PH_IN(base + 2)) PH_REP(base + 2) { int tid = threadIdx.x; asm volatile("" : "+v"(tid)); const int G = gridDim.x, bid = blockIdx.x;
        if (G >= 256) { if (bid < 128) rwkv_scan(p, l, bid >> 2, bid & 3, 4, lds, tid); else if (bid < 256) gdn_scan(p, l, (bid - 128) >> 2, bid & 3, 4, lds, tid);
            if (bid < 128) { for (int it = bid; it < 384; it += 128) fft1_item(p, it, lds, tid); }
            else fft1_item(p, 384 + (bid - 128), lds, tid); }
        else { if (bid < 32) rwkv_scan(p, l, bid, 0, 1, lds, tid); else if (bid < 64) gdn_scan(p, l, bid - 32, 0, 1, lds, tid);
            else for (int it = bid - 64; it < 512; it += G - 64) fft1_item(p, it, lds, tid); } }
    PH_SYNC(base + 2);
    if (PH_IN(base + 3)) PH_REP(base + 3) { int tid = threadIdx.x; asm volatile("" : "+v"(tid)); post_phase(p, l, lds, tid, gridDim.x); }
    PH_SYNC(base + 3);
    if (PH_IN(base + 4)) PH_REP(base + 4) { unsigned char* ws = p.ws; const int G = gridDim.x, bid = blockIdx.x; const float* modl = (const float*)(ws + WS_MOD) + (size_t)l * 5 * 6144;
        constexpr int Mg = (l == 0) ? M : ML;
        pg8::Gemm g{(const bf16_t*)(ws + WS_Y), (const bf16_t*)(ws + WS_WOUT) + (size_t)l * 1024 * 1024, Mg, 1024, 1024}; pg8::StaticOrder S; S.init(Mg, 1024, G, bid);
        pg8::EpiResidN E{l == 0 ? p.in[0] : p.out, l == 0 ? p.in[2] : (const float*)(ws + WS_XC), p.out, (float*)(ws + WS_XC), modl + 2 * 1024,
                         (bf16_t*)(ws + WS_HN), (float*)(ws + WS_SS) + l * M, p.in[5] + l * 1024, modl + 4 * 1024};
        pg8::gemm_phase<pg8::EpiResidN, pg8::StaticOrder, true, true>((PG8_LAS unsigned char*)lds, g, S, E); }
    PH_SYNC(base + 4);
    if (PH_IN(base + 6)) PH_REP(base + 6) { unsigned char* ws = p.ws; const int G = gridDim.x, bid = blockIdx.x; constexpr int Mg = (l == 0) ? M : ML;
        pg8::Gemm g{(const bf16_t*)(ws + WS_HN), (const bf16_t*)(ws + WS_W1) + (size_t)l * 4096 * 1024, Mg, DFF, 1024}; pg8::StaticOrder S; S.init(Mg, DFF, G, bid);
        const PG8_LAS float* tab = fill_rs_table(lds, S, (const float*)(ws + WS_SS) + l * M, (const float*)(ws + WS_BIAS) + 5 * 3584 + l * 5 * 4096, 4096);
        pg8::EpiBf16RS<1> E{(bf16_t*)(ws + WS_H), DFF, tab};
        pg8::gemm_phase<pg8::EpiBf16RS<1>, pg8::StaticOrder, true, true>((PG8_LAS unsigned char*)lds, g, S, E); }
    PH_SYNC(base + 6);
    if (PH_IN(base + 7)) PH_REP(base + 7) { unsigned char* ws = p.ws; const int G = gridDim.x, bid = blockIdx.x; const float* modl = (const float*)(ws + WS_MOD) + (size_t)l * 5 * 6144; constexpr int Mg = (l == 0) ? M : ML;
        pg8::Gemm g{(const bf16_t*)(ws + WS_H), (const bf16_t*)(ws + WS_W2) + (size_t)l * 1024 * 4096, Mg, 1024, DFF}; pg8::StaticOrder S; S.init(Mg, 1024, G, bid);
        if (L == 0) { const float* modn = (const float*)(ws + WS_MOD) + (size_t)5 * 6144;
            pg8::EpiResidN E{p.out, (const float*)(ws + WS_XC), p.out, (float*)(ws + WS_XC), modl + 5 * 1024, (bf16_t*)(ws + WS_HN), (float*)(ws + WS_SS) + 2 * M, p.in[4] + 1024, modn + 1 * 1024};
            pg8::gemm_phase<pg8::EpiResidN, pg8::StaticOrder, true, true>((PG8_LAS unsigned char*)lds, g, S, E); }
        else { pg8::EpiResid E{p.out, (const float*)(ws + WS_XC), p.out, (float*)(ws + WS_XC), modl + 5 * 1024};
            pg8::gemm_phase<pg8::EpiResid, pg8::StaticOrder, true, true>((PG8_LAS unsigned char*)lds, g, S, E); } }
    PH_SYNC(base + 7);
}
__global__ void __launch_bounds__(512, 2) mega_fwd(Prm p) {
    extern __shared__ __attribute__((aligned(16))) unsigned char lds[];
    cg::grid_group grid = cg::this_grid();
    const int lo = p.ph_lo, hi = p.ph_hi;
    if (threadIdx.x < 2) ((volatile LAS unsigned*)((LAS unsigned char*)lds + LDS_XB))[threadIdx.x] = 0u;
    __syncthreads();
#ifdef EXTRA_SYNCS
    for (int es = 0; es < EXTRA_SYNCS; ++es) grid.sync();
#endif
    if (PH_IN(0)) PH_REP(0) { int tid = threadIdx.x; asm volatile("" : "+v"(tid)); prep_phase(p, lds, tid, gridDim.x); }
    if (PH_IN(0) && PH_IN(1)) grid.sync();
    const XcdBarrier xbar = xcd_barrier_post((unsigned*)(p.ws + WS_BARW), (volatile LAS unsigned*)((LAS unsigned char*)lds + LDS_XB));
    layer_phases<0>(p, grid, xbar, lds, lo, hi);
    layer_phases<1>(p, grid, xbar, lds, lo, hi);
    if (PH_IN(NPH - 1)) { int tid = threadIdx.x; asm volatile("" : "+v"(tid)); norm_phase(p, 1, 2, tid, gridDim.x); }
}

#ifndef MK_SPLIT
#define MK_SPLIT 0
#endif
extern "C" void kernel_launch(void* const* d_in, const int* in_sizes, int n_in, void* d_out, int out_size, void* d_ws, size_t ws_size, hipStream_t stream) {
    static int grid = 0;
    if (grid == 0) {
        int dev = 0, cus = 0, per_cu = 0;
        if (n_in != 29 || out_size != ML * D || ws_size < WS_END3) { fprintf(stderr, "kernel_launch: unexpected problem shape (n_in %d out %d ws %zu)\n", n_in, out_size, ws_size); grid = -1; return; }
        hipGetDevice(&dev); hipDeviceGetAttribute(&cus, hipDeviceAttributeMultiprocessorCount, dev);
        if (hipFuncSetAttribute((const void*)mega_fwd, hipFuncAttributeMaxDynamicSharedMemorySize, LDS_BYTES) != hipSuccess) { fprintf(stderr, "kernel_launch: hipFuncSetAttribute failed\n"); grid = -1; return; }
        if (hipOccupancyMaxActiveBlocksPerMultiprocessor(&per_cu, (const void*)mega_fwd, 512, LDS_BYTES) != hipSuccess || per_cu < 1) { fprintf(stderr, "kernel_launch: occupancy query says %d blocks per CU\n", per_cu); grid = -1; return; }
        grid = cus * 1;
        if (grid > 256) grid = 256;
        if (grid < 128) { fprintf(stderr, "kernel_launch: needs >= 128 CUs\n"); grid = -1; return; }
    }
    if (grid < 0) return;
    Prm prm{};
    for (int i = 0; i < 29; ++i) prm.in[i] = (const float*)d_in[i];
    prm.out = (float*)d_out; prm.ws = (unsigned char*)d_ws;
#if MK_SPLIT
    for (int ph = 0; ph < NPH; ++ph) { prm.ph_lo = ph; prm.ph_hi = ph + 1; void* args[] = {&prm};
        hipError_t e = hipLaunchCooperativeKernel((const void*)mega_fwd, dim3(grid), dim3(512), args, LDS_BYTES, stream);
        if (e != hipSuccess) { fprintf(stderr, "kernel_launch: launch failed: %s\n", hipGetErrorString(e)); break; } }
#else
    prm.ph_lo = 0; prm.ph_hi = NPH; void* args[] = {&prm};
    hipError_t e = hipLaunchCooperativeKernel((const void*)mega_fwd, dim3(grid), dim3(512), args, LDS_BYTES, stream);
    if (e != hipSuccess) fprintf(stderr, "kernel_launch: cooperative launch failed: %s (grid %d)\n", hipGetErrorString(e), grid);
#endif
}
```
